# Optimizing an MI355X kernel written in HIP

```python
import math
import jax, jax.numpy as jnp
from jax import lax
import numpy as np

D_MODEL = 1024
BATCH = 16
SEQ = 4096
DEPTH = 2
DEC_BATCH = 32
DEC_SEQ = 2048
PAST_LEN = 128

GRID_W = 64
D_FF = 2816
C_A = 512
H_A = 8
N_A = 64
R_W = 64
R_A = 64
R_G = 128
LNX_EPS = 64e-5
C_B = 256
H_B = 4
N_B = 64
NA_KH = 8
NA_KW = 16
C_C = 256
H_C = 4
DQ = 32
DV = 64
Q_BLOCK = 128
RMS_EPS = 1e-6
SUBLN_EPS = 1e-5
RW_COLS = 3 * C_A + R_W + R_A + R_G
NA_COLS = 3 * C_B
DF_COLS = 3 * C_C
GATE_COLS = 3 * D_MODEL
IN_COLS = RW_COLS + NA_COLS + DF_COLS + GATE_COLS

kernel_name = 'hybrid_bidir_rwkv7_natten_diffattn_encoder'


def _rmsnorm(x, g, eps=RMS_EPS):
    x32 = x.astype(jnp.float32)
    y = x32 * lax.rsqrt(jnp.mean(x32 * x32, axis=-1, keepdims=True) + eps)
    return (y * g.astype(jnp.float32)).astype(x.dtype)


def _swiglu(x, w_gate, w_up, w_down):
    return (jax.nn.silu(x @ w_gate) * (x @ w_up)) @ w_down


def _wkv7_scan(r, decay, k, v, a, b, reverse):
    B, L, H, N = r.shape
    xs = tuple(jnp.moveaxis(t, 1, 0) for t in (r, decay, k, v, a, b))

    def step(S, inp):
        r_t, d_t, k_t, v_t, a_t, b_t = inp
        sa = jnp.einsum('bhvk,bhk->bhv', S, a_t)
        S = S * d_t[:, :, None, :] + sa[..., None] * b_t[:, :, None, :] + v_t[..., None] * k_t[:, :, None, :]
        return S, jnp.einsum('bhvk,bhk->bhv', S, r_t)

    S0 = jnp.zeros((B, H, N, N), jnp.float32)
    _, y = lax.scan(step, S0, xs, reverse=reverse)
    return jnp.moveaxis(y, 0, 1)


def _rwkv7_branch(z, mu, w0, w2, a0, a2, k_a, r_k, k_k, g2, lnx_g, lnx_b):
    B, L, _ = z.shape
    f32 = jnp.float32
    prev = jnp.pad(z, ((0, 0), (1, 0), (0, 0)))[:, :L]
    nxt = jnp.pad(z, ((0, 0), (0, 1), (0, 0)))[:, 1:]
    z = z + mu[0] * (prev - z) + mu[1] * (nxt - z)
    r, k, v, w_lo, a_lo, g_lo = jnp.split(
        z, [C_A, 2 * C_A, 3 * C_A, 3 * C_A + R_W, 3 * C_A + R_W + R_A], axis=-1)

    def heads(t):
        return t.astype(f32).reshape(B, L, H_A, N_A)

    r, k, v = heads(r), heads(k), heads(v)
    kk = k * k_k.astype(f32).reshape(H_A, N_A)
    kk = kk / jnp.maximum(jnp.sqrt(jnp.sum(kk * kk, axis=-1, keepdims=True)), 1e-12)
    wt = jnp.tanh(w_lo.astype(f32))
    a_lo = a_lo.astype(f32)

    def direction(d, reverse):
        w = -jax.nn.softplus(-(w0[d].astype(f32) + wt @ w2[d].astype(f32))) - 0.5
        decay = heads(jnp.exp(-jnp.exp(w)))
        a = heads(jax.nn.sigmoid(a0[d].astype(f32) + a_lo @ a2[d].astype(f32)))
        kd = k * (1.0 + (a - 1.0) * k_a[d].astype(f32).reshape(H_A, N_A))
        y = _wkv7_scan(r, decay, kd, v, -kk, kk * a, reverse)
        bonus = jnp.sum(r * kd * r_k[d].astype(f32), axis=-1, keepdims=True) * v
        return y, bonus

    y_f, bonus_f = direction(0, False)
    y_b, bonus_b = direction(1, True)
    y = y_f + y_b
    mean = jnp.mean(y, axis=-1, keepdims=True)
    var = jnp.mean(jnp.square(y - mean), axis=-1, keepdims=True)
    y = (y - mean) * lax.rsqrt(var + LNX_EPS)
    y = y.reshape(B, L, C_A) * lnx_g.astype(f32) + lnx_b.astype(f32) + (bonus_f + bonus_b).reshape(B, L, C_A)
    g = jax.nn.sigmoid(g_lo.astype(f32)) @ g2.astype(f32)
    return (y * g).astype(z.dtype)


def _neighbourhood_attention(q, k, v, rpb):
    B, L, H, N = q.shape
    f32 = jnp.float32
    rows = L // GRID_W
    kh = min(NA_KH, rows)
    qg = q.reshape(B, rows, GRID_W, H, N)
    kg = k.reshape(B, rows, GRID_W, H, N)
    vg = v.reshape(B, rows, GRID_W, H, N)
    cols = np.arange(GRID_W)
    col_idx = np.clip(cols - NA_KW // 2, 0, GRID_W - NA_KW)[:, None] + np.arange(NA_KW)[None, :]
    dc = col_idx - cols[:, None] + (NA_KW - 1)
    bias_c = jnp.transpose(rpb.astype(f32)[:, :, dc], (0, 2, 1, 3))
    scale = N ** -0.5

    def one_row(r):
        rs = jnp.clip(r - kh // 2, 0, rows - kh)
        k_win = lax.dynamic_slice_in_dim(kg, rs, kh, axis=1)[:, :, col_idx]
        v_win = lax.dynamic_slice_in_dim(vg, rs, kh, axis=1)[:, :, col_idx]
        q_r = lax.dynamic_index_in_dim(qg, r, axis=1, keepdims=False)
        s = jnp.einsum('bchn,bicjhn->bhcij', q_r, k_win, preferred_element_type=f32) * scale
        dr = rs + jnp.arange(kh) - r + (NA_KH - 1)
        s = s + jnp.take(bias_c, dr, axis=2)[None]
        p = jax.nn.softmax(s.reshape(B, H, GRID_W, kh * NA_KW), axis=-1).reshape(B, H, GRID_W, kh, NA_KW)
        return jnp.einsum('bhcij,bicjhn->bchn', p, v_win.astype(f32))

    out = lax.map(one_row, jnp.arange(rows))
    return jnp.transpose(out, (1, 0, 2, 3, 4)).reshape(B, L, H * N)


def _diff_attention(q, k, v, lam, lam_init, subln_g):
    B, L = q.shape[:2]
    f32 = jnp.float32
    nb = L // Q_BLOCK
    slopes = np.repeat(2.0 ** (-8.0 * np.arange(1, H_C + 1) / H_C), 2).astype(np.float32)
    pos = jnp.arange(L)
    qb = jnp.moveaxis(q.reshape(B, nb, Q_BLOCK, 2 * H_C, DQ), 1, 0)
    v32 = v.astype(f32)
    scale = DQ ** -0.5

    def one_block(args):
        q_blk, i = args
        s = jnp.einsum('bqgd,bkgd->bgqk', q_blk, k, preferred_element_type=f32) * scale
        qpos = i * Q_BLOCK + jnp.arange(Q_BLOCK)
        dist = jnp.abs(qpos[:, None] - pos[None, :]).astype(f32)
        s = s - slopes[:, None, None] * dist[None]
        p = jax.nn.softmax(s, axis=-1).reshape(B, H_C, 2, Q_BLOCK, L)
        attn = p[:, :, 0] - lam * p[:, :, 1]
        return jnp.einsum('bhqk,bkhd->bqhd', attn, v32)

    o = lax.map(one_block, (qb, jnp.arange(nb)))
    o = jnp.moveaxis(o, 0, 1).reshape(B, L, H_C, DV)
    o = o * lax.rsqrt(jnp.mean(o * o, axis=-1, keepdims=True) + SUBLN_EPS) * subln_g.astype(f32) * (1.0 - lam_init)
    return o.reshape(B, L, H_C * DV)


def _token_mixing(u, p, l):
    B, L, _ = u.shape
    f32 = jnp.float32
    proj = u @ p['w_in'][l]
    o1 = RW_COLS
    o2 = o1 + NA_COLS
    o3 = o2 + DF_COLS
    z_a, z_b, z_c, z_g = jnp.split(proj, [o1, o2, o3], axis=-1)
    y_a = _rwkv7_branch(z_a, p['rwkv_mu'][l], p['rwkv_w0'][l], p['rwkv_w2'][l], p['rwkv_a0'][l], p['rwkv_a2'][l],
                        p['rwkv_k_a'][l], p['rwkv_r_k'][l], p['rwkv_k_k'][l], p['rwkv_g2'][l],
                        p['rwkv_lnx_g'][l], p['rwkv_lnx_b'][l])
    qn, kn, vn = (t.reshape(B, L, H_B, N_B) for t in jnp.split(z_b, 3, axis=-1))
    y_b = _neighbourhood_attention(qn, kn, vn, p['na_rpb'][l]).astype(u.dtype)
    qd, kd, vd = jnp.split(z_c, 3, axis=-1)
    lam_init = 0.8 - 0.6 * math.exp(-0.3 * l)
    lp = p['diff_lam'][l].astype(f32)
    lam = jnp.exp(jnp.sum(lp[0] * lp[1])) - jnp.exp(jnp.sum(lp[2] * lp[3])) + lam_init
    y_c = _diff_attention(qd.reshape(B, L, 2 * H_C, DQ), kd.reshape(B, L, 2 * H_C, DQ),
                          vd.reshape(B, L, H_C, DV), lam, lam_init, p['diff_subln_g'][l]).astype(u.dtype)
    g_a, g_b, g_c = jnp.split(jax.nn.sigmoid(z_g), 3, axis=-1)
    m = g_a * (y_a @ p['p_a'][l]) + g_b * (y_b @ p['p_b'][l]) + g_c * (y_c @ p['p_c'][l])
    return m @ p['w_out'][l]


def _trunk(x, p):
    for l in range(DEPTH):
        x = x + 0.5 * _swiglu(_rmsnorm(x, p['ln_ffn1_g'][l]), p['ffn1_w_gate'][l], p['ffn1_w_up'][l], p['ffn1_w_down'][l])
        x = x + _token_mixing(_rmsnorm(x, p['ln_mix_g'][l]), p, l)
        x = x + 0.5 * _swiglu(_rmsnorm(x, p['ln_ffn2_g'][l]), p['ffn2_w_gate'][l], p['ffn2_w_up'][l], p['ffn2_w_down'][l])
    return _rmsnorm(x, p['final_g'])


def setup_inputs(seed: int = 0) -> dict:
    key = jax.random.key(seed)
    ks = list(jax.random.split(key, 48))
    f32 = jnp.float32

    def nrm(shape, scale):
        return scale * jax.random.normal(ks.pop(), shape, f32)

    def uni(shape, lo, hi):
        return jax.random.uniform(ks.pop(), shape, f32, lo, hi)

    return {
        'x_prompt': nrm((BATCH, SEQ, D_MODEL), 1.0),
        'x_sample': nrm((DEC_BATCH, DEC_SEQ, D_MODEL), 1.0),
        'ln_ffn1_g': 1.0 + nrm((DEPTH, D_MODEL), 0.1),
        'ffn1_w_gate': nrm((DEPTH, D_MODEL, D_FF), D_MODEL ** -0.5),
        'ffn1_w_up': nrm((DEPTH, D_MODEL, D_FF), D_MODEL ** -0.5),
        'ffn1_w_down': nrm((DEPTH, D_FF, D_MODEL), D_FF ** -0.5),
        'ln_mix_g': 1.0 + nrm((DEPTH, D_MODEL), 0.1),
        'w_in': nrm((DEPTH, D_MODEL, IN_COLS), D_MODEL ** -0.5),
        'rwkv_mu': uni((DEPTH, 2, RW_COLS), 0.0, 0.5),
        'rwkv_w0': uni((DEPTH, 2, C_A), -6.0, -1.0),
        'rwkv_w2': nrm((DEPTH, 2, R_W, C_A), 0.5 * R_W ** -0.5),
        'rwkv_a0': nrm((DEPTH, 2, C_A), 0.1),
        'rwkv_a2': nrm((DEPTH, 2, R_A, C_A), R_A ** -0.5),
        'rwkv_k_a': 1.0 + nrm((DEPTH, 2, C_A), 0.1),
        'rwkv_r_k': nrm((DEPTH, 2, H_A, N_A), 0.1),
        'rwkv_k_k': 0.85 + nrm((DEPTH, C_A), 0.05),
        'rwkv_g2': nrm((DEPTH, R_G, C_A), R_G ** -0.5),
        'rwkv_lnx_g': 1.0 + nrm((DEPTH, C_A), 0.1),
        'rwkv_lnx_b': nrm((DEPTH, C_A), 0.1),
        'na_rpb': nrm((DEPTH, H_B, 2 * NA_KH - 1, 2 * NA_KW - 1), 0.2),
        'diff_lam': nrm((DEPTH, 4, DQ), 0.1),
        'diff_subln_g': 1.0 + nrm((DEPTH, DV), 0.1),
        'p_a': nrm((DEPTH, C_A, D_MODEL), C_A ** -0.5),
        'p_b': nrm((DEPTH, C_B, D_MODEL), C_B ** -0.5),
        'p_c': nrm((DEPTH, C_C, D_MODEL), C_C ** -0.5),
        'w_out': nrm((DEPTH, D_MODEL, D_MODEL), D_MODEL ** -0.5),
        'ln_ffn2_g': 1.0 + nrm((DEPTH, D_MODEL), 0.1),
        'ffn2_w_gate': nrm((DEPTH, D_MODEL, D_FF), D_MODEL ** -0.5),
        'ffn2_w_up': nrm((DEPTH, D_MODEL, D_FF), D_MODEL ** -0.5),
        'ffn2_w_down': nrm((DEPTH, D_FF, D_MODEL), D_FF ** -0.5),
        'final_g': 1.0 + nrm((D_MODEL,), 0.1),
    }


def reference(x_prompt, x_sample, ln_ffn1_g, ffn1_w_gate, ffn1_w_up, ffn1_w_down, ln_mix_g, w_in,
              rwkv_mu, rwkv_w0, rwkv_w2, rwkv_a0, rwkv_a2, rwkv_k_a, rwkv_r_k, rwkv_k_k, rwkv_g2,
              rwkv_lnx_g, rwkv_lnx_b, na_rpb, diff_lam, diff_subln_g, p_a, p_b, p_c, w_out,
              ln_ffn2_g, ffn2_w_gate, ffn2_w_up, ffn2_w_down, final_g):
    p = dict(ln_ffn1_g=ln_ffn1_g, ffn1_w_gate=ffn1_w_gate, ffn1_w_up=ffn1_w_up, ffn1_w_down=ffn1_w_down,
             ln_mix_g=ln_mix_g, w_in=w_in, rwkv_mu=rwkv_mu, rwkv_w0=rwkv_w0, rwkv_w2=rwkv_w2,
             rwkv_a0=rwkv_a0, rwkv_a2=rwkv_a2, rwkv_k_a=rwkv_k_a, rwkv_r_k=rwkv_r_k, rwkv_k_k=rwkv_k_k,
             rwkv_g2=rwkv_g2, rwkv_lnx_g=rwkv_lnx_g, rwkv_lnx_b=rwkv_lnx_b, na_rpb=na_rpb,
             diff_lam=diff_lam, diff_subln_g=diff_subln_g, p_a=p_a, p_b=p_b, p_c=p_c, w_out=w_out,
             ln_ffn2_g=ln_ffn2_g, ffn2_w_gate=ffn2_w_gate, ffn2_w_up=ffn2_w_up, ffn2_w_down=ffn2_w_down,
             final_g=final_g)
    y_prompt = _trunk(x_prompt, p)
    y_sample = _trunk(x_sample, p)
    return (y_prompt, y_sample)
```

```cpp
#include <hip/hip_runtime.h>
#include <hip/hip_cooperative_groups.h>
#include <cstdio>
#include <cstdint>
namespace cg = cooperative_groups;

typedef unsigned short bf16_t;
typedef short bf16x8 __attribute__((ext_vector_type(8)));
typedef short s16x4 __attribute__((ext_vector_type(4)));
typedef float f32x4 __attribute__((ext_vector_type(4)));
typedef float f32x2 __attribute__((ext_vector_type(2)));
typedef unsigned u32x4 __attribute__((ext_vector_type(4)));
typedef unsigned u32x2 __attribute__((ext_vector_type(2)));
#define DI __device__ __forceinline__
#define MFMA16(a, b, c) __builtin_amdgcn_mfma_f32_16x16x32_bf16((a), (b), (c), 0, 0, 0)

constexpr int D = 1024, DFF = 2816, HT = 65536  , NLAYER = 2;
constexpr int ZC = 3328;
constexpr int INC = 6400;
constexpr int CA = 512;
constexpr float LOG2E = 1.4426950408889634f;

constexpr size_t WS_CTL = 0;
constexpr size_t WS_W = 4096;
constexpr size_t W_GU = 0;
constexpr size_t W_WD = W_GU + (size_t)2 * DFF * D;
constexpr size_t W_GU2 = W_WD + (size_t)D * DFF;
constexpr size_t W_WD2 = W_GU2 + (size_t)2 * DFF * D;
constexpr size_t W_IN = W_WD2 + (size_t)D * DFF;
constexpr size_t W_PA = W_IN + (size_t)INC * D;
constexpr size_t W_PB = W_PA + (size_t)D * 512;
constexpr size_t W_PC = W_PB + (size_t)D * 256;
constexpr size_t W_OUT = W_PC + (size_t)D * 256;
constexpr size_t W_G2 = W_OUT + (size_t)D * D;
constexpr size_t W_LAYER = W_G2 + (size_t)512 * 128;
constexpr size_t WS_XN = WS_W + 2 * W_LAYER * 2;
constexpr size_t WS_R = WS_XN + (size_t)HT * D * 2;
constexpr size_t WS_HID = WS_R;
constexpr size_t WS_Z = WS_R;
constexpr size_t WS_M = WS_R;
constexpr size_t WS_YF = WS_Z + (size_t)HT * ZC * 2;
constexpr size_t WS_YB = WS_YF + (size_t)HT * 512 * 2;
constexpr size_t WS_YN = WS_YB + (size_t)HT * 512 * 2;
constexpr size_t WS_YD = WS_YN + (size_t)HT * 256 * 2;
constexpr size_t WS_SG = WS_YD + (size_t)HT * 256 * 2;
constexpr size_t WS_BON = WS_SG + (size_t)HT * 128 * 2;
constexpr size_t WS_END = WS_BON + (size_t)2 * HT * 8 * 4;

struct Params {
  const float* in[31];
  float* out;
  unsigned char* ws;
};

typedef __bf16 bf16x2_t __attribute__((ext_vector_type(2)));
DI unsigned pack2(float lo, float hi) { const f32x2 v = {lo, hi}; const bf16x2_t b = __builtin_convertvector(v, bf16x2_t); return __builtin_bit_cast(unsigned, b); }
DI bf16_t f2bf(float x) { return (bf16_t)(pack2(x, x) & 0xffffu); }
DI float bf2f(bf16_t h) { return __uint_as_float(((unsigned)h) << 16); }
DI float lo2f(unsigned u) { return __uint_as_float(u << 16); }
DI float hi2f(unsigned u) { return __uint_as_float(u & 0xffff0000u); }
DI float xor16_sum(float v) { const auto r = __builtin_amdgcn_permlane16_swap(__float_as_uint(v), __float_as_uint(v), false, false); return __uint_as_float(r[0]) + __uint_as_float(r[1]); }
DI float xor32_sum(float v) { const auto r = __builtin_amdgcn_permlane32_swap(__float_as_uint(v), __float_as_uint(v), false, false); return __uint_as_float(r[0]) + __uint_as_float(r[1]); }
DI float xor16_max(float v) { const auto r = __builtin_amdgcn_permlane16_swap(__float_as_uint(v), __float_as_uint(v), false, false); return fmaxf(__uint_as_float(r[0]), __uint_as_float(r[1])); }
DI float xor32_max(float v) { const auto r = __builtin_amdgcn_permlane32_swap(__float_as_uint(v), __float_as_uint(v), false, false); return fmaxf(__uint_as_float(r[0]), __uint_as_float(r[1])); }
DI float fq_sum(float v) { return xor32_sum(xor16_sum(v)); }
DI float fq_max(float v) { return xor32_max(xor16_max(v)); }
DI float quad_sum(float v) {
  int t = __builtin_amdgcn_update_dpp(0, __float_as_int(v), 0xB1, 0xF, 0xF, true);
  v += __int_as_float(t);
  t = __builtin_amdgcn_update_dpp(0, __float_as_int(v), 0x4E, 0xF, 0xF, true);
  v += __int_as_float(t);
  return v;
}
DI float oct_sum(float v) {
  v = quad_sum(v);
  const int t = __builtin_amdgcn_update_dpp(0, __float_as_int(v), 0x141, 0xF, 0xF, true);
  return v + __int_as_float(t);
}
DI float row_sum16(float v) {
  v = oct_sum(v);
  const int t = __builtin_amdgcn_update_dpp(0, __float_as_int(v), 0x140, 0xF, 0xF, true);
  return v + __int_as_float(t);
}
DI float wave_sum(float v) { return fq_sum(row_sum16(v)); }
DI int otid() { int t = threadIdx.x; asm volatile("" : "+v"(t)); return t; }
DI float rcp_(float x) { return __builtin_amdgcn_rcpf(x); }
DI float sigmoidf_(float x) { return rcp_(1.0f + __expf(-x)); }

DI void convert_job(const float* __restrict__ src, int K, int N, bf16_t* __restrict__ dst, int mode, float* tile  ) {
  const int tid = otid();
  const int ntk = K / 64, ntn = N / 64, nt = ntk * ntn;
  for (int t = blockIdx.x; t < nt; t += gridDim.x) {
    const int tk = t / ntn, tn = t % ntn;
    const int k0 = tk * 64, n0 = tn * 64;
    __syncthreads();
#pragma unroll
    for (int i = 0; i < 8; ++i) {
      const int kk = (tid >> 6) + i * 8, nn = tid & 63;
      tile[kk * 65 + nn] = src[(size_t)(k0 + kk) * N + n0 + nn];
    }
    __syncthreads();
    const int nn = tid >> 3, kc = (tid & 7) * 8;
    const int n = n0 + nn;
    int row = n;
    if (mode == 1) row = (n >> 5) * 64 + (n & 31);
    else if (mode == 2) row = (n >> 5) * 64 + 32 + (n & 31);
    u32x4 pk;
#pragma unroll
    for (int i = 0; i < 4; ++i) pk[i] = pack2(tile[(kc + 2 * i) * 65 + nn], tile[(kc + 2 * i + 1) * 65 + nn]);
    *(u32x4*)(dst + (size_t)row * K + k0 + kc) = pk;
  }
}

DI void phase_convert(const Params& p, unsigned char* smem) {
  float* tile = (float*)smem;
  bf16_t* W = (bf16_t*)(p.ws + WS_W);
  for (int l = 0; l < NLAYER; ++l) {
    bf16_t* Wl = W + (size_t)l * W_LAYER;
    convert_job(p.in[3] + (size_t)l * D * DFF, D, DFF, Wl + W_GU, 1, tile);
    convert_job(p.in[4] + (size_t)l * D * DFF, D, DFF, Wl + W_GU, 2, tile);
    convert_job(p.in[5] + (size_t)l * DFF * D, DFF, D, Wl + W_WD, 0, tile);
    convert_job(p.in[27] + (size_t)l * D * DFF, D, DFF, Wl + W_GU2, 1, tile);
    convert_job(p.in[28] + (size_t)l * D * DFF, D, DFF, Wl + W_GU2, 2, tile);
    convert_job(p.in[29] + (size_t)l * DFF * D, DFF, D, Wl + W_WD2, 0, tile);
    convert_job(p.in[7] + (size_t)l * D * INC, D, INC, Wl + W_IN, 0, tile);
    convert_job(p.in[22] + (size_t)l * 512 * D, 512, D, Wl + W_PA, 0, tile);
    convert_job(p.in[23] + (size_t)l * 256 * D, 256, D, Wl + W_PB, 0, tile);
    convert_job(p.in[24] + (size_t)l * 256 * D, 256, D, Wl + W_PC, 0, tile);
    convert_job(p.in[25] + (size_t)l * D * D, D, D, Wl + W_OUT, 0, tile);
    convert_job(p.in[16] + (size_t)l * 128 * 512, 128, 512, Wl + W_G2, 0, tile);
  }
}

DI void phase_norm(const float* __restrict__ src, const float* __restrict__ gam, bf16_t* __restrict__ xn, float* __restrict__ fout) {
  const int tid_ = otid(), lane = tid_ & 63, w = tid_ >> 6;
  f32x4 g[4];
#pragma unroll
  for (int i = 0; i < 4; ++i) g[i] = *(const f32x4*)(gam + i * 256 + lane * 4);
  const int stride = gridDim.x * 8;
  auto ld = [&](f32x4 (&v)[4], int row) {
    if (row < HT) {
#pragma unroll
      for (int i = 0; i < 4; ++i) v[i] = *(const f32x4*)(src + (size_t)row * D + i * 256 + lane * 4);
    }
  };
  auto proc = [&](const f32x4 (&v)[4], int row) {
    float ss = 0.f;
#pragma unroll
    for (int i = 0; i < 4; ++i) ss += (v[i][0] * v[i][0] + v[i][1] * v[i][1]) + (v[i][2] * v[i][2] + v[i][3] * v[i][3]);
    ss = wave_sum(ss);
    const float rs = rsqrtf(ss * (1.0f / 1024.0f) + 1e-6f);
#pragma unroll
    for (int i = 0; i < 4; ++i) {
      const f32x4 y = v[i] * rs * g[i];
      if (fout) *(f32x4*)(fout + (size_t)row * D + i * 256 + lane * 4) = y;
      else *(uint2*)(xn + (size_t)row * D + i * 256 + lane * 4) = make_uint2(pack2(y[0], y[1]), pack2(y[2], y[3]));
    }
  };
  int t = blockIdx.x * 8 + w;
  f32x4 a[4], b[4];
  ld(a, t); ld(b, t + stride);
  for (; t < HT; t += 2 * stride) {
    f32x4 na[4], nb[4];
    ld(na, t + 2 * stride); ld(nb, t + 3 * stride);
    proc(a, t);
    if (t + stride < HT) proc(b, t + stride);
#pragma unroll
    for (int i = 0; i < 4; ++i) { a[i] = na[i]; b[i] = nb[i]; }
  }
}

constexpr int RS = 144;
typedef __attribute__((address_space(3))) unsigned lds_u32;
DI void glds16(const void* g, unsigned char* l) { __builtin_amdgcn_global_load_lds((const unsigned*)g, (lds_u32*)l, 16, 0, 0); }
template <int N> DI void wait_vm() { asm volatile("s_waitcnt vmcnt(%0)" :: "n"(N) : "memory"); }
template <int MT, int NT, int WR, int WC>
DI void gemm_block(const bf16_t* __restrict__ A, int lda, const bf16_t* __restrict__ B, int ldb, int K, f32x4 (&acc)[MT][NT], unsigned char* smem,
                   bool primed = false, const bf16_t* __restrict__ nA = nullptr, int nlda = 0, const bf16_t* __restrict__ nB = nullptr, int nldb = 0) {
  static_assert(WR * WC == 8, "8 waves");
  constexpr int AR = 16 * MT * WR, BR = 16 * NT * WC;
  constexpr int AB = AR * 128, BB = BR * 128, STG = AB + BB;
  constexpr int NA = AR * 8 / 512, NB = BR * 8 / 512;
  const int tid = otid(), lane = tid & 63, w = tid >> 6, wr = w / WC, wc = w % WC, fr = lane & 15, fq = lane >> 4;
  const int srow = tid >> 3, kch = (tid & 7) ^ ((tid >> 4) & 7);
  const unsigned voA = (unsigned)(srow * lda + kch * 8) * 2u, voB = (unsigned)(srow * ldb + kch * 8) * 2u;
  const char* Ab = (const char*)A;
  const char* Bb = (const char*)B;
  const int nk = K >> 6;
  if (!primed) {
#pragma unroll
    for (int i = 0; i < NA; ++i) glds16(Ab + (size_t)i * 128 * lda + voA, smem + (i * 512 + tid) * 16);
#pragma unroll
    for (int i = 0; i < NB; ++i) glds16(Bb + (size_t)i * 128 * ldb + voB, smem + AB + (i * 512 + tid) * 16);
  }
  const int sw = (fr >> 1) & 7;
  const unsigned lds_base = (unsigned)(size_t)(__attribute__((address_space(3))) unsigned char*)smem;
  const unsigned a_row = (wr * 16 * MT + fr) * 128, b_row = AB + (wc * 16 * NT + fr) * 128;
  for (int kt = 0; kt < nk; ++kt) {
    wait_vm<0>();
    __builtin_amdgcn_s_barrier();
    if (kt + 1 < nk) {
      unsigned char* sn = smem + ((kt + 1) & 1) * STG;
      const int ko = (kt + 1) * 64;
#pragma unroll
      for (int i = 0; i < NA; ++i) glds16(Ab + ((size_t)i * 128 * lda + ko * 2) + voA, sn + (i * 512 + tid) * 16);
#pragma unroll
      for (int i = 0; i < NB; ++i) glds16(Bb + ((size_t)i * 128 * ldb + ko * 2) + voB, sn + AB + (i * 512 + tid) * 16);
    } else if (nA) {
      const unsigned nvoA = (unsigned)(srow * nlda + kch * 8) * 2u, nvoB = (unsigned)(srow * nldb + kch * 8) * 2u;
#pragma unroll
      for (int i = 0; i < NA; ++i) glds16((const char*)nA + (size_t)i * 128 * nlda + nvoA, smem + (i * 512 + tid) * 16);
#pragma unroll
      for (int i = 0; i < NB; ++i) glds16((const char*)nB + (size_t)i * 128 * nldb + nvoB, smem + AB + (i * 512 + tid) * 16);
    }
    const unsigned stb = lds_base + (kt & 1) * STG;
#pragma unroll
    for (int ks = 0; ks < 2; ++ks) {
      const unsigned co = ((ks * 4 + fq) ^ sw) * 16;
      const unsigned sa = stb + a_row + co, sb = stb + b_row + co;
      bf16x8 af[4], bfr[NT];
#pragma unroll
      for (int n = 0; n < NT; ++n) asm volatile("ds_read_b128 %0, %1 offset:%2" : "=v"(bfr[n]) : "v"(sb), "n"(n * 2048) : "memory");
#pragma unroll
      for (int mg = 0; mg < MT / 4; ++mg) {
#pragma unroll
        for (int m = 0; m < 4; ++m) asm volatile("ds_read_b128 %0, %1 offset:%2" : "=v"(af[m]) : "v"(sa), "n"((mg * 4 + m) * 2048) : "memory");
        if (mg == 0) {
#pragma unroll
          for (int n = 0; n < NT; ++n) asm volatile("s_waitcnt lgkmcnt(%1)" : "+v"(bfr[n]) : "n"(4 + NT - 1 - n) : "memory");
        }
#pragma unroll
        for (int m = 0; m < 4; ++m) {
          asm volatile("s_waitcnt lgkmcnt(%1)" : "+v"(af[m]) : "n"(3 - m) : "memory");
#pragma unroll
          for (int n = 0; n < NT; ++n) acc[mg * 4 + m][n] = MFMA16(bfr[n], af[m], acc[mg * 4 + m][n]);
        }
      }
    }
  }
  if (!nA) __syncthreads();
}

template <int MT, int NT>
DI void zero_acc(f32x4 (&acc)[MT][NT]) {
#pragma unroll
  for (int m = 0; m < MT; ++m)
#pragma unroll
    for (int n = 0; n < NT; ++n) acc[m][n] = (f32x4){0.f, 0.f, 0.f, 0.f};
}

DI void tile_coords(int id, int nN, int& pm, int& pn) {
  const int band = id / (16 * nN), r = id % (16 * nN);
  pm = band * 16 + (r & 15); pn = r >> 4;
}

DI void phase_ffn_up(const bf16_t* __restrict__ xn, const bf16_t* __restrict__ gu, bf16_t* __restrict__ hid, unsigned char* smem) {
  const int tid_ = otid(), lane = tid_ & 63, w = tid_ >> 6, wr = w >> 2, wc = w & 3, fr = lane & 15, fq = lane >> 4;
  constexpr int nN = 2 * DFF / 256, nM = HT / 256;
  for (int id = blockIdx.x; id < nM * nN; id += gridDim.x) {
    int pm, pn; tile_coords(id, nN, pm, pn);
    f32x4 acc[8][4]; zero_acc(acc);
    {
      const int idn = id + gridDim.x; int pm2 = 0, pn2 = 0; const bool hn = idn < nM * nN; if (hn) tile_coords(idn, nN, pm2, pn2);
      gemm_block<8, 4, 2, 4>(xn + (size_t)pm * 256 * D, D, gu + (size_t)pn * 256 * D, D, D, acc, smem, id != (int)blockIdx.x,
                             hn ? xn + (size_t)pm2 * 256 * D : nullptr, D, gu + (size_t)pn2 * 256 * D, D);
    }
    const int hc0 = (pn * 4 + wc) * 32 + fq * 4;
#pragma unroll
    for (int m = 0; m < 8; ++m) {
      const size_t row = (size_t)pm * 256 + wr * 128 + m * 16 + fr;
#pragma unroll
      for (int n = 0; n < 2; ++n) {
        float h[4];
#pragma unroll
        for (int j = 0; j < 4; ++j) { const float g = acc[m][n][j], u = acc[m][n + 2][j]; h[j] = g * rcp_(1.0f + __expf(-g)) * u; }
        *(uint2*)(hid + row * DFF + hc0 + n * 16) = make_uint2(pack2(h[0], h[1]), pack2(h[2], h[3]));
      }
    }
  }
}

DI void phase_gemm_resid(const bf16_t* __restrict__ A, int K, const bf16_t* __restrict__ Bt, const float* __restrict__ xin, float* __restrict__ xout, float alpha, unsigned char* smem) {
  const int tid_ = otid(), lane = tid_ & 63, w = tid_ >> 6, wr = w >> 2, wc = w & 3, fr = lane & 15, fq = lane >> 4;
  constexpr int nN = D / 256, nM = HT / 256;
  for (int id = blockIdx.x; id < nM * nN; id += gridDim.x) {
    int pm, pn; tile_coords(id, nN, pm, pn);
    f32x4 acc[8][4]; zero_acc(acc);
    {
      const int idn = id + gridDim.x; int pm2 = 0, pn2 = 0; const bool hn = idn < nM * nN; if (hn) tile_coords(idn, nN, pm2, pn2);
      gemm_block<8, 4, 2, 4>(A + (size_t)pm * 256 * K, K, Bt + (size_t)pn * 256 * K, K, K, acc, smem, id != (int)blockIdx.x,
                             hn ? A + (size_t)pm2 * 256 * K : nullptr, K, Bt + (size_t)pn2 * 256 * K, K);
    }
#pragma unroll
    for (int m = 0; m < 8; ++m) {
      const size_t row = (size_t)pm * 256 + wr * 128 + m * 16 + fr;
#pragma unroll
      for (int n = 0; n < 4; ++n) {
        const size_t o = row * D + pn * 256 + wc * 64 + n * 16 + fq * 4;
        const f32x4 x = *(const f32x4*)(xin + o);
        *(f32x4*)(xout + o) = x + alpha * acc[m][n];
      }
    }
  }
}

DI void phase_proj(const bf16_t* __restrict__ xn, const bf16_t* __restrict__ wint, bf16_t* __restrict__ z, unsigned char* smem) {
  const int tid_ = otid(), lane = tid_ & 63, w = tid_ >> 6, wr = w >> 2, wc = w & 3, fr = lane & 15, fq = lane >> 4;
  constexpr int nN = ZC / 256, nM = HT / 256;
  for (int id = blockIdx.x; id < nM * nN; id += gridDim.x) {
    int pm, pn; tile_coords(id, nN, pm, pn);
    f32x4 acc[8][4]; zero_acc(acc);
    {
      const int idn = id + gridDim.x; int pm2 = 0, pn2 = 0; const bool hn = idn < nM * nN; if (hn) tile_coords(idn, nN, pm2, pn2);
      gemm_block<8, 4, 2, 4>(xn + (size_t)pm * 256 * D, D, wint + (size_t)pn * 256 * D, D, D, acc, smem, id != (int)blockIdx.x,
                             hn ? xn + (size_t)pm2 * 256 * D : nullptr, D, wint + (size_t)pn2 * 256 * D, D);
    }
#pragma unroll
    for (int m = 0; m < 8; ++m) {
      const size_t row = (size_t)pm * 256 + wr * 128 + m * 16 + fr;
#pragma unroll
      for (int n = 0; n < 4; ++n) {
        const f32x4 a = acc[m][n];
        *(uint2*)(z + row * ZC + pn * 256 + wc * 64 + n * 16 + fq * 4) = make_uint2(pack2(a[0], a[1]), pack2(a[2], a[3]));
      }
    }
  }
}

DI void phase_ya(const Params& p, int l, int L, const bf16_t* __restrict__ sg, const bf16_t* __restrict__ g2t, const bf16_t* __restrict__ z,
                 bf16_t* __restrict__ yf, const bf16_t* __restrict__ yb, const float* __restrict__ bon, unsigned char* smem) {
  const int tid_ = otid(), lane = tid_ & 63, w = tid_ >> 6, wr = w >> 2, wc = w & 3, fr = lane & 15, fq = lane >> 4;
  constexpr int nN = 2, nM = HT / 256;
  const float* mu0 = p.in[8] + (size_t)l * 2 * 1792;
  const float* mu1 = mu0 + 1792;
  const float* lng = p.in[17] + (size_t)l * CA;
  const float* lnb = p.in[18] + (size_t)l * CA;
  for (int id = blockIdx.x; id < nM * nN; id += gridDim.x) {
    int pm, pn; tile_coords(id, nN, pm, pn);
    f32x4 acc[8][4]; zero_acc(acc);
    {
      const int idn = id + gridDim.x; int pm2 = 0, pn2 = 0; const bool hn = idn < nM * nN; if (hn) tile_coords(idn, nN, pm2, pn2);
      gemm_block<8, 4, 2, 4>(sg + (size_t)pm * 256 * 128, 128, g2t + (size_t)pn * 256 * 128, 128, 128, acc, smem, id != (int)blockIdx.x,
                             hn ? sg + (size_t)pm2 * 256 * 128 : nullptr, 128, g2t + (size_t)pn2 * 256 * 128, 128);
    }
    const int h = pn * 4 + wc;
#pragma unroll
    for (int m = 0; m < 8; ++m) {
      const int row = pm * 256 + wr * 128 + m * 16 + fr;
      const int t = row % L;
      const bool hasp = t > 0, hasn = t < L - 1;
      float y[4][4];
      float s = 0.f;
#pragma unroll
      for (int n = 0; n < 4; ++n) {
        const int c = h * 64 + n * 16 + fq * 4;
        const uint2 a = *(const uint2*)(yf + (size_t)row * CA + c);
        const uint2 b = *(const uint2*)(yb + (size_t)row * CA + c);
        y[n][0] = lo2f(a.x) + lo2f(b.x); y[n][1] = hi2f(a.x) + hi2f(b.x); y[n][2] = lo2f(a.y) + lo2f(b.y); y[n][3] = hi2f(a.y) + hi2f(b.y);
        s += (y[n][0] + y[n][1]) + (y[n][2] + y[n][3]);
      }
      s = fq_sum(s);
      const float mean = s * (1.0f / 64.0f);
      float q = 0.f;
#pragma unroll
      for (int n = 0; n < 4; ++n)
#pragma unroll
        for (int j = 0; j < 4; ++j) { const float d = y[n][j] - mean; q += d * d; }
      q = fq_sum(q);
      const float rstd = rsqrtf(q * (1.0f / 64.0f) + 64e-5f);
      const float bsum = bon[(size_t)row * 8 + h] + bon[(size_t)HT * 8 + (size_t)row * 8 + h];
#pragma unroll
      for (int n = 0; n < 4; ++n) {
        const int c = h * 64 + n * 16 + fq * 4;
        const bf16_t* zr = z + (size_t)row * ZC + 1024 + c;
        const uint2 v0 = *(const uint2*)zr;
        uint2 vp = make_uint2(0u, 0u), vn = make_uint2(0u, 0u);
        if (hasp) vp = *(const uint2*)(zr - ZC);
        if (hasn) vn = *(const uint2*)(zr + ZC);
        const f32x4 m0 = *(const f32x4*)(mu0 + 1024 + c), m1 = *(const f32x4*)(mu1 + 1024 + c);
        const f32x4 gg = *(const f32x4*)(lng + c), bb = *(const f32x4*)(lnb + c);
        const float vc[4] = {lo2f(v0.x), hi2f(v0.x), lo2f(v0.y), hi2f(v0.y)};
        const float vpp[4] = {lo2f(vp.x), hi2f(vp.x), lo2f(vp.y), hi2f(vp.y)};
        const float vnn[4] = {lo2f(vn.x), hi2f(vn.x), lo2f(vn.y), hi2f(vn.y)};
        float o[4];
#pragma unroll
        for (int j = 0; j < 4; ++j) {
          const float vs = vc[j] + m0[j] * (vpp[j] - vc[j]) + m1[j] * (vnn[j] - vc[j]);
          o[j] = ((y[n][j] - mean) * rstd * gg[j] + bb[j] + bsum * vs) * acc[m][n][j];
        }
        *(uint2*)(yf + (size_t)row * CA + c) = make_uint2(pack2(o[0], o[1]), pack2(o[2], o[3]));
      }
    }
  }
}

DI void phase_merge(const bf16_t* __restrict__ xn, const bf16_t* __restrict__ Wl, const bf16_t* __restrict__ ya, const bf16_t* __restrict__ yn, const bf16_t* __restrict__ yd,
                    bf16_t* __restrict__ mo, unsigned char* smem) {
  const int tid_ = otid(), lane = tid_ & 63, w = tid_ >> 6, wr = w >> 1, wc = w & 1, fr = lane & 15, fq = lane >> 4;
  constexpr int nN = D / 128, nM = HT / 256;
  for (int id = blockIdx.x; id < nM * nN; id += gridDim.x) {
    int pm, pn; tile_coords(id, nN, pm, pn);
    unsigned tot[4][4][2];
#pragma unroll 1
    for (int i = 0; i < 3; ++i) {
      unsigned gp[4][4][2];
      {
        f32x4 ag[4][4]; zero_acc(ag);
        const bf16_t* Yn = (i == 0) ? ya : (i == 1 ? yn : yd);
        const int Kn = (i == 0) ? 512 : 256;
        const bf16_t* Pn = Wl + (i == 0 ? W_PA : (i == 1 ? W_PB : W_PC));
        gemm_block<4, 4, 4, 2>(xn + (size_t)pm * 256 * D, D, Wl + W_IN + (size_t)(ZC + i * 1024 + pn * 128) * D, D, D, ag, smem, !(i == 0 && id == (int)blockIdx.x),
                               Yn + (size_t)pm * 256 * Kn, Kn, Pn + (size_t)pn * 128 * Kn, Kn);
#pragma unroll
        for (int m = 0; m < 4; ++m)
#pragma unroll
          for (int n = 0; n < 4; ++n) {
            gp[m][n][0] = pack2(sigmoidf_(ag[m][n][0]), sigmoidf_(ag[m][n][1]));
            gp[m][n][1] = pack2(sigmoidf_(ag[m][n][2]), sigmoidf_(ag[m][n][3]));
          }
      }
      f32x4 ay[4][4]; zero_acc(ay);
      const bf16_t* Y = (i == 0) ? ya : (i == 1 ? yn : yd);
      const int Ki = (i == 0) ? 512 : 256;
      const bf16_t* P = Wl + (i == 0 ? W_PA : (i == 1 ? W_PB : W_PC));
      {
        const int idn = id + gridDim.x; int pm2 = pm, pn2 = pn, i2 = i + 1; bool hn = true;
        if (i == 2) { i2 = 0; hn = idn < nM * nN; if (hn) tile_coords(idn, nN, pm2, pn2); }
        gemm_block<4, 4, 4, 2>(Y + (size_t)pm * 256 * Ki, Ki, P + (size_t)pn * 128 * Ki, Ki, Ki, ay, smem, true,
                               hn ? xn + (size_t)pm2 * 256 * D : nullptr, D, Wl + W_IN + (size_t)(ZC + i2 * 1024 + pn2 * 128) * D, D);
      }
#pragma unroll
      for (int m = 0; m < 4; ++m)
#pragma unroll
        for (int n = 0; n < 4; ++n) {
          float t0 = ay[m][n][0] * lo2f(gp[m][n][0]), t1 = ay[m][n][1] * hi2f(gp[m][n][0]);
          float t2 = ay[m][n][2] * lo2f(gp[m][n][1]), t3 = ay[m][n][3] * hi2f(gp[m][n][1]);
          if (i > 0) { t0 += lo2f(tot[m][n][0]); t1 += hi2f(tot[m][n][0]); t2 += lo2f(tot[m][n][1]); t3 += hi2f(tot[m][n][1]); }
          tot[m][n][0] = pack2(t0, t1); tot[m][n][1] = pack2(t2, t3);
        }
    }
#pragma unroll
    for (int m = 0; m < 4; ++m) {
      const size_t row = (size_t)pm * 256 + wr * 64 + m * 16 + fr;
#pragma unroll
      for (int n = 0; n < 4; ++n)
        *(uint2*)(mo + row * D + pn * 128 + wc * 64 + n * 16 + fq * 4) = make_uint2(tot[m][n][0], tot[m][n][1]);
    }
  }
}

DI void item_sg(const Params& p, int l, int L, int item, const bf16_t* __restrict__ z, bf16_t* __restrict__ sg) {
  const int tid_ = otid() & 255, lane = tid_ & 63, w = tid_ >> 6;
  const float* mu0 = p.in[8] + (size_t)l * 2 * 1792 + 1664 + 2 * lane;
  const float* mu1 = mu0 + 1792;
  const float m0a = mu0[0], m0b = mu0[1], m1a = mu1[0], m1b = mu1[1];
  for (int i = w; i < 256; i += 4) {
    const int row = item * 256 + i;
    const int t = row % L;
    const bf16_t* zr = z + (size_t)row * ZC + 1664 + 2 * lane;
    const unsigned c = *(const unsigned*)zr;
    const unsigned pv = (t > 0) ? *(const unsigned*)(zr - ZC) : 0u;
    const unsigned nv = (t < L - 1) ? *(const unsigned*)(zr + ZC) : 0u;
    const float ca = lo2f(c), cb = hi2f(c);
    const float ga = ca + m0a * (lo2f(pv) - ca) + m1a * (lo2f(nv) - ca);
    const float gb = cb + m0b * (hi2f(pv) - cb) + m1b * (hi2f(nv) - cb);
    *(unsigned*)(sg + (size_t)row * 128 + 2 * lane) = pack2(sigmoidf_(ga), sigmoidf_(gb));
  }
}

DI void item_scan(const Params& p, int l, int L, int b, int h, int dir, const bf16_t* __restrict__ z, bf16_t* __restrict__ yout, float* __restrict__ bon, unsigned char* smem) {
  const int tid = otid() & 255, lane = tid & 63, w = tid >> 6, fr = lane & 15, fq = lane >> 4;
  unsigned* ZR = (unsigned*)smem;
  float* VR = (float*)(smem + 11520);
  float* VD = VR + 1024; float* VK = VD + 1024; float* VV = VK + 1024; float* VA = VV + 1024; float* VB = VA + 1024;
  float* YO = VB + 1024;
  float* BO = YO + 1024;
  unsigned char* WT = (unsigned char*)(BO + 16);
  unsigned char* AL = WT + 16 * RS;
  float* MU = (float*)(AL + 16 * RS);
  float* KKC = MU + 640;
  const size_t tok0 = (size_t)b * L;
  const float* mu0 = p.in[8] + (size_t)l * 2 * 1792;
  const float* mu1 = mu0 + 1792;
  const int cA = lane;
  __syncthreads();
  for (int i = tid; i < 640; i += 256) {
    const int s5 = i >> 7, d = (i >> 6) & 1, c = i & 63;
    const int col = (s5 < 3) ? (s5 * 512 + h * 64 + c) : (1536 + (s5 - 3) * 64 + c);
    MU[i] = (d ? mu1 : mu0)[col];
  }
  if (tid < 64) KKC[tid] = p.in[15][(size_t)l * CA + h * 64 + tid];
  const float rkc = p.in[14][((size_t)l * 2 + dir) * CA + h * 64 + cA];
  const int cB = w * 16 + fr;
  const float w0c = p.in[9][((size_t)l * 2 + dir) * CA + h * 64 + cB];
  const float a0c = p.in[11][((size_t)l * 2 + dir) * CA + h * 64 + cB];
  const float kac = p.in[13][((size_t)l * 2 + dir) * CA + h * 64 + cB];
  bf16x8 bw[2], ba[2];
  {
    const float* w2 = p.in[10] + ((size_t)l * 2 + dir) * 64 * CA + h * 64 + cB;
    const float* a2 = p.in[12] + ((size_t)l * 2 + dir) * 64 * CA + h * 64 + cB;
#pragma unroll
    for (int ks = 0; ks < 2; ++ks)
#pragma unroll
      for (int j = 0; j < 8; ++j) {
        bw[ks][j] = (short)f2bf(w2[(size_t)(ks * 32 + fq * 8 + j) * CA]);
        ba[ks][j] = (short)f2bf(a2[(size_t)(ks * 32 + fq * 8 + j) * CA]);
      }
  }
  const int kq = lane & 7, v0 = w * 16 + (lane >> 3) * 2;
  f32x2 S0[4], S1[4];
#pragma unroll
  for (int i = 0; i < 4; ++i) { S0[i] = (f32x2){0.f, 0.f}; S1[i] = (f32x2){0.f, 0.f}; }

  unsigned pf[12], poff[12];
  unsigned vbits = 0u, r0bits = 0u, r17bits = 0u, pf_ok = 0u;
#pragma unroll
  for (int i = 0; i < 12; ++i) {
    const int q = tid + i * 256;
    const int row = q / 160, pr = q - row * 160;
    const int col = (pr < 96) ? ((pr >> 5) * 512 + h * 64 + (pr & 31) * 2) : (1536 + (pr - 96) * 2);
    poff[i] = (q < 2880) ? (unsigned)(row * ZC + col) * 2u : 0u;
    if (q < 2880) vbits |= 1u << i;
    if (row == 0) r0bits |= 1u << i;
    if (row == 17) r17bits |= 1u << i;
  }
  auto prefetch = [&](int tc) {
    const char* zc = (const char*)(z + (tok0 + tc) * ZC) - (size_t)ZC * 2;
    pf_ok = vbits & ~((tc == 0) ? r0bits : 0u) & ~((tc == L - 16) ? r17bits : 0u);
#pragma unroll
    for (int i = 0; i < 12; ++i)
      pf[i] = *(const unsigned*)(zc + (((pf_ok >> i) & 1u) ? poff[i] : (unsigned)(ZC * 2)));
  };
  auto output = [&](int tco) {
    const int tt = tid >> 4, pj = tid & 15;
    const f32x2 ya = *(const f32x2*)(YO + tt * 64 + 2 * pj), yb2 = *(const f32x2*)(YO + tt * 64 + 32 + 2 * pj);
    bf16_t* yp = yout + (tok0 + tco + tt) * CA + h * 64 + 2 * pj;
    *(unsigned*)yp = pack2(ya[0], ya[1]);
    *(unsigned*)(yp + 32) = pack2(yb2[0], yb2[1]);
    if (tid < 16) bon[(tok0 + tco + tid) * 8 + h] = BO[tid];
  };
  const int nch = L / 16;
  prefetch(dir ? L - 16 : 0);
  int tc_prev = 0;
  for (int ci = 0; ci < nch; ++ci) {
    const int tc = dir ? (L - 16 - 16 * ci) : 16 * ci;
#pragma unroll
    for (int i = 0; i < 12; ++i) { const int q = tid + i * 256; if (q < 2880) ZR[q] = ((pf_ok >> i) & 1u) ? pf[i] : 0u; }
    __syncthreads();
    if (ci > 0) output(tc_prev);
    tc_prev = tc;
    if (ci + 1 < nch) prefetch(dir ? (tc - 16) : (tc + 16));
    {
      const int tt = tid >> 4, j = tid & 15;
      float kq2[4];
      float ksum = 0.f;
      unsigned zu[2][5][3];
      f32x2 mm[2][5][2];
#pragma unroll
      for (int hp = 0; hp < 2; ++hp)
#pragma unroll
        for (int s5 = 0; s5 < 5; ++s5) {
          const int pr = j + 16 * hp, pi = s5 * 32 + pr;
          zu[hp][s5][0] = ZR[tt * 160 + pi]; zu[hp][s5][1] = ZR[(tt + 1) * 160 + pi]; zu[hp][s5][2] = ZR[(tt + 2) * 160 + pi];
          mm[hp][s5][0] = *(const f32x2*)(MU + (s5 * 2) * 64 + 2 * pr); mm[hp][s5][1] = *(const f32x2*)(MU + (s5 * 2 + 1) * 64 + 2 * pr);
        }
#pragma unroll
      for (int hp = 0; hp < 2; ++hp) {
        const int pr = j + 16 * hp, c = 2 * pr;
        float zs[5][2];
#pragma unroll
        for (int s5 = 0; s5 < 5; ++s5) {
          const unsigned up = zu[hp][s5][0], uc = zu[hp][s5][1], un = zu[hp][s5][2];
          const f32x2 m0 = mm[hp][s5][0], m1 = mm[hp][s5][1];
          const float c0 = lo2f(uc), c1 = hi2f(uc);
          zs[s5][0] = c0 + m0[0] * (lo2f(up) - c0) + m1[0] * (lo2f(un) - c0);
          zs[s5][1] = c1 + m0[1] * (hi2f(up) - c1) + m1[1] * (hi2f(un) - c1);
        }
        *(f32x2*)(VR + tt * 64 + c) = (f32x2){zs[0][0], zs[0][1]};
        *(f32x2*)(VK + tt * 64 + c) = (f32x2){zs[1][0], zs[1][1]};
        *(f32x2*)(VV + tt * 64 + c) = (f32x2){zs[2][0], zs[2][1]};
        const f32x2 kc = *(const f32x2*)(KKC + c);
        kq2[2 * hp] = zs[1][0] * kc[0]; kq2[2 * hp + 1] = zs[1][1] * kc[1];
        ksum += kq2[2 * hp] * kq2[2 * hp] + kq2[2 * hp + 1] * kq2[2 * hp + 1];
        const float t0 = 1.0f - 2.0f * rcp_(__expf(2.0f * zs[3][0]) + 1.0f);
        const float t1 = 1.0f - 2.0f * rcp_(__expf(2.0f * zs[3][1]) + 1.0f);
        *(unsigned*)(WT + tt * RS + c * 2) = pack2(t0, t1);
        *(unsigned*)(AL + tt * RS + c * 2) = pack2(zs[4][0], zs[4][1]);
      }
      ksum = row_sum16(ksum);
      const float inv = rcp_(fmaxf(sqrtf(ksum), 1e-12f));
      *(f32x2*)(VA + tt * 64 + 2 * j) = (f32x2){kq2[0] * inv, kq2[1] * inv};
      *(f32x2*)(VA + tt * 64 + 2 * j + 32) = (f32x2){kq2[2] * inv, kq2[3] * inv};
    }
    __syncthreads();
    {
      f32x4 aw = {0.f, 0.f, 0.f, 0.f}, aa = {0.f, 0.f, 0.f, 0.f};
#pragma unroll
      for (int ks = 0; ks < 2; ++ks) {
        const bf16x8 fw = *(const bf16x8*)(WT + fr * RS + ks * 64 + fq * 16);
        const bf16x8 fa = *(const bf16x8*)(AL + fr * RS + ks * 64 + fq * 16);
        aw = MFMA16(fw, bw[ks], aw);
        aa = MFMA16(fa, ba[ks], aa);
      }
#pragma unroll
      for (int j = 0; j < 4; ++j) {
        const int tt = fq * 4 + j;
        const float x = w0c + aw[j];
        const float yv = -x;
        const float sp = fmaxf(yv, 0.f) + __logf(1.0f + __expf(-fabsf(yv)));
        const float e = __expf(-sp - 0.5f);
        const float dcy = __expf(-e);
        const float a = sigmoidf_(a0c + aa[j]);
        const float k = VK[tt * 64 + cB], kk = VA[tt * 64 + cB];
        VD[tt * 64 + cB] = dcy;
        VK[tt * 64 + cB] = k * (1.0f + (a - 1.0f) * kac);
        VA[tt * 64 + cB] = -kk;
        VB[tt * 64 + cB] = kk * a;
      }
    }
    __syncthreads();
    float pc[4];
#pragma unroll
    for (int i = 0; i < 4; ++i) { const int tt = w * 4 + i; pc[i] = VR[tt * 64 + cA] * VK[tt * 64 + cA] * rkc; }
#pragma unroll
    for (int i = 0; i < 4; ++i) {
      const int tt = w * 4 + i;
      const float s = wave_sum(pc[i]);
      if (lane == 0) BO[tt] = s;
    }
    {
      struct VA_ { f32x4 A0, A1; f32x2 V; };
      auto loada = [&](VA_& q, int off, int voff) {
        q.A0 = *(const f32x4*)(VA + off); q.A1 = *(const f32x4*)(VA + off + 4);
        q.V = *(const f32x2*)(VV + voff);
      };
      auto stepf = [&](const VA_& c, VA_& nx, int off, int voff, int offn, int voffn, bool has_next) {
        const f32x4 D0 = *(const f32x4*)(VD + off), D1 = *(const f32x4*)(VD + off + 4);
        const f32x4 B0 = *(const f32x4*)(VB + off), B1 = *(const f32x4*)(VB + off + 4);
        const f32x4 K0 = *(const f32x4*)(VK + off), K1 = *(const f32x4*)(VK + off + 4);
        const f32x4 R0 = *(const f32x4*)(VR + off), R1 = *(const f32x4*)(VR + off + 4);
        if (has_next) loada(nx, offn, voffn);
        const f32x2 a[4] = {{c.A0[0], c.A0[1]}, {c.A0[2], c.A0[3]}, {c.A1[0], c.A1[1]}, {c.A1[2], c.A1[3]}};
        const f32x2 d[4] = {{D0[0], D0[1]}, {D0[2], D0[3]}, {D1[0], D1[1]}, {D1[2], D1[3]}};
        const f32x2 bb[4] = {{B0[0], B0[1]}, {B0[2], B0[3]}, {B1[0], B1[1]}, {B1[2], B1[3]}};
        const f32x2 kk[4] = {{K0[0], K0[1]}, {K0[2], K0[3]}, {K1[0], K1[1]}, {K1[2], K1[3]}};
        const f32x2 rr[4] = {{R0[0], R0[1]}, {R0[2], R0[3]}, {R1[0], R1[1]}, {R1[2], R1[3]}};
        const f32x2 p0 = (S0[0] * a[0] + S0[1] * a[1]) + (S0[2] * a[2] + S0[3] * a[3]);
        const f32x2 p1 = (S1[0] * a[0] + S1[1] * a[1]) + (S1[2] * a[2] + S1[3] * a[3]);
        const float sa0 = oct_sum(p0[0] + p0[1]);
        const float sa1 = oct_sum(p1[0] + p1[1]);
        f32x2 y0a = {0.f, 0.f}, y0b = {0.f, 0.f}, y1a = {0.f, 0.f}, y1b = {0.f, 0.f};
#pragma unroll
        for (int i = 0; i < 4; ++i) {
          const f32x2 n0 = S0[i] * d[i] + (sa0 * bb[i] + c.V[0] * kk[i]);
          const f32x2 n1 = S1[i] * d[i] + (sa1 * bb[i] + c.V[1] * kk[i]);
          S0[i] = n0; S1[i] = n1;
          if (i & 1) { y0b += n0 * rr[i]; y1b += n1 * rr[i]; } else { y0a += n0 * rr[i]; y1a += n1 * rr[i]; }
        }
        const f32x2 y0 = y0a + y0b, y1 = y1a + y1b;
        const float ys0 = oct_sum(y0[0] + y0[1]), ys1 = oct_sum(y1[0] + y1[1]);
        *(f32x2*)(YO + voff) = (f32x2){ys0, ys1};
      };
      const int dstep = dir ? -64 : 64;
      int off = (dir ? 15 * 64 : 0) + kq * 8, voff = (dir ? 15 * 64 : 0) + v0;
      VA_ X, Y;
      loada(X, off, voff);
#pragma unroll 1
      for (int it2 = 0; it2 < 8; ++it2) {
        stepf(X, Y, off, voff, off + dstep, voff + dstep, true);
        stepf(Y, X, off + dstep, voff + dstep, off + 2 * dstep, voff + 2 * dstep, it2 < 7);
        off += 2 * dstep; voff += 2 * dstep;
      }
    }
  }
  __syncthreads();
  output(tc_prev);
  __syncthreads();
}

template <int MODE>
DI void item_attn(const Params& p, int l, int L, int b, int h, int qi, const bf16_t* __restrict__ z, bf16_t* __restrict__ yo, unsigned char* smem, unsigned char* smc) {
  const int tid = otid() & 255, lane = tid & 63, w = tid >> 6, fr = lane & 15, fq = lane >> 4;
  unsigned char* KV0 = (MODE == 1) ? smc : smem;
  constexpr int NLD = (MODE == 1) ? 1 : 2;
  const int t5 = (MODE == 1) ? (tid + (int)(smem - smc) / 256) : tid;
  const int vkey = (MODE == 1) ? (t5 & 63) : lane, vdc0 = (MODE == 1) ? (t5 >> 6) : 2 * w;
  float* RPB = (float*)(smem + 256 * RS);
  const size_t tok0 = (size_t)b * L;
  const int rows = L / 64;
  const int qcol = (MODE == 0 ? 1792 : 2560) + h * 64, kcol = qcol + 256, vcol = qcol + 512;
  const int ntile = (MODE == 0) ? 8 : rows;
  int rs = 0;
  if (MODE == 0) { rs = qi - 4; rs = rs < 0 ? 0 : (rs > rows - 8 ? rows - 8 : rs); }
  const int qc = w * 16 + fr;
  const size_t qtok = tok0 + (size_t)qi * 64 + qc;
  bf16x8 qf[2];
#pragma unroll
  for (int ks = 0; ks < 2; ++ks) qf[ks] = *(const bf16x8*)(z + qtok * ZC + qcol + ks * 32 + fq * 8);
  float lam = 0.f, lam_init = 0.f;
  if (MODE == 0) {
    __syncthreads();
    const float* rp = p.in[19] + ((size_t)l * 4 + h) * 465;
    for (int i = tid; i < 465; i += 256) RPB[i] = rp[i];
  } else {
    const float* lp = p.in[20] + (size_t)l * 128;
    float v1 = 0.f, v2 = 0.f;
    if (lane < 32) { v1 = lp[lane] * lp[32 + lane]; v2 = lp[64 + lane] * lp[96 + lane]; }
    v1 = wave_sum(v1); v2 = wave_sum(v2);
    lam_init = 0.8f - 0.6f * __expf(-0.3f * (float)l);
    lam = __expf(v1) - __expf(v2) + lam_init;
  }
  u32x4 rk[NLD], rv[NLD];
  auto load_tile = [&](int it) {
    const size_t kt0 = tok0 + (size_t)((MODE == 0) ? (rs + it) : it) * 64;
#pragma unroll
    for (int i = 0; i < NLD; ++i) {
      const int q = t5 + i * 256;
      rk[i] = *(const u32x4*)(z + (kt0 + (q >> 3)) * ZC + kcol + (q & 7) * 8);
      rv[i] = *(const u32x4*)(z + (kt0 + vkey) * ZC + vcol + (vdc0 + i) * 8);
    }
  };
  auto store_tile = [&](int buf) {
    unsigned char* KSw = KV0 + buf * (128 * RS);
    unsigned char* VTw = KSw + 64 * RS;
#pragma unroll
    for (int i = 0; i < NLD; ++i) {
      const int q = t5 + i * 256;
      *(u32x4*)(KSw + (q >> 3) * RS + (q & 7) * 16) = rk[i];
#pragma unroll
      for (int e = 0; e < 8; ++e) {
        const unsigned vwd = rv[i][e >> 1];
        const bf16_t val = (bf16_t)((e & 1) ? (vwd >> 16) : (vwd & 0xffffu));
        *(bf16_t*)(VTw + ((vdc0 + i) * 8 + e) * RS + vkey * 2) = val;
      }
    }
  };
  load_tile(0);
  store_tile(0);
  if (ntile > 1) load_tile(1);
  constexpr int NS = (MODE == 0) ? 1 : 2;
  f32x4 o[NS][4];
  float mrun[NS], lrun[NS];
#pragma unroll
  for (int s = 0; s < NS; ++s) { mrun[s] = -1e30f; lrun[s] = 0.f;
#pragma unroll
    for (int dt = 0; dt < 4; ++dt) o[s][dt] = (f32x4){0.f, 0.f, 0.f, 0.f}; }
  const float slope2 = (MODE == 1) ? exp2f(-2.0f * (float)(h + 1)) * LOG2E : 0.f;
  const float sc2 = (MODE == 0) ? 0.125f * LOG2E : 0.17677669529663687f * LOG2E;
  const int qpos = qi * 64 + qc;
  const float dbase = (float)(fq * 4 - qpos);
  int cs = qc - 8; cs = cs < 0 ? 0 : (cs > 48 ? 48 : cs);
  for (int it = 0; it < ntile; ++it) {
    __syncthreads();
    if (it + 1 < ntile) store_tile((it + 1) & 1);
    if (it + 2 < ntile) load_tile(it + 2);
    const unsigned char* KS = KV0 + (it & 1) * (128 * RS);
    const unsigned char* VT = KS + 64 * RS;
    f32x4 s[NS][4];
#pragma unroll
    for (int kt = 0; kt < 4; ++kt) {
      const bf16x8 k0 = *(const bf16x8*)(KS + (kt * 16 + fr) * RS + fq * 16);
      const bf16x8 k1 = *(const bf16x8*)(KS + (kt * 16 + fr) * RS + 64 + fq * 16);
      const f32x4 zf = {0.f, 0.f, 0.f, 0.f};
      if (MODE == 0) { s[0][kt] = MFMA16(k0, qf[0], zf); s[0][kt] = MFMA16(k1, qf[1], s[0][kt]); }
      else { s[0][kt] = MFMA16(k0, qf[0], zf); s[NS - 1][kt] = MFMA16(k1, qf[1], zf); }
    }
    float alpha[NS];
    float mx[NS];
#pragma unroll
    for (int sh = 0; sh < NS; ++sh) mx[sh] = -1e30f;
    if (MODE == 0) {
#pragma unroll
      for (int kt = 0; kt < 4; ++kt)
#pragma unroll
        for (int j = 0; j < 4; ++j) {
          const int kj = kt * 16 + fq * 4 + j;
          const bool valid = (kj >= cs) && (kj < cs + 16);
          int dc = kj - qc + 15; dc = dc < 0 ? 0 : (dc > 30 ? 30 : dc);
          const int dr = rs + it - qi + 7;
          const float t2 = valid ? (s[0][kt][j] * sc2 + RPB[dr * 31 + dc] * LOG2E) : -1e30f;
          s[0][kt][j] = t2;
          mx[0] = fmaxf(mx[0], t2);
        }
    } else {
      const float d0 = dbase + (float)(it * 64);
#pragma unroll
      for (int kt = 0; kt < 4; ++kt)
#pragma unroll
        for (int j = 0; j < 4; ++j) {
          const float ad = slope2 * fabsf(d0 + (float)(kt * 16 + j));
#pragma unroll
          for (int sh = 0; sh < NS; ++sh) {
            const float t2 = s[sh][kt][j] * sc2 - ad;
            s[sh][kt][j] = t2;
            mx[sh] = fmaxf(mx[sh], t2);
          }
        }
    }
#pragma unroll
    for (int sh = 0; sh < NS; ++sh) {
      float m1 = mx[sh];
      m1 = fq_max(m1);
      const float mn = fmaxf(mrun[sh], m1);
      alpha[sh] = __builtin_amdgcn_exp2f(mrun[sh] - mn);
      mrun[sh] = mn;
      float ps = 0.f;
#pragma unroll
      for (int kt = 0; kt < 4; ++kt)
#pragma unroll
        for (int j = 0; j < 4; ++j) { const float pe = __builtin_amdgcn_exp2f(s[sh][kt][j] - mn); s[sh][kt][j] = pe; ps += pe; }
      lrun[sh] = lrun[sh] * alpha[sh] + ps;
#pragma unroll
      for (int dt = 0; dt < 4; ++dt) o[sh][dt] = o[sh][dt] * alpha[sh];
    }
#pragma unroll
    for (int i2 = 0; i2 < 2; ++i2) {
      bf16x8 pfr[NS];
#pragma unroll
      for (int sh = 0; sh < NS; ++sh) {
        const unsigned u0 = pack2(s[sh][2 * i2][0], s[sh][2 * i2][1]), u1 = pack2(s[sh][2 * i2][2], s[sh][2 * i2][3]);
        const unsigned u2 = pack2(s[sh][2 * i2 + 1][0], s[sh][2 * i2 + 1][1]), u3 = pack2(s[sh][2 * i2 + 1][2], s[sh][2 * i2 + 1][3]);
        const u32x4 u = {u0, u1, u2, u3};
        pfr[sh] = __builtin_bit_cast(bf16x8, u);
      }
#pragma unroll
      for (int dt = 0; dt < 4; ++dt) {
        const u32x2 va = *(const u32x2*)(VT + (dt * 16 + fr) * RS + (32 * i2 + fq * 4) * 2);
        const u32x2 vb = *(const u32x2*)(VT + (dt * 16 + fr) * RS + (32 * i2 + 16 + fq * 4) * 2);
        const u32x4 vu = {va[0], va[1], vb[0], vb[1]};
        const bf16x8 vf = __builtin_bit_cast(bf16x8, vu);
#pragma unroll
        for (int sh = 0; sh < NS; ++sh) o[sh][dt] = MFMA16(vf, pfr[sh], o[sh][dt]);
      }
    }
  }
  float linv[NS];
#pragma unroll
  for (int sh = 0; sh < NS; ++sh) { float lt = lrun[sh]; lt = fq_sum(lt); linv[sh] = rcp_(lt); }
  if (MODE == 0) {
#pragma unroll
    for (int dt = 0; dt < 4; ++dt) {
      const f32x4 r = o[0][dt] * linv[0];
      *(uint2*)(yo + qtok * 256 + h * 64 + dt * 16 + fq * 4) = make_uint2(pack2(r[0], r[1]), pack2(r[2], r[3]));
    }
  } else {
    f32x4 r[4];
    float ss = 0.f;
#pragma unroll
    for (int dt = 0; dt < 4; ++dt) {
      r[dt] = o[0][dt] * linv[0] - lam * (o[NS - 1][dt] * linv[NS - 1]);
      ss += r[dt][0] * r[dt][0] + r[dt][1] * r[dt][1] + r[dt][2] * r[dt][2] + r[dt][3] * r[dt][3];
    }
    ss = fq_sum(ss);
    const float rn = rsqrtf(ss * (1.0f / 64.0f) + 1e-5f) * (1.0f - lam_init);
    const float* sg = p.in[21] + (size_t)l * 64;
#pragma unroll
    for (int dt = 0; dt < 4; ++dt) {
      const f32x4 g = *(const f32x4*)(sg + dt * 16 + fq * 4);
      const f32x4 q = r[dt] * rn * g;
      *(uint2*)(yo + qtok * 256 + h * 64 + dt * 16 + fq * 4) = make_uint2(pack2(q[0], q[1]), pack2(q[2], q[3]));
    }
  }
}

DI void phase_mixers(const Params& p, int l, int half, unsigned* counter, unsigned char* smem) {
  const int L = half ? 2048 : 4096, nseq = HT / L, rows = L / 64;
  const bf16_t* z = (const bf16_t*)(p.ws + WS_Z);
  bf16_t* yf = (bf16_t*)(p.ws + WS_YF);
  bf16_t* yb = (bf16_t*)(p.ws + WS_YB);
  bf16_t* yn = (bf16_t*)(p.ws + WS_YN);
  bf16_t* yd = (bf16_t*)(p.ws + WS_YD);
  bf16_t* sg = (bf16_t*)(p.ws + WS_SG);
  float* bon = (float*)(p.ws + WS_BON);
  const int n_scan = nseq * 16, n_diff = nseq * 4 * rows, n_na = nseq * rows * 4, n_sg = HT / 256;
  const int total = n_scan + n_diff + n_na + n_sg;
  const int hf = __builtin_amdgcn_readfirstlane(otid() >> 8);
  unsigned char* sm = smem + hf * 65536;
  __shared__ int s_item;
  for (;;) {
    __syncthreads();
    if (threadIdx.x == 0) s_item = (int)atomicAdd(counter, 1u);
    __syncthreads();
    int it = 2 * s_item + hf;
    if (it >= total) break;
    if (it < n_scan) {
      const int dir = it & 1, h = (it >> 1) & 7, b = it >> 4;
      item_scan(p, l, L, b, h, dir, z, dir ? yb : yf, bon + (size_t)dir * HT * 8, sm);
      continue;
    }
    it -= n_scan;
    if (it < n_diff) {
      const int qb = it % rows, h = (it / rows) & 3, b = it / (rows * 4);
      item_attn<1>(p, l, L, b, h, qb, z, yd, sm, smem);
      continue;
    }
    it -= n_diff;
    if (it < n_na) {
      const int r = it % rows, h = (it / rows) & 3, b = it / (rows * 4);
      item_attn<0>(p, l, L, b, h, r, z, yn, sm, smem);
      continue;
    }
    it -= n_na;
    item_sg(p, l, L, it, z, sg);
  }
}

__global__ void __launch_bounds__(512, 2) fwd_megakernel(Params p) {
  cg::grid_group grid = cg::this_grid();
  __shared__ __attribute__((aligned(16))) unsigned char smem[131072];
  bf16_t* W = (bf16_t*)(p.ws + WS_W);
  bf16_t* xn = (bf16_t*)(p.ws + WS_XN);
  bf16_t* hid = (bf16_t*)(p.ws + WS_HID);
  bf16_t* z = (bf16_t*)(p.ws + WS_Z);
  bf16_t* mo = (bf16_t*)(p.ws + WS_M);
  unsigned* ctl = (unsigned*)(p.ws + WS_CTL);

  phase_convert(p, smem);
  grid.sync();
  for (int half = 0; half < 2; ++half) {
    const float* xin = p.in[half];
    float* x = p.out + (size_t)half * HT * D;
    const int L = half ? 2048 : 4096;
    for (int l = 0; l < NLAYER; ++l) {
      const bf16_t* Wl = W + (size_t)l * W_LAYER;
      const float* xsrc = (l == 0) ? xin : x;
      phase_norm(xsrc, p.in[2] + (size_t)l * D, xn, nullptr);
      grid.sync();
      phase_ffn_up(xn, Wl + W_GU, hid, smem);
      grid.sync();
      phase_gemm_resid(hid, DFF, Wl + W_WD, xsrc, x, 0.5f, smem);
      grid.sync();
      phase_norm(x, p.in[6] + (size_t)l * D, xn, nullptr);
      grid.sync();
      phase_proj(xn, Wl + W_IN, z, smem);
      grid.sync();
      phase_mixers(p, l, half, ctl + (half * NLAYER + l) * 16, smem);
      grid.sync();
      phase_ya(p, l, L, (const bf16_t*)(p.ws + WS_SG), Wl + W_G2, z, (bf16_t*)(p.ws + WS_YF), (const bf16_t*)(p.ws + WS_YB), (const float*)(p.ws + WS_BON), smem);
      grid.sync();
      phase_merge(xn, Wl, (const bf16_t*)(p.ws + WS_YF), (const bf16_t*)(p.ws + WS_YN), (const bf16_t*)(p.ws + WS_YD), mo, smem);
      grid.sync();
      phase_gemm_resid(mo, D, Wl + W_OUT, x, x, 1.0f, smem);
      grid.sync();
      phase_norm(x, p.in[26] + (size_t)l * D, xn, nullptr);
      grid.sync();
      phase_ffn_up(xn, Wl + W_GU2, hid, smem);
      grid.sync();
      phase_gemm_resid(hid, DFF, Wl + W_WD2, x, x, 0.5f, smem);
      grid.sync();
    }
    phase_norm(x, p.in[30], nullptr, x);
    grid.sync();
  }
}

extern "C" void kernel_launch(void* const* d_in, const int* in_sizes, int n_in, void* d_out, int out_size, void* d_ws, size_t ws_size, hipStream_t stream) {
  static int grid_blocks = 0;
  if (!grid_blocks) {
    int dev = 0, cus = 0, per_cu = 0;
    (void)hipGetDevice(&dev);
    (void)hipDeviceGetAttribute(&cus, hipDeviceAttributeMultiprocessorCount, dev);
    (void)hipOccupancyMaxActiveBlocksPerMultiprocessor(&per_cu, fwd_megakernel, 512, 0);
    if (per_cu < 1) per_cu = 1;
    if (per_cu > 1) per_cu = 1;
    grid_blocks = cus * per_cu;
    if (ws_size < WS_END) fprintf(stderr, "kernel_launch: workspace too small: need %zu have %zu\n", (size_t)WS_END, ws_size);
  }
  (void)hipMemsetAsync((char*)d_ws + WS_CTL, 0, 4096, stream);
  Params p{};
  for (int i = 0; i < 31; ++i) p.in[i] = (const float*)d_in[i];
  p.out = (float*)d_out;
  p.ws = (unsigned char*)d_ws;
  void* args[] = {&p};
  hipError_t e = hipLaunchCooperativeKernel((void*)fwd_megakernel, dim3(grid_blocks), dim3(512), args, 0, stream);
  if (e != hipSuccess) fprintf(stderr, "cooperative launch failed: %s (grid %d)\n", hipGetErrorString(e), grid_blocks);
}
```

```cpp
#include <hip/hip_runtime.h>
#include <hip/hip_cooperative_groups.h>
#include <cstdio>
#include <cstdint>
namespace cg = cooperative_groups;

typedef unsigned short bf16_t;
typedef short bf16x8 __attribute__((ext_vector_type(8)));
typedef short s16x4 __attribute__((ext_vector_type(4)));
typedef float f32x4 __attribute__((ext_vector_type(4)));
typedef float f32x2 __attribute__((ext_vector_type(2)));
typedef unsigned u32x4 __attribute__((ext_vector_type(4)));
typedef unsigned u32x2 __attribute__((ext_vector_type(2)));
#define DI __device__ __forceinline__
#define MFMA16(a, b, c) __builtin_amdgcn_mfma_f32_16x16x32_bf16((a), (b), (c), 0, 0, 0)

constexpr int D = 1024, DFF = 2816, HT = 65536  , NLAYER = 2;
constexpr int ZC = 3328;
constexpr int INC = 6400;
constexpr int CA = 512;
constexpr float LOG2E = 1.4426950408889634f;

constexpr size_t WS_CTL = 0;
constexpr size_t WS_BAR = 4096;
constexpr size_t WS_CTL_BYTES = 32768;
constexpr size_t WS_W = WS_CTL_BYTES;
constexpr size_t W_GU = 0;
constexpr size_t W_WD = W_GU + (size_t)2 * DFF * D;
constexpr size_t W_GU2 = W_WD + (size_t)D * DFF;
constexpr size_t W_WD2 = W_GU2 + (size_t)2 * DFF * D;
constexpr size_t W_IN = W_WD2 + (size_t)D * DFF;
constexpr size_t W_PA = W_IN + (size_t)INC * D;
constexpr size_t W_PB = W_PA + (size_t)D * 512;
constexpr size_t W_PC = W_PB + (size_t)D * 256;
constexpr size_t W_OUT = W_PC + (size_t)D * 256;
constexpr size_t W_G2 = W_OUT + (size_t)D * D;
constexpr size_t W_LAYER = W_G2 + (size_t)512 * 128;
constexpr size_t WS_XN = WS_W + 2 * W_LAYER * 2;
constexpr size_t WS_R = WS_XN + (size_t)HT * D * 2;
constexpr size_t WS_HID = WS_R;
constexpr size_t WS_Z = WS_R;
constexpr size_t WS_M = WS_R;
constexpr size_t WS_YF = WS_Z + (size_t)HT * ZC * 2;
constexpr size_t WS_YB = WS_YF + (size_t)HT * 512 * 2;
constexpr size_t WS_YN = WS_YB + (size_t)HT * 512 * 2;
constexpr size_t WS_YD = WS_YN + (size_t)HT * 256 * 2;
constexpr size_t WS_SG = WS_YD + (size_t)HT * 256 * 2;
constexpr size_t WS_BON = WS_SG + (size_t)HT * 128 * 2;
constexpr size_t WS_END = WS_BON + (size_t)2 * HT * 8 * 4;

struct Params {
  const float* in[31];
  float* out;
  unsigned char* ws;
};

typedef __bf16 bf16x2_t __attribute__((ext_vector_type(2)));
DI unsigned pack2(float lo, float hi) { const f32x2 v = {lo, hi}; const bf16x2_t b = __builtin_convertvector(v, bf16x2_t); return __builtin_bit_cast(unsigned, b); }
DI bf16_t f2bf(float x) { return (bf16_t)(pack2(x, x) & 0xffffu); }
DI float bf2f(bf16_t h) { return __uint_as_float(((unsigned)h) << 16); }
DI float lo2f(unsigned u) { return __uint_as_float(u << 16); }
DI float hi2f(unsigned u) { return __uint_as_float(u & 0xffff0000u); }
DI float xor16_sum(float v) { const auto r = __builtin_amdgcn_permlane16_swap(__float_as_uint(v), __float_as_uint(v), false, false); return __uint_as_float(r[0]) + __uint_as_float(r[1]); }
DI float xor32_sum(float v) { const auto r = __builtin_amdgcn_permlane32_swap(__float_as_uint(v), __float_as_uint(v), false, false); return __uint_as_float(r[0]) + __uint_as_float(r[1]); }
DI float xor16_max(float v) { const auto r = __builtin_amdgcn_permlane16_swap(__float_as_uint(v), __float_as_uint(v), false, false); return fmaxf(__uint_as_float(r[0]), __uint_as_float(r[1])); }
DI float xor32_max(float v) { const auto r = __builtin_amdgcn_permlane32_swap(__float_as_uint(v), __float_as_uint(v), false, false); return fmaxf(__uint_as_float(r[0]), __uint_as_float(r[1])); }
DI float fq_sum(float v) { return xor32_sum(xor16_sum(v)); }
DI float fq_max(float v) { return xor32_max(xor16_max(v)); }
DI float quad_sum(float v) {
  int t = __builtin_amdgcn_update_dpp(0, __float_as_int(v), 0xB1, 0xF, 0xF, true);
  v += __int_as_float(t);
  t = __builtin_amdgcn_update_dpp(0, __float_as_int(v), 0x4E, 0xF, 0xF, true);
  v += __int_as_float(t);
  return v;
}
DI float oct_sum(float v) {
  v = quad_sum(v);
  const int t = __builtin_amdgcn_update_dpp(0, __float_as_int(v), 0x141, 0xF, 0xF, true);
  return v + __int_as_float(t);
}
DI float row_sum16(float v) {
  v = oct_sum(v);
  const int t = __builtin_amdgcn_update_dpp(0, __float_as_int(v), 0x140, 0xF, 0xF, true);
  return v + __int_as_float(t);
}
DI float wave_sum(float v) { return fq_sum(row_sum16(v)); }
DI int otid() { int t = threadIdx.x; asm volatile("" : "+v"(t)); return t; }
DI float rcp_(float x) { return __builtin_amdgcn_rcpf(x); }
DI float sigmoidf_(float x) { return rcp_(1.0f + __expf(-x)); }

DI void convert_job(const float* __restrict__ src, int K, int N, bf16_t* __restrict__ dst, int mode, float* tile  ) {
  const int tid = otid();
  const int ntk = K / 64, ntn = N / 64, nt = ntk * ntn;
  for (int t = blockIdx.x; t < nt; t += gridDim.x) {
    const int tk = t / ntn, tn = t % ntn;
    const int k0 = tk * 64, n0 = tn * 64;
    __syncthreads();
#pragma unroll
    for (int i = 0; i < 8; ++i) {
      const int kk = (tid >> 6) + i * 8, nn = tid & 63;
      tile[kk * 65 + nn] = src[(size_t)(k0 + kk) * N + n0 + nn];
    }
    __syncthreads();
    const int nn = tid >> 3, kc = (tid & 7) * 8;
    const int n = n0 + nn;
    int row = n;
    if (mode == 1) row = (n >> 5) * 64 + (n & 31);
    else if (mode == 2) row = (n >> 5) * 64 + 32 + (n & 31);
    u32x4 pk;
#pragma unroll
    for (int i = 0; i < 4; ++i) pk[i] = pack2(tile[(kc + 2 * i) * 65 + nn], tile[(kc + 2 * i + 1) * 65 + nn]);
    *(u32x4*)(dst + (size_t)row * K + k0 + kc) = pk;
  }
}

DI void phase_convert(const Params& p, unsigned char* smem) {
  float* tile = (float*)smem;
  bf16_t* W = (bf16_t*)(p.ws + WS_W);
  for (int l = 0; l < NLAYER; ++l) {
    bf16_t* Wl = W + (size_t)l * W_LAYER;
    convert_job(p.in[3] + (size_t)l * D * DFF, D, DFF, Wl + W_GU, 1, tile);
    convert_job(p.in[4] + (size_t)l * D * DFF, D, DFF, Wl + W_GU, 2, tile);
    convert_job(p.in[5] + (size_t)l * DFF * D, DFF, D, Wl + W_WD, 0, tile);
    convert_job(p.in[27] + (size_t)l * D * DFF, D, DFF, Wl + W_GU2, 1, tile);
    convert_job(p.in[28] + (size_t)l * D * DFF, D, DFF, Wl + W_GU2, 2, tile);
    convert_job(p.in[29] + (size_t)l * DFF * D, DFF, D, Wl + W_WD2, 0, tile);
    convert_job(p.in[7] + (size_t)l * D * INC, D, INC, Wl + W_IN, 0, tile);
    convert_job(p.in[22] + (size_t)l * 512 * D, 512, D, Wl + W_PA, 0, tile);
    convert_job(p.in[23] + (size_t)l * 256 * D, 256, D, Wl + W_PB, 0, tile);
    convert_job(p.in[24] + (size_t)l * 256 * D, 256, D, Wl + W_PC, 0, tile);
    convert_job(p.in[25] + (size_t)l * D * D, D, D, Wl + W_OUT, 0, tile);
    convert_job(p.in[16] + (size_t)l * 128 * 512, 128, 512, Wl + W_G2, 0, tile);
  }
}

DI void phase_norm(const float* __restrict__ src, const float* __restrict__ gam, bf16_t* __restrict__ xn, float* __restrict__ fout) {
  const int tid_ = otid(), lane = tid_ & 63, w = tid_ >> 6;
  f32x4 g[4];
#pragma unroll
  for (int i = 0; i < 4; ++i) g[i] = *(const f32x4*)(gam + i * 256 + lane * 4);
  const int stride = gridDim.x * 8;
  auto ld = [&](f32x4 (&v)[4], int row) {
    if (row < HT) {
#pragma unroll
      for (int i = 0; i < 4; ++i) v[i] = *(const f32x4*)(src + (size_t)row * D + i * 256 + lane * 4);
    }
  };
  auto proc = [&](const f32x4 (&v)[4], int row) {
    float ss = 0.f;
#pragma unroll
    for (int i = 0; i < 4; ++i) ss += (v[i][0] * v[i][0] + v[i][1] * v[i][1]) + (v[i][2] * v[i][2] + v[i][3] * v[i][3]);
    ss = wave_sum(ss);
    const float rs = rsqrtf(ss * (1.0f / 1024.0f) + 1e-6f);
#pragma unroll
    for (int i = 0; i < 4; ++i) {
      const f32x4 y = v[i] * rs * g[i];
      if (fout) *(f32x4*)(fout + (size_t)row * D + i * 256 + lane * 4) = y;
      else *(uint2*)(xn + (size_t)row * D + i * 256 + lane * 4) = make_uint2(pack2(y[0], y[1]), pack2(y[2], y[3]));
    }
  };
  int t = blockIdx.x * 8 + w;
  f32x4 a[4], b[4];
  ld(a, t); ld(b, t + stride);
  for (; t < HT; t += 2 * stride) {
    f32x4 na[4], nb[4];
    ld(na, t + 2 * stride); ld(nb, t + 3 * stride);
    proc(a, t);
    if (t + stride < HT) proc(b, t + stride);
#pragma unroll
    for (int i = 0; i < 4; ++i) { a[i] = na[i]; b[i] = nb[i]; }
  }
}

constexpr int RS = 144;
typedef __attribute__((address_space(3))) unsigned lds_u32;
DI void glds16(const void* g, unsigned char* l) { __builtin_amdgcn_global_load_lds((const unsigned*)g, (lds_u32*)l, 16, 0, 0); }
template <int N> DI void wait_vm() { asm volatile("s_waitcnt vmcnt(%0)" :: "n"(N) : "memory"); }
template <int MT, int NT, int WR, int WC>
DI void gemm_block(const bf16_t* __restrict__ A, int lda, const bf16_t* __restrict__ B, int ldb, int K, f32x4 (&acc)[MT][NT], unsigned char* smem,
                   bool primed = false, const bf16_t* __restrict__ nA = nullptr, int nlda = 0, const bf16_t* __restrict__ nB = nullptr, int nldb = 0) {
  static_assert(WR * WC == 8, "8 waves");
  constexpr int AR = 16 * MT * WR, BR = 16 * NT * WC;
  constexpr int AB = AR * 128, BB = BR * 128, STG = AB + BB;
  constexpr int NA = AR * 8 / 512, NB = BR * 8 / 512;
  const int tid = otid(), lane = tid & 63, w = tid >> 6, wr = w / WC, wc = w % WC, fr = lane & 15, fq = lane >> 4;
  const int srow = tid >> 3, kch = (tid & 7) ^ ((tid >> 4) & 7);
  const unsigned voA = (unsigned)(srow * lda + kch * 8) * 2u, voB = (unsigned)(srow * ldb + kch * 8) * 2u;
  const char* Ab = (const char*)A;
  const char* Bb = (const char*)B;
  const int nk = K >> 6;
  if (!primed) {
#pragma unroll
    for (int i = 0; i < NA; ++i) glds16(Ab + (size_t)i * 128 * lda + voA, smem + (i * 512 + tid) * 16);
#pragma unroll
    for (int i = 0; i < NB; ++i) glds16(Bb + (size_t)i * 128 * ldb + voB, smem + AB + (i * 512 + tid) * 16);
  }
  const int sw = (fr >> 1) & 7;
  const unsigned lds_base = (unsigned)(size_t)(__attribute__((address_space(3))) unsigned char*)smem;
  const unsigned a_row = (wr * 16 * MT + fr) * 128, b_row = AB + (wc * 16 * NT + fr) * 128;
  for (int kt = 0; kt < nk; ++kt) {
    wait_vm<0>();
    __builtin_amdgcn_s_barrier();
    if (kt + 1 < nk) {
      unsigned char* sn = smem + ((kt + 1) & 1) * STG;
      const int ko = (kt + 1) * 64;
#pragma unroll
      for (int i = 0; i < NA; ++i) glds16(Ab + ((size_t)i * 128 * lda + ko * 2) + voA, sn + (i * 512 + tid) * 16);
#pragma unroll
      for (int i = 0; i < NB; ++i) glds16(Bb + ((size_t)i * 128 * ldb + ko * 2) + voB, sn + AB + (i * 512 + tid) * 16);
    } else if (nA) {
      const unsigned nvoA = (unsigned)(srow * nlda + kch * 8) * 2u, nvoB = (unsigned)(srow * nldb + kch * 8) * 2u;
#pragma unroll
      for (int i = 0; i < NA; ++i) glds16((const char*)nA + (size_t)i * 128 * nlda + nvoA, smem + (i * 512 + tid) * 16);
#pragma unroll
      for (int i = 0; i < NB; ++i) glds16((const char*)nB + (size_t)i * 128 * nldb + nvoB, smem + AB + (i * 512 + tid) * 16);
    }
    const unsigned stb = lds_base + (kt & 1) * STG;
#pragma unroll
    for (int ks = 0; ks < 2; ++ks) {
      const unsigned co = ((ks * 4 + fq) ^ sw) * 16;
      const unsigned sa = stb + a_row + co, sb = stb + b_row + co;
      bf16x8 af[4], bfr[NT];
#pragma unroll
      for (int n = 0; n < NT; ++n) asm volatile("ds_read_b128 %0, %1 offset:%2" : "=v"(bfr[n]) : "v"(sb), "n"(n * 2048) : "memory");
#pragma unroll
      for (int mg = 0; mg < MT / 4; ++mg) {
#pragma unroll
        for (int m = 0; m < 4; ++m) asm volatile("ds_read_b128 %0, %1 offset:%2" : "=v"(af[m]) : "v"(sa), "n"((mg * 4 + m) * 2048) : "memory");
        if (mg == 0) {
#pragma unroll
          for (int n = 0; n < NT; ++n) asm volatile("s_waitcnt lgkmcnt(%1)" : "+v"(bfr[n]) : "n"(4 + NT - 1 - n) : "memory");
        }
#pragma unroll
        for (int m = 0; m < 4; ++m) {
          asm volatile("s_waitcnt lgkmcnt(%1)" : "+v"(af[m]) : "n"(3 - m) : "memory");
#pragma unroll
          for (int n = 0; n < NT; ++n) acc[mg * 4 + m][n] = MFMA16(bfr[n], af[m], acc[mg * 4 + m][n]);
        }
      }
    }
  }
  if (!nA) __syncthreads();
}

template <int MT, int NT>
DI void zero_acc(f32x4 (&acc)[MT][NT]) {
#pragma unroll
  for (int m = 0; m < MT; ++m)
#pragma unroll
    for (int n = 0; n < NT; ++n) acc[m][n] = (f32x4){0.f, 0.f, 0.f, 0.f};
}

DI void tile_coords(int id, int nN, int& pm, int& pn) {
  const int band = id / (16 * nN), r = id % (16 * nN);
  pm = band * 16 + (r & 15); pn = r >> 4;
}

DI void phase_ffn_up(const bf16_t* __restrict__ xn, const bf16_t* __restrict__ gu, bf16_t* __restrict__ hid, unsigned char* smem) {
  const int tid_ = otid(), lane = tid_ & 63, w = tid_ >> 6, wr = w >> 2, wc = w & 3, fr = lane & 15, fq = lane >> 4;
  constexpr int nN = 2 * DFF / 256, nM = HT / 256;
  for (int id = blockIdx.x; id < nM * nN; id += gridDim.x) {
    int pm, pn; tile_coords(id, nN, pm, pn);
    f32x4 acc[8][4]; zero_acc(acc);
    {
      const int idn = id + gridDim.x; int pm2 = 0, pn2 = 0; const bool hn = idn < nM * nN; if (hn) tile_coords(idn, nN, pm2, pn2);
      gemm_block<8, 4, 2, 4>(xn + (size_t)pm * 256 * D, D, gu + (size_t)pn * 256 * D, D, D, acc, smem, id != (int)blockIdx.x,
                             hn ? xn + (size_t)pm2 * 256 * D : nullptr, D, gu + (size_t)pn2 * 256 * D, D);
    }
    const int hc0 = (pn * 4 + wc) * 32 + fq * 4;
#pragma unroll
    for (int m = 0; m < 8; ++m) {
      const size_t row = (size_t)pm * 256 + wr * 128 + m * 16 + fr;
#pragma unroll
      for (int n = 0; n < 2; ++n) {
        float h[4];
#pragma unroll
        for (int j = 0; j < 4; ++j) { const float g = acc[m][n][j], u = acc[m][n + 2][j]; h[j] = g * rcp_(1.0f + __expf(-g)) * u; }
        *(uint2*)(hid + row * DFF + hc0 + n * 16) = make_uint2(pack2(h[0], h[1]), pack2(h[2], h[3]));
      }
    }
  }
}

DI void phase_gemm_resid(const bf16_t* __restrict__ A, int K, const bf16_t* __restrict__ Bt, const float* __restrict__ xin, float* __restrict__ xout, float alpha, unsigned char* smem) {
  const int tid_ = otid(), lane = tid_ & 63, w = tid_ >> 6, wr = w >> 2, wc = w & 3, fr = lane & 15, fq = lane >> 4;
  constexpr int nN = D / 256, nM = HT / 256;
  for (int id = blockIdx.x; id < nM * nN; id += gridDim.x) {
    int pm, pn; tile_coords(id, nN, pm, pn);
    f32x4 acc[8][4]; zero_acc(acc);
    {
      const int idn = id + gridDim.x; int pm2 = 0, pn2 = 0; const bool hn = idn < nM * nN; if (hn) tile_coords(idn, nN, pm2, pn2);
      gemm_block<8, 4, 2, 4>(A + (size_t)pm * 256 * K, K, Bt + (size_t)pn * 256 * K, K, K, acc, smem, id != (int)blockIdx.x,
                             hn ? A + (size_t)pm2 * 256 * K : nullptr, K, Bt + (size_t)pn2 * 256 * K, K);
    }
#pragma unroll
    for (int m = 0; m < 8; ++m) {
      const size_t row = (size_t)pm * 256 + wr * 128 + m * 16 + fr;
#pragma unroll
      for (int n = 0; n < 4; ++n) {
        const size_t o = row * D + pn * 256 + wc * 64 + n * 16 + fq * 4;
        const f32x4 x = *(const f32x4*)(xin + o);
        *(f32x4*)(xout + o) = x + alpha * acc[m][n];
      }
    }
  }
}

DI void phase_proj(const bf16_t* __restrict__ xn, const bf16_t* __restrict__ wint, bf16_t* __restrict__ z, unsigned char* smem) {
  const int tid_ = otid(), lane = tid_ & 63, w = tid_ >> 6, wr = w >> 2, wc = w & 3, fr = lane & 15, fq = lane >> 4;
  constexpr int nN = ZC / 256, nM = HT / 256;
  for (int id = blockIdx.x; id < nM * nN; id += gridDim.x) {
    int pm, pn; tile_coords(id, nN, pm, pn);
    f32x4 acc[8][4]; zero_acc(acc);
    {
      const int idn = id + gridDim.x; int pm2 = 0, pn2 = 0; const bool hn = idn < nM * nN; if (hn) tile_coords(idn, nN, pm2, pn2);
      gemm_block<8, 4, 2, 4>(xn + (size_t)pm * 256 * D, D, wint + (size_t)pn * 256 * D, D, D, acc, smem, id != (int)blockIdx.x,
                             hn ? xn + (size_t)pm2 * 256 * D : nullptr, D, wint + (size_t)pn2 * 256 * D, D);
    }
#pragma unroll
    for (int m = 0; m < 8; ++m) {
      const size_t row = (size_t)pm * 256 + wr * 128 + m * 16 + fr;
#pragma unroll
      for (int n = 0; n < 4; ++n) {
        const f32x4 a = acc[m][n];
        *(uint2*)(z + row * ZC + pn * 256 + wc * 64 + n * 16 + fq * 4) = make_uint2(pack2(a[0], a[1]), pack2(a[2], a[3]));
      }
    }
  }
}

DI void phase_ya(const Params& p, int l, int L, const bf16_t* __restrict__ sg, const bf16_t* __restrict__ g2t, const bf16_t* __restrict__ z,
                 bf16_t* __restrict__ yf, const bf16_t* __restrict__ yb, const float* __restrict__ bon, unsigned char* smem) {
  const int tid_ = otid(), lane = tid_ & 63, w = tid_ >> 6, wr = w >> 2, wc = w & 3, fr = lane & 15, fq = lane >> 4;
  constexpr int nN = 2, nM = HT / 256;
  const float* mu0 = p.in[8] + (size_t)l * 2 * 1792;
  const float* mu1 = mu0 + 1792;
  const float* lng = p.in[17] + (size_t)l * CA;
  const float* lnb = p.in[18] + (size_t)l * CA;
  for (int id = blockIdx.x; id < nM * nN; id += gridDim.x) {
    int pm, pn; tile_coords(id, nN, pm, pn);
    f32x4 acc[8][4]; zero_acc(acc);
    {
      const int idn = id + gridDim.x; int pm2 = 0, pn2 = 0; const bool hn = idn < nM * nN; if (hn) tile_coords(idn, nN, pm2, pn2);
      gemm_block<8, 4, 2, 4>(sg + (size_t)pm * 256 * 128, 128, g2t + (size_t)pn * 256 * 128, 128, 128, acc, smem, id != (int)blockIdx.x,
                             hn ? sg + (size_t)pm2 * 256 * 128 : nullptr, 128, g2t + (size_t)pn2 * 256 * 128, 128);
    }
    const int h = pn * 4 + wc;
#pragma unroll
    for (int m = 0; m < 8; ++m) {
      const int row = pm * 256 + wr * 128 + m * 16 + fr;
      const int t = row % L;
      const bool hasp = t > 0, hasn = t < L - 1;
      float y[4][4];
      float s = 0.f;
#pragma unroll
      for (int n = 0; n < 4; ++n) {
        const int c = h * 64 + n * 16 + fq * 4;
        const uint2 a = *(const uint2*)(yf + (size_t)row * CA + c);
        const uint2 b = *(const uint2*)(yb + (size_t)row * CA + c);
        y[n][0] = lo2f(a.x) + lo2f(b.x); y[n][1] = hi2f(a.x) + hi2f(b.x); y[n][2] = lo2f(a.y) + lo2f(b.y); y[n][3] = hi2f(a.y) + hi2f(b.y);
        s += (y[n][0] + y[n][1]) + (y[n][2] + y[n][3]);
      }
      s = fq_sum(s);
      const float mean = s * (1.0f / 64.0f);
      float q = 0.f;
#pragma unroll
      for (int n = 0; n < 4; ++n)
#pragma unroll
        for (int j = 0; j < 4; ++j) { const float d = y[n][j] - mean; q += d * d; }
      q = fq_sum(q);
      const float rstd = rsqrtf(q * (1.0f / 64.0f) + 64e-5f);
      const float bsum = bon[(size_t)row * 8 + h] + bon[(size_t)HT * 8 + (size_t)row * 8 + h];
#pragma unroll
      for (int n = 0; n < 4; ++n) {
        const int c = h * 64 + n * 16 + fq * 4;
        const bf16_t* zr = z + (size_t)row * ZC + 1024 + c;
        const uint2 v0 = *(const uint2*)zr;
        uint2 vp = make_uint2(0u, 0u), vn = make_uint2(0u, 0u);
        if (hasp) vp = *(const uint2*)(zr - ZC);
        if (hasn) vn = *(const uint2*)(zr + ZC);
        const f32x4 m0 = *(const f32x4*)(mu0 + 1024 + c), m1 = *(const f32x4*)(mu1 + 1024 + c);
        const f32x4 gg = *(const f32x4*)(lng + c), bb = *(const f32x4*)(lnb + c);
        const float vc[4] = {lo2f(v0.x), hi2f(v0.x), lo2f(v0.y), hi2f(v0.y)};
        const float vpp[4] = {lo2f(vp.x), hi2f(vp.x), lo2f(vp.y), hi2f(vp.y)};
        const float vnn[4] = {lo2f(vn.x), hi2f(vn.x), lo2f(vn.y), hi2f(vn.y)};
        float o[4];
#pragma unroll
        for (int j = 0; j < 4; ++j) {
          const float vs = vc[j] + m0[j] * (vpp[j] - vc[j]) + m1[j] * (vnn[j] - vc[j]);
          o[j] = ((y[n][j] - mean) * rstd * gg[j] + bb[j] + bsum * vs) * acc[m][n][j];
        }
        *(uint2*)(yf + (size_t)row * CA + c) = make_uint2(pack2(o[0], o[1]), pack2(o[2], o[3]));
      }
    }
  }
}

DI void phase_merge(const bf16_t* __restrict__ xn, const bf16_t* __restrict__ Wl, const bf16_t* __restrict__ ya, const bf16_t* __restrict__ yn, const bf16_t* __restrict__ yd,
                    bf16_t* __restrict__ mo, unsigned char* smem) {
  const int tid_ = otid(), lane = tid_ & 63, w = tid_ >> 6, wr = w >> 1, wc = w & 1, fr = lane & 15, fq = lane >> 4;
  constexpr int nN = D / 128, nM = HT / 256;
  for (int id = blockIdx.x; id < nM * nN; id += gridDim.x) {
    int pm, pn; tile_coords(id, nN, pm, pn);
    unsigned tot[4][4][2];
#pragma unroll 1
    for (int i = 0; i < 3; ++i) {
      unsigned gp[4][4][2];
      {
        f32x4 ag[4][4]; zero_acc(ag);
        const bf16_t* Yn = (i == 0) ? ya : (i == 1 ? yn : yd);
        const int Kn = (i == 0) ? 512 : 256;
        const bf16_t* Pn = Wl + (i == 0 ? W_PA : (i == 1 ? W_PB : W_PC));
        gemm_block<4, 4, 4, 2>(xn + (size_t)pm * 256 * D, D, Wl + W_IN + (size_t)(ZC + i * 1024 + pn * 128) * D, D, D, ag, smem, !(i == 0 && id == (int)blockIdx.x),
                               Yn + (size_t)pm * 256 * Kn, Kn, Pn + (size_t)pn * 128 * Kn, Kn);
#pragma unroll
        for (int m = 0; m < 4; ++m)
#pragma unroll
          for (int n = 0; n < 4; ++n) {
            gp[m][n][0] = pack2(sigmoidf_(ag[m][n][0]), sigmoidf_(ag[m][n][1]));
            gp[m][n][1] = pack2(sigmoidf_(ag[m][n][2]), sigmoidf_(ag[m][n][3]));
          }
      }
      f32x4 ay[4][4]; zero_acc(ay);
      const bf16_t* Y = (i == 0) ? ya : (i == 1 ? yn : yd);
      const int Ki = (i == 0) ? 512 : 256;
      const bf16_t* P = Wl + (i == 0 ? W_PA : (i == 1 ? W_PB : W_PC));
      {
        const int idn = id + gridDim.x; int pm2 = pm, pn2 = pn, i2 = i + 1; bool hn = true;
        if (i == 2) { i2 = 0; hn = idn < nM * nN; if (hn) tile_coords(idn, nN, pm2, pn2); }
        gemm_block<4, 4, 4, 2>(Y + (size_t)pm * 256 * Ki, Ki, P + (size_t)pn * 128 * Ki, Ki, Ki, ay, smem, true,
                               hn ? xn + (size_t)pm2 * 256 * D : nullptr, D, Wl + W_IN + (size_t)(ZC + i2 * 1024 + pn2 * 128) * D, D);
      }
#pragma unroll
      for (int m = 0; m < 4; ++m)
#pragma unroll
        for (int n = 0; n < 4; ++n) {
          float t0 = ay[m][n][0] * lo2f(gp[m][n][0]), t1 = ay[m][n][1] * hi2f(gp[m][n][0]);
          float t2 = ay[m][n][2] * lo2f(gp[m][n][1]), t3 = ay[m][n][3] * hi2f(gp[m][n][1]);
          if (i > 0) { t0 += lo2f(tot[m][n][0]); t1 += hi2f(tot[m][n][0]); t2 += lo2f(tot[m][n][1]); t3 += hi2f(tot[m][n][1]); }
          tot[m][n][0] = pack2(t0, t1); tot[m][n][1] = pack2(t2, t3);
        }
    }
#pragma unroll
    for (int m = 0; m < 4; ++m) {
      const size_t row = (size_t)pm * 256 + wr * 64 + m * 16 + fr;
#pragma unroll
      for (int n = 0; n < 4; ++n)
        *(uint2*)(mo + row * D + pn * 128 + wc * 64 + n * 16 + fq * 4) = make_uint2(tot[m][n][0], tot[m][n][1]);
    }
  }
}

DI void item_sg(const Params& p, int l, int L, int item, const bf16_t* __restrict__ z, bf16_t* __restrict__ sg) {
  const int tid_ = otid() & 255, lane = tid_ & 63, w = tid_ >> 6;
  const float* mu0 = p.in[8] + (size_t)l * 2 * 1792 + 1664 + 2 * lane;
  const float* mu1 = mu0 + 1792;
  const float m0a = mu0[0], m0b = mu0[1], m1a = mu1[0], m1b = mu1[1];
  for (int i = w; i < 256; i += 4) {
    const int row = item * 256 + i;
    const int t = row % L;
    const bf16_t* zr = z + (size_t)row * ZC + 1664 + 2 * lane;
    const unsigned c = *(const unsigned*)zr;
    const unsigned pv = (t > 0) ? *(const unsigned*)(zr - ZC) : 0u;
    const unsigned nv = (t < L - 1) ? *(const unsigned*)(zr + ZC) : 0u;
    const float ca = lo2f(c), cb = hi2f(c);
    const float ga = ca + m0a * (lo2f(pv) - ca) + m1a * (lo2f(nv) - ca);
    const float gb = cb + m0b * (hi2f(pv) - cb) + m1b * (hi2f(nv) - cb);
    *(unsigned*)(sg + (size_t)row * 128 + 2 * lane) = pack2(sigmoidf_(ga), sigmoidf_(gb));
  }
}

DI void item_scan(const Params& p, int l, int L, int b, int h, int dir, const bf16_t* __restrict__ z, bf16_t* __restrict__ yout, float* __restrict__ bon, unsigned char* smem) {
  const int tid = otid() & 255, lane = tid & 63, w = tid >> 6, fr = lane & 15, fq = lane >> 4;
  unsigned* ZR = (unsigned*)smem;
  float* VR = (float*)(smem + 11520);
  float* VD = VR + 1024; float* VK = VD + 1024; float* VV = VK + 1024; float* VA = VV + 1024; float* VB = VA + 1024;
  float* YO = VB + 1024;
  float* BO = YO + 1024;
  unsigned char* WT = (unsigned char*)(BO + 16);
  unsigned char* AL = WT + 16 * RS;
  float* MU = (float*)(AL + 16 * RS);
  float* KKC = MU + 640;
  const size_t tok0 = (size_t)b * L;
  const float* mu0 = p.in[8] + (size_t)l * 2 * 1792;
  const float* mu1 = mu0 + 1792;
  const int cA = lane;
  __syncthreads();
  for (int i = tid; i < 640; i += 256) {
    const int s5 = i >> 7, d = (i >> 6) & 1, c = i & 63;
    const int col = (s5 < 3) ? (s5 * 512 + h * 64 + c) : (1536 + (s5 - 3) * 64 + c);
    MU[i] = (d ? mu1 : mu0)[col];
  }
  if (tid < 64) KKC[tid] = p.in[15][(size_t)l * CA + h * 64 + tid];
  const float rkc = p.in[14][((size_t)l * 2 + dir) * CA + h * 64 + cA];
  const int cB = w * 16 + fr;
  const float w0c = p.in[9][((size_t)l * 2 + dir) * CA + h * 64 + cB];
  const float a0c = p.in[11][((size_t)l * 2 + dir) * CA + h * 64 + cB];
  const float kac = p.in[13][((size_t)l * 2 + dir) * CA + h * 64 + cB];
  bf16x8 bw[2], ba[2];
  {
    const float* w2 = p.in[10] + ((size_t)l * 2 + dir) * 64 * CA + h * 64 + cB;
    const float* a2 = p.in[12] + ((size_t)l * 2 + dir) * 64 * CA + h * 64 + cB;
#pragma unroll
    for (int ks = 0; ks < 2; ++ks)
#pragma unroll
      for (int j = 0; j < 8; ++j) {
        bw[ks][j] = (short)f2bf(w2[(size_t)(ks * 32 + fq * 8 + j) * CA]);
        ba[ks][j] = (short)f2bf(a2[(size_t)(ks * 32 + fq * 8 + j) * CA]);
      }
  }
  const int kq = lane & 7, v0 = w * 16 + (lane >> 3) * 2;
  f32x2 S0[4], S1[4];
#pragma unroll
  for (int i = 0; i < 4; ++i) { S0[i] = (f32x2){0.f, 0.f}; S1[i] = (f32x2){0.f, 0.f}; }

  unsigned pf[12], poff[12];
  unsigned vbits = 0u, r0bits = 0u, r17bits = 0u, pf_ok = 0u;
#pragma unroll
  for (int i = 0; i < 12; ++i) {
    const int q = tid + i * 256;
    const int row = q / 160, pr = q - row * 160;
    const int col = (pr < 96) ? ((pr >> 5) * 512 + h * 64 + (pr & 31) * 2) : (1536 + (pr - 96) * 2);
    poff[i] = (q < 2880) ? (unsigned)(row * ZC + col) * 2u : 0u;
    if (q < 2880) vbits |= 1u << i;
    if (row == 0) r0bits |= 1u << i;
    if (row == 17) r17bits |= 1u << i;
  }
  auto prefetch = [&](int tc) {
    const char* zc = (const char*)(z + (tok0 + tc) * ZC) - (size_t)ZC * 2;
    pf_ok = vbits & ~((tc == 0) ? r0bits : 0u) & ~((tc == L - 16) ? r17bits : 0u);
#pragma unroll
    for (int i = 0; i < 12; ++i)
      pf[i] = *(const unsigned*)(zc + (((pf_ok >> i) & 1u) ? poff[i] : (unsigned)(ZC * 2)));
  };
  auto output = [&](int tco) {
    const int tt = tid >> 4, pj = tid & 15;
    const f32x2 ya = *(const f32x2*)(YO + tt * 64 + 2 * pj), yb2 = *(const f32x2*)(YO + tt * 64 + 32 + 2 * pj);
    bf16_t* yp = yout + (tok0 + tco + tt) * CA + h * 64 + 2 * pj;
    *(unsigned*)yp = pack2(ya[0], ya[1]);
    *(unsigned*)(yp + 32) = pack2(yb2[0], yb2[1]);
    if (tid < 16) bon[(tok0 + tco + tid) * 8 + h] = BO[tid];
  };
  const int nch = L / 16;
  prefetch(dir ? L - 16 : 0);
  int tc_prev = 0;
  for (int ci = 0; ci < nch; ++ci) {
    const int tc = dir ? (L - 16 - 16 * ci) : 16 * ci;
#pragma unroll
    for (int i = 0; i < 12; ++i) { const int q = tid + i * 256; if (q < 2880) ZR[q] = ((pf_ok >> i) & 1u) ? pf[i] : 0u; }
    __syncthreads();
    if (ci > 0) output(tc_prev);
    tc_prev = tc;
    if (ci + 1 < nch) prefetch(dir ? (tc - 16) : (tc + 16));
    {
      const int tt = tid >> 4, j = tid & 15;
      float kq2[4];
      float ksum = 0.f;
      unsigned zu[2][5][3];
      f32x2 mm[2][5][2];
#pragma unroll
      for (int hp = 0; hp < 2; ++hp)
#pragma unroll
        for (int s5 = 0; s5 < 5; ++s5) {
          const int pr = j + 16 * hp, pi = s5 * 32 + pr;
          zu[hp][s5][0] = ZR[tt * 160 + pi]; zu[hp][s5][1] = ZR[(tt + 1) * 160 + pi]; zu[hp][s5][2] = ZR[(tt + 2) * 160 + pi];
          mm[hp][s5][0] = *(const f32x2*)(MU + (s5 * 2) * 64 + 2 * pr); mm[hp][s5][1] = *(const f32x2*)(MU + (s5 * 2 + 1) * 64 + 2 * pr);
        }
#pragma unroll
      for (int hp = 0; hp < 2; ++hp) {
        const int pr = j + 16 * hp, c = 2 * pr;
        float zs[5][2];
#pragma unroll
        for (int s5 = 0; s5 < 5; ++s5) {
          const unsigned up = zu[hp][s5][0], uc = zu[hp][s5][1], un = zu[hp][s5][2];
          const f32x2 m0 = mm[hp][s5][0], m1 = mm[hp][s5][1];
          const float c0 = lo2f(uc), c1 = hi2f(uc);
          zs[s5][0] = c0 + m0[0] * (lo2f(up) - c0) + m1[0] * (lo2f(un) - c0);
          zs[s5][1] = c1 + m0[1] * (hi2f(up) - c1) + m1[1] * (hi2f(un) - c1);
        }
        *(f32x2*)(VR + tt * 64 + c) = (f32x2){zs[0][0], zs[0][1]};
        *(f32x2*)(VK + tt * 64 + c) = (f32x2){zs[1][0], zs[1][1]};
        *(f32x2*)(VV + tt * 64 + c) = (f32x2){zs[2][0], zs[2][1]};
        const f32x2 kc = *(const f32x2*)(KKC + c);
        kq2[2 * hp] = zs[1][0] * kc[0]; kq2[2 * hp + 1] = zs[1][1] * kc[1];
        ksum += kq2[2 * hp] * kq2[2 * hp] + kq2[2 * hp + 1] * kq2[2 * hp + 1];
        const float t0 = 1.0f - 2.0f * rcp_(__expf(2.0f * zs[3][0]) + 1.0f);
        const float t1 = 1.0f - 2.0f * rcp_(__expf(2.0f * zs[3][1]) + 1.0f);
        *(unsigned*)(WT + tt * RS + c * 2) = pack2(t0, t1);
        *(unsigned*)(AL + tt * RS + c * 2) = pack2(zs[4][0], zs[4][1]);
      }
      ksum = row_sum16(ksum);
      const float inv = rcp_(fmaxf(sqrtf(ksum), 1e-12f));
      *(f32x2*)(VA + tt * 64 + 2 * j) = (f32x2){kq2[0] * inv, kq2[1] * inv};
      *(f32x2*)(VA + tt * 64 + 2 * j + 32) = (f32x2){kq2[2] * inv, kq2[3] * inv};
    }
    __syncthreads();
    {
      f32x4 aw = {0.f, 0.f, 0.f, 0.f}, aa = {0.f, 0.f, 0.f, 0.f};
#pragma unroll
      for (int ks = 0; ks < 2; ++ks) {
        const bf16x8 fw = *(const bf16x8*)(WT + fr * RS + ks * 64 + fq * 16);
        const bf16x8 fa = *(const bf16x8*)(AL + fr * RS + ks * 64 + fq * 16);
        aw = MFMA16(fw, bw[ks], aw);
        aa = MFMA16(fa, ba[ks], aa);
      }
#pragma unroll
      for (int j = 0; j < 4; ++j) {
        const int tt = fq * 4 + j;
        const float x = w0c + aw[j];
        const float yv = -x;
        const float sp = fmaxf(yv, 0.f) + __logf(1.0f + __expf(-fabsf(yv)));
        const float e = __expf(-sp - 0.5f);
        const float dcy = __expf(-e);
        const float a = sigmoidf_(a0c + aa[j]);
        const float k = VK[tt * 64 + cB], kk = VA[tt * 64 + cB];
        VD[tt * 64 + cB] = dcy;
        VK[tt * 64 + cB] = k * (1.0f + (a - 1.0f) * kac);
        VA[tt * 64 + cB] = -kk;
        VB[tt * 64 + cB] = kk * a;
      }
    }
    __syncthreads();
    float pc[4];
#pragma unroll
    for (int i = 0; i < 4; ++i) { const int tt = w * 4 + i; pc[i] = VR[tt * 64 + cA] * VK[tt * 64 + cA] * rkc; }
#pragma unroll
    for (int i = 0; i < 4; ++i) {
      const int tt = w * 4 + i;
      const float s = wave_sum(pc[i]);
      if (lane == 0) BO[tt] = s;
    }
    {
      struct VA_ { f32x4 A0, A1; f32x2 V; };
      auto loada = [&](VA_& q, int off, int voff) {
        q.A0 = *(const f32x4*)(VA + off); q.A1 = *(const f32x4*)(VA + off + 4);
        q.V = *(const f32x2*)(VV + voff);
      };
      auto stepf = [&](const VA_& c, VA_& nx, int off, int voff, int offn, int voffn, bool has_next) {
        const f32x4 D0 = *(const f32x4*)(VD + off), D1 = *(const f32x4*)(VD + off + 4);
        const f32x4 B0 = *(const f32x4*)(VB + off), B1 = *(const f32x4*)(VB + off + 4);
        const f32x4 K0 = *(const f32x4*)(VK + off), K1 = *(const f32x4*)(VK + off + 4);
        const f32x4 R0 = *(const f32x4*)(VR + off), R1 = *(const f32x4*)(VR + off + 4);
        if (has_next) loada(nx, offn, voffn);
        const f32x2 a[4] = {{c.A0[0], c.A0[1]}, {c.A0[2], c.A0[3]}, {c.A1[0], c.A1[1]}, {c.A1[2], c.A1[3]}};
        const f32x2 d[4] = {{D0[0], D0[1]}, {D0[2], D0[3]}, {D1[0], D1[1]}, {D1[2], D1[3]}};
        const f32x2 bb[4] = {{B0[0], B0[1]}, {B0[2], B0[3]}, {B1[0], B1[1]}, {B1[2], B1[3]}};
        const f32x2 kk[4] = {{K0[0], K0[1]}, {K0[2], K0[3]}, {K1[0], K1[1]}, {K1[2], K1[3]}};
        const f32x2 rr[4] = {{R0[0], R0[1]}, {R0[2], R0[3]}, {R1[0], R1[1]}, {R1[2], R1[3]}};
        const f32x2 p0 = (S0[0] * a[0] + S0[1] * a[1]) + (S0[2] * a[2] + S0[3] * a[3]);
        const f32x2 p1 = (S1[0] * a[0] + S1[1] * a[1]) + (S1[2] * a[2] + S1[3] * a[3]);
        const float sa0 = oct_sum(p0[0] + p0[1]);
        const float sa1 = oct_sum(p1[0] + p1[1]);
        f32x2 y0a = {0.f, 0.f}, y0b = {0.f, 0.f}, y1a = {0.f, 0.f}, y1b = {0.f, 0.f};
#pragma unroll
        for (int i = 0; i < 4; ++i) {
          const f32x2 n0 = S0[i] * d[i] + (sa0 * bb[i] + c.V[0] * kk[i]);
          const f32x2 n1 = S1[i] * d[i] + (sa1 * bb[i] + c.V[1] * kk[i]);
          S0[i] = n0; S1[i] = n1;
          if (i & 1) { y0b += n0 * rr[i]; y1b += n1 * rr[i]; } else { y0a += n0 * rr[i]; y1a += n1 * rr[i]; }
        }
        const f32x2 y0 = y0a + y0b, y1 = y1a + y1b;
        const float ys0 = oct_sum(y0[0] + y0[1]), ys1 = oct_sum(y1[0] + y1[1]);
        *(f32x2*)(YO + voff) = (f32x2){ys0, ys1};
      };
      const int dstep = dir ? -64 : 64;
      int off = (dir ? 15 * 64 : 0) + kq * 8, voff = (dir ? 15 * 64 : 0) + v0;
      VA_ X, Y;
      loada(X, off, voff);
#pragma unroll 1
      for (int it2 = 0; it2 < 8; ++it2) {
        stepf(X, Y, off, voff, off + dstep, voff + dstep, true);
        stepf(Y, X, off + dstep, voff + dstep, off + 2 * dstep, voff + 2 * dstep, it2 < 7);
        off += 2 * dstep; voff += 2 * dstep;
      }
    }
  }
  __syncthreads();
  output(tc_prev);
  __syncthreads();
}

template <int MODE>
DI void item_attn(const Params& p, int l, int L, int b, int h, int qi, const bf16_t* __restrict__ z, bf16_t* __restrict__ yo, unsigned char* smem, unsigned char* smc) {
  const int tid = otid() & 255, lane = tid & 63, w = tid >> 6, fr = lane & 15, fq = lane >> 4;
  unsigned char* KV0 = (MODE == 1) ? smc : smem;
  constexpr int NLD = (MODE == 1) ? 1 : 2;
  const int t5 = (MODE == 1) ? (tid + (int)(smem - smc) / 256) : tid;
  const int vkey = (MODE == 1) ? (t5 & 63) : lane, vdc0 = (MODE == 1) ? (t5 >> 6) : 2 * w;
  float* RPB = (float*)(smem + 256 * RS);
  const size_t tok0 = (size_t)b * L;
  const int rows = L / 64;
  const int qcol = (MODE == 0 ? 1792 : 2560) + h * 64, kcol = qcol + 256, vcol = qcol + 512;
  const int ntile = (MODE == 0) ? 8 : rows;
  int rs = 0;
  if (MODE == 0) { rs = qi - 4; rs = rs < 0 ? 0 : (rs > rows - 8 ? rows - 8 : rs); }
  const int qc = w * 16 + fr;
  const size_t qtok = tok0 + (size_t)qi * 64 + qc;
  bf16x8 qf[2];
#pragma unroll
  for (int ks = 0; ks < 2; ++ks) qf[ks] = *(const bf16x8*)(z + qtok * ZC + qcol + ks * 32 + fq * 8);
  float lam = 0.f, lam_init = 0.f;
  if (MODE == 0) {
    __syncthreads();
    const float* rp = p.in[19] + ((size_t)l * 4 + h) * 465;
    for (int i = tid; i < 465; i += 256) RPB[i] = rp[i];
  } else {
    const float* lp = p.in[20] + (size_t)l * 128;
    float v1 = 0.f, v2 = 0.f;
    if (lane < 32) { v1 = lp[lane] * lp[32 + lane]; v2 = lp[64 + lane] * lp[96 + lane]; }
    v1 = wave_sum(v1); v2 = wave_sum(v2);
    lam_init = 0.8f - 0.6f * __expf(-0.3f * (float)l);
    lam = __expf(v1) - __expf(v2) + lam_init;
  }
  u32x4 rk[NLD], rv[NLD];
  auto load_tile = [&](int it) {
    const size_t kt0 = tok0 + (size_t)((MODE == 0) ? (rs + it) : it) * 64;
#pragma unroll
    for (int i = 0; i < NLD; ++i) {
      const int q = t5 + i * 256;
      rk[i] = *(const u32x4*)(z + (kt0 + (q >> 3)) * ZC + kcol + (q & 7) * 8);
      rv[i] = *(const u32x4*)(z + (kt0 + vkey) * ZC + vcol + (vdc0 + i) * 8);
    }
  };
  auto store_tile = [&](int buf) {
    unsigned char* KSw = KV0 + buf * (128 * RS);
    unsigned char* VTw = KSw + 64 * RS;
#pragma unroll
    for (int i = 0; i < NLD; ++i) {
      const int q = t5 + i * 256;
      *(u32x4*)(KSw + (q >> 3) * RS + (q & 7) * 16) = rk[i];
#pragma unroll
      for (int e = 0; e < 8; ++e) {
        const unsigned vwd = rv[i][e >> 1];
        const bf16_t val = (bf16_t)((e & 1) ? (vwd >> 16) : (vwd & 0xffffu));
        *(bf16_t*)(VTw + ((vdc0 + i) * 8 + e) * RS + vkey * 2) = val;
      }
    }
  };
  load_tile(0);
  store_tile(0);
  if (ntile > 1) load_tile(1);
  constexpr int NS = (MODE == 0) ? 1 : 2;
  f32x4 o[NS][4];
  float mrun[NS], lrun[NS];
#pragma unroll
  for (int s = 0; s < NS; ++s) { mrun[s] = -1e30f; lrun[s] = 0.f;
#pragma unroll
    for (int dt = 0; dt < 4; ++dt) o[s][dt] = (f32x4){0.f, 0.f, 0.f, 0.f}; }
  const float slope2 = (MODE == 1) ? exp2f(-2.0f * (float)(h + 1)) * LOG2E : 0.f;
  const float sc2 = (MODE == 0) ? 0.125f * LOG2E : 0.17677669529663687f * LOG2E;
  const int qpos = qi * 64 + qc;
  const float dbase = (float)(fq * 4 - qpos);
  int cs = qc - 8; cs = cs < 0 ? 0 : (cs > 48 ? 48 : cs);
  for (int it = 0; it < ntile; ++it) {
    __syncthreads();
    if (it + 1 < ntile) store_tile((it + 1) & 1);
    if (it + 2 < ntile) load_tile(it + 2);
    const unsigned char* KS = KV0 + (it & 1) * (128 * RS);
    const unsigned char* VT = KS + 64 * RS;
    f32x4 s[NS][4];
#pragma unroll
    for (int kt = 0; kt < 4; ++kt) {
      const bf16x8 k0 = *(const bf16x8*)(KS + (kt * 16 + fr) * RS + fq * 16);
      const bf16x8 k1 = *(const bf16x8*)(KS + (kt * 16 + fr) * RS + 64 + fq * 16);
      const f32x4 zf = {0.f, 0.f, 0.f, 0.f};
      if (MODE == 0) { s[0][kt] = MFMA16(k0, qf[0], zf); s[0][kt] = MFMA16(k1, qf[1], s[0][kt]); }
      else { s[0][kt] = MFMA16(k0, qf[0], zf); s[NS - 1][kt] = MFMA16(k1, qf[1], zf); }
    }
    float alpha[NS];
    float mx[NS];
#pragma unroll
    for (int sh = 0; sh < NS; ++sh) mx[sh] = -1e30f;
    if (MODE == 0) {
#pragma unroll
      for (int kt = 0; kt < 4; ++kt)
#pragma unroll
        for (int j = 0; j < 4; ++j) {
          const int kj = kt * 16 + fq * 4 + j;
          const bool valid = (kj >= cs) && (kj < cs + 16);
          int dc = kj - qc + 15; dc = dc < 0 ? 0 : (dc > 30 ? 30 : dc);
          const int dr = rs + it - qi + 7;
          const float t2 = valid ? (s[0][kt][j] * sc2 + RPB[dr * 31 + dc] * LOG2E) : -1e30f;
          s[0][kt][j] = t2;
          mx[0] = fmaxf(mx[0], t2);
        }
    } else {
      const float d0 = dbase + (float)(it * 64);
#pragma unroll
      for (int kt = 0; kt < 4; ++kt)
#pragma unroll
        for (int j = 0; j < 4; ++j) {
          const float ad = slope2 * fabsf(d0 + (float)(kt * 16 + j));
#pragma unroll
          for (int sh = 0; sh < NS; ++sh) {
            const float t2 = s[sh][kt][j] * sc2 - ad;
            s[sh][kt][j] = t2;
            mx[sh] = fmaxf(mx[sh], t2);
          }
        }
    }
#pragma unroll
    for (int sh = 0; sh < NS; ++sh) {
      float m1 = mx[sh];
      m1 = fq_max(m1);
      const float mn = fmaxf(mrun[sh], m1);
      alpha[sh] = __builtin_amdgcn_exp2f(mrun[sh] - mn);
      mrun[sh] = mn;
      float ps = 0.f;
#pragma unroll
      for (int kt = 0; kt < 4; ++kt)
#pragma unroll
        for (int j = 0; j < 4; ++j) { const float pe = __builtin_amdgcn_exp2f(s[sh][kt][j] - mn); s[sh][kt][j] = pe; ps += pe; }
      lrun[sh] = lrun[sh] * alpha[sh] + ps;
#pragma unroll
      for (int dt = 0; dt < 4; ++dt) o[sh][dt] = o[sh][dt] * alpha[sh];
    }
#pragma unroll
    for (int i2 = 0; i2 < 2; ++i2) {
      bf16x8 pfr[NS];
#pragma unroll
      for (int sh = 0; sh < NS; ++sh) {
        const unsigned u0 = pack2(s[sh][2 * i2][0], s[sh][2 * i2][1]), u1 = pack2(s[sh][2 * i2][2], s[sh][2 * i2][3]);
        const unsigned u2 = pack2(s[sh][2 * i2 + 1][0], s[sh][2 * i2 + 1][1]), u3 = pack2(s[sh][2 * i2 + 1][2], s[sh][2 * i2 + 1][3]);
        const u32x4 u = {u0, u1, u2, u3};
        pfr[sh] = __builtin_bit_cast(bf16x8, u);
      }
#pragma unroll
      for (int dt = 0; dt < 4; ++dt) {
        const u32x2 va = *(const u32x2*)(VT + (dt * 16 + fr) * RS + (32 * i2 + fq * 4) * 2);
        const u32x2 vb = *(const u32x2*)(VT + (dt * 16 + fr) * RS + (32 * i2 + 16 + fq * 4) * 2);
        const u32x4 vu = {va[0], va[1], vb[0], vb[1]};
        const bf16x8 vf = __builtin_bit_cast(bf16x8, vu);
#pragma unroll
        for (int sh = 0; sh < NS; ++sh) o[sh][dt] = MFMA16(vf, pfr[sh], o[sh][dt]);
      }
    }
  }
  float linv[NS];
#pragma unroll
  for (int sh = 0; sh < NS; ++sh) { float lt = lrun[sh]; lt = fq_sum(lt); linv[sh] = rcp_(lt); }
  if (MODE == 0) {
#pragma unroll
    for (int dt = 0; dt < 4; ++dt) {
      const f32x4 r = o[0][dt] * linv[0];
      *(uint2*)(yo + qtok * 256 + h * 64 + dt * 16 + fq * 4) = make_uint2(pack2(r[0], r[1]), pack2(r[2], r[3]));
    }
  } else {
    f32x4 r[4];
    float ss = 0.f;
#pragma unroll
    for (int dt = 0; dt < 4; ++dt) {
      r[dt] = o[0][dt] * linv[0] - lam * (o[NS - 1][dt] * linv[NS - 1]);
      ss += r[dt][0] * r[dt][0] + r[dt][1] * r[dt][1] + r[dt][2] * r[dt][2] + r[dt][3] * r[dt][3];
    }
    ss = fq_sum(ss);
    const float rn = rsqrtf(ss * (1.0f / 64.0f) + 1e-5f) * (1.0f - lam_init);
    const float* sg = p.in[21] + (size_t)l * 64;
#pragma unroll
    for (int dt = 0; dt < 4; ++dt) {
      const f32x4 g = *(const f32x4*)(sg + dt * 16 + fq * 4);
      const f32x4 q = r[dt] * rn * g;
      *(uint2*)(yo + qtok * 256 + h * 64 + dt * 16 + fq * 4) = make_uint2(pack2(q[0], q[1]), pack2(q[2], q[3]));
    }
  }
}

DI void phase_mixers(const Params& p, int l, int half, unsigned* counter, unsigned char* smem) {
  const int L = half ? 2048 : 4096, nseq = HT / L, rows = L / 64;
  const bf16_t* z = (const bf16_t*)(p.ws + WS_Z);
  bf16_t* yf = (bf16_t*)(p.ws + WS_YF);
  bf16_t* yb = (bf16_t*)(p.ws + WS_YB);
  bf16_t* yn = (bf16_t*)(p.ws + WS_YN);
  bf16_t* yd = (bf16_t*)(p.ws + WS_YD);
  bf16_t* sg = (bf16_t*)(p.ws + WS_SG);
  float* bon = (float*)(p.ws + WS_BON);
  const int n_scan = nseq * 16, n_diff = nseq * 4 * rows, n_na = nseq * rows * 4, n_sg = HT / 256;
  const int total = n_scan + n_diff + n_na + n_sg;
  const int hf = __builtin_amdgcn_readfirstlane(otid() >> 8);
  unsigned char* sm = smem + hf * 65536;
  __shared__ int s_item;
  for (;;) {
    __syncthreads();
    if (threadIdx.x == 0) s_item = (int)atomicAdd(counter, 1u);
    __syncthreads();
    int it = 2 * s_item + hf;
    if (it >= total) break;
    if (it < n_scan) {
      const int dir = it & 1, h = (it >> 1) & 7, b = it >> 4;
      item_scan(p, l, L, b, h, dir, z, dir ? yb : yf, bon + (size_t)dir * HT * 8, sm);
      continue;
    }
    it -= n_scan;
    if (it < n_diff) {
      const int qb = it % rows, h = (it / rows) & 3, b = it / (rows * 4);
      item_attn<1>(p, l, L, b, h, qb, z, yd, sm, smem);
      continue;
    }
    it -= n_diff;
    if (it < n_na) {
      const int r = it % rows, h = (it / rows) & 3, b = it / (rows * 4);
      item_attn<0>(p, l, L, b, h, r, z, yn, sm, smem);
      continue;
    }
    it -= n_na;
    item_sg(p, l, L, it, z, sg);
  }
}

#define XB_TMO      128
#define XB_XCNT(j)  (256  + 64 * (j))
#define XB_XSUB(j)  (1280 + 64 * (j))
#define XB_XGEN(j)  (2304 + 64 * (j))
#define XB_TOP      3328
#define XB_TOPGEN   3392
#define XB_SPIN_CAP (1u << 18)
#define LAS __attribute__((address_space(3)))
DI unsigned xb_ld(unsigned* p)              { return __hip_atomic_load(p, __ATOMIC_RELAXED, __HIP_MEMORY_SCOPE_AGENT); }
DI unsigned xb_add(unsigned* p, unsigned v) { return __hip_atomic_fetch_add(p, v, __ATOMIC_RELAXED, __HIP_MEMORY_SCOPE_AGENT); }
DI unsigned xb_xcc_id() { return (unsigned)__builtin_amdgcn_s_getreg((3 << 11) | 20) & 0xFu; }
#define XB_SPIN(cond, bar) do { unsigned _sp = 0; while (cond) { __builtin_amdgcn_s_sleep(1); \
    if ((++_sp & 255u) == 0u) { if (xb_ld(&(bar)[XB_TMO])) break; if (_sp > XB_SPIN_CAP) { atomicAdd(&(bar)[XB_TMO], 1u); break; } } } } while (0)
struct XcdBarrier { unsigned* bar; unsigned x; volatile LAS unsigned* st; };
DI XcdBarrier xcd_barrier_post(unsigned* bar, volatile LAS unsigned* st) {
  XcdBarrier b; b.bar = bar; b.x = xb_xcc_id(); b.st = st;
  if (threadIdx.x == 0) (void)xb_add(&bar[XB_XCNT(b.x)], 1u);
  return b;
}
DI void xcd_barrier_complete(unsigned* bar, unsigned x, unsigned& nloc, unsigned& nx) {
  const unsigned G = gridDim.x * gridDim.y * gridDim.z;
  unsigned sum, cnt, mine, sp = 0u;
  for (;;) {
    sum = 0u; cnt = 0u; mine = 0u;
#pragma unroll
    for (unsigned j = 0; j < 16; ++j) { const unsigned c = xb_ld(&bar[XB_XCNT(j)]); sum += c; cnt += (c > 0u) ? 1u : 0u; mine = (j == x) ? c : mine; }
    if (sum == G) break;
    __builtin_amdgcn_s_sleep(1);
    if ((++sp & 255u) == 0u) { if (xb_ld(&bar[XB_TMO])) break; if (sp > XB_SPIN_CAP) { atomicAdd(&bar[XB_TMO], 1u); break; } }
  }
  nloc = mine > 0u ? mine : 1u; nx = cnt > 0u ? cnt : 1u;
}
DI void xcd_barrier(const XcdBarrier& b) {
  asm volatile("s_waitcnt vmcnt(0)" ::: "memory");
  __syncthreads();
  if (threadIdx.x == 0) {
    unsigned* bar = b.bar;
    __builtin_amdgcn_s_waitcnt(0);
    unsigned nloc = b.st[0], nx = b.st[1];
    if (nloc == 0u) { xcd_barrier_complete(bar, b.x, nloc, nx); b.st[0] = nloc; b.st[1] = nx; }
    const unsigned old = xb_add(&bar[XB_XSUB(b.x)], 1u);
    const unsigned gen = old / nloc;
    if (old + 1u == (gen + 1u) * nloc) {
      __builtin_amdgcn_fence(__ATOMIC_RELEASE, "agent");
      asm volatile("s_waitcnt vmcnt(0)" ::: "memory");
      const unsigned og = xb_add(&bar[XB_TOP], 1u);
      const unsigned tg = og / nx;
      if (og + 1u == (tg + 1u) * nx) xb_add(&bar[XB_TOPGEN], 1u);
      else XB_SPIN(xb_ld(&bar[XB_TOPGEN]) == tg, bar);
      __builtin_amdgcn_fence(__ATOMIC_ACQUIRE, "agent");
      xb_add(&bar[XB_XGEN(b.x)], 1u);
      asm volatile("s_waitcnt vmcnt(0)" ::: "memory");
    } else {
      XB_SPIN(xb_ld(&bar[XB_XGEN(b.x)]) == gen, bar);
      __builtin_amdgcn_fence(__ATOMIC_ACQUIRE, "agent");
      asm volatile("s_waitcnt vmcnt(0)" ::: "memory");
    }
  }
  __syncthreads();
}

__global__ void __launch_bounds__(512, 2) fwd_megakernel(Params p) {
  cg::grid_group grid = cg::this_grid();
  __shared__ __attribute__((aligned(16))) unsigned char smem[131072];
  bf16_t* W = (bf16_t*)(p.ws + WS_W);
  bf16_t* xn = (bf16_t*)(p.ws + WS_XN);
  bf16_t* hid = (bf16_t*)(p.ws + WS_HID);
  bf16_t* z = (bf16_t*)(p.ws + WS_Z);
  bf16_t* mo = (bf16_t*)(p.ws + WS_M);
  unsigned* ctl = (unsigned*)(p.ws + WS_CTL);
  __shared__ uint4 xb_words;
  if (threadIdx.x == 0) xb_words = make_uint4(0u, 0u, 0u, 0u);
  __syncthreads();
  const XcdBarrier xb = xcd_barrier_post((unsigned*)(p.ws + WS_BAR), (volatile LAS unsigned*)&xb_words);

  phase_convert(p, smem);
  grid.sync();
  for (int half = 0; half < 2; ++half) {
    const float* xin = p.in[half];
    float* x = p.out + (size_t)half * HT * D;
    const int L = half ? 2048 : 4096;
    for (int l = 0; l < NLAYER; ++l) {
      const bf16_t* Wl = W + (size_t)l * W_LAYER;
      const float* xsrc = (l == 0) ? xin : x;
      phase_norm(xsrc, p.in[2] + (size_t)l * D, xn, nullptr);
      xcd_barrier(xb);
      phase_ffn_up(xn, Wl + W_GU, hid, smem);
      xcd_barrier(xb);
      phase_gemm_resid(hid, DFF, Wl + W_WD, xsrc, x, 0.5f, smem);
      xcd_barrier(xb);
      phase_norm(x, p.in[6] + (size_t)l * D, xn, nullptr);
      xcd_barrier(xb);
      phase_proj(xn, Wl + W_IN, z, smem);
      xcd_barrier(xb);
      phase_mixers(p, l, half, ctl + (half * NLAYER + l) * 16, smem);
      xcd_barrier(xb);
      phase_ya(p, l, L, (const bf16_t*)(p.ws + WS_SG), Wl + W_G2, z, (bf16_t*)(p.ws + WS_YF), (const bf16_t*)(p.ws + WS_YB), (const float*)(p.ws + WS_BON), smem);
      xcd_barrier(xb);
      phase_merge(xn, Wl, (const bf16_t*)(p.ws + WS_YF), (const bf16_t*)(p.ws + WS_YN), (const bf16_t*)(p.ws + WS_YD), mo, smem);
      xcd_barrier(xb);
      phase_gemm_resid(mo, D, Wl + W_OUT, x, x, 1.0f, smem);
      xcd_barrier(xb);
      phase_norm(x, p.in[26] + (size_t)l * D, xn, nullptr);
      xcd_barrier(xb);
      phase_ffn_up(xn, Wl + W_GU2, hid, smem);
      xcd_barrier(xb);
      phase_gemm_resid(hid, DFF, Wl + W_WD2, x, x, 0.5f, smem);
      xcd_barrier(xb);
    }
    phase_norm(x, p.in[30], nullptr, x);
    xcd_barrier(xb);
  }
}

extern "C" void kernel_launch(void* const* d_in, const int* in_sizes, int n_in, void* d_out, int out_size, void* d_ws, size_t ws_size, hipStream_t stream) {
  static int grid_blocks = 0;
  if (!grid_blocks) {
    int dev = 0, cus = 0, per_cu = 0;
    (void)hipGetDevice(&dev);
    (void)hipDeviceGetAttribute(&cus, hipDeviceAttributeMultiprocessorCount, dev);
    (void)hipOccupancyMaxActiveBlocksPerMultiprocessor(&per_cu, fwd_megakernel, 512, 0);
    if (per_cu < 1) per_cu = 1;
    if (per_cu > 1) per_cu = 1;
    grid_blocks = cus * per_cu;
    if (ws_size < WS_END) fprintf(stderr, "kernel_launch: workspace too small: need %zu have %zu\n", (size_t)WS_END, ws_size);
  }
  (void)hipMemsetAsync((char*)d_ws + WS_CTL, 0, WS_CTL_BYTES, stream);
  Params p{};
  for (int i = 0; i < 31; ++i) p.in[i] = (const float*)d_in[i];
  p.out = (float*)d_out;
  p.ws = (unsigned char*)d_ws;
  void* args[] = {&p};
  hipError_t e = hipLaunchCooperativeKernel((void*)fwd_megakernel, dim3(grid_blocks), dim3(512), args, 0, stream);
  if (e != hipSuccess) fprintf(stderr, "cooperative launch failed: %s (grid %d)\n", hipGetErrorString(e), grid_blocks);
}
```

```cpp
#include <hip/hip_runtime.h>
#include <hip/hip_cooperative_groups.h>
#include <cstdio>
#include <cstdint>
namespace cg = cooperative_groups;

typedef unsigned short bf16_t;
typedef short bf16x8 __attribute__((ext_vector_type(8)));
typedef short s16x4 __attribute__((ext_vector_type(4)));
typedef float f32x4 __attribute__((ext_vector_type(4)));
typedef float f32x2 __attribute__((ext_vector_type(2)));
typedef unsigned u32x4 __attribute__((ext_vector_type(4)));
typedef unsigned u32x2 __attribute__((ext_vector_type(2)));
#define DI __device__ __forceinline__
#define MFMA16(a, b, c) __builtin_amdgcn_mfma_f32_16x16x32_bf16((a), (b), (c), 0, 0, 0)

constexpr int D = 1024, DFF = 2816, HT = 65536  , NLAYER = 2;
constexpr int ZC = 3328;
constexpr int INC = 6400;
constexpr int CA = 512;
constexpr float LOG2E = 1.4426950408889634f;

constexpr size_t WS_CTL = 0;
constexpr size_t WS_BAR = 4096;
constexpr size_t WS_CTL_BYTES = 32768;
constexpr size_t WS_W = WS_CTL_BYTES;
constexpr size_t W_GU = 0;
constexpr size_t W_WD = W_GU + (size_t)2 * DFF * D;
constexpr size_t W_GU2 = W_WD + (size_t)D * DFF;
constexpr size_t W_WD2 = W_GU2 + (size_t)2 * DFF * D;
constexpr size_t W_IN = W_WD2 + (size_t)D * DFF;
constexpr size_t W_PA = W_IN + (size_t)INC * D;
constexpr size_t W_PB = W_PA + (size_t)D * 512;
constexpr size_t W_PC = W_PB + (size_t)D * 256;
constexpr size_t W_OUT = W_PC + (size_t)D * 256;
constexpr size_t W_G2 = W_OUT + (size_t)D * D;
constexpr size_t W_LAYER = W_G2 + (size_t)512 * 128;
constexpr size_t WS_XN = WS_W + 2 * W_LAYER * 2;
constexpr size_t WS_R = WS_XN + (size_t)HT * D * 2;
constexpr size_t WS_HID = WS_R;
constexpr size_t WS_Z = WS_R;
constexpr size_t WS_M = WS_R;
constexpr size_t WS_YF = WS_Z + (size_t)HT * ZC * 2;
constexpr size_t WS_YB = WS_YF + (size_t)HT * 512 * 2;
constexpr size_t WS_YN = WS_YB + (size_t)HT * 512 * 2;
constexpr size_t WS_YD = WS_YN + (size_t)HT * 256 * 2;
constexpr size_t WS_SG = WS_YD + (size_t)HT * 256 * 2;
constexpr size_t WS_BON = WS_SG + (size_t)HT * 128 * 2;
constexpr size_t WS_END = WS_BON + (size_t)2 * HT * 8 * 4;

struct Params {
  const float* in[31];
  float* out;
  unsigned char* ws;
};

typedef __bf16 bf16x2_t __attribute__((ext_vector_type(2)));
DI unsigned pack2(float lo, float hi) { const f32x2 v = {lo, hi}; const bf16x2_t b = __builtin_convertvector(v, bf16x2_t); return __builtin_bit_cast(unsigned, b); }
DI bf16_t f2bf(float x) { return (bf16_t)(pack2(x, x) & 0xffffu); }
DI float bf2f(bf16_t h) { return __uint_as_float(((unsigned)h) << 16); }
DI float lo2f(unsigned u) { return __uint_as_float(u << 16); }
DI float hi2f(unsigned u) { return __uint_as_float(u & 0xffff0000u); }
DI float xor16_sum(float v) { const auto r = __builtin_amdgcn_permlane16_swap(__float_as_uint(v), __float_as_uint(v), false, false); return __uint_as_float(r[0]) + __uint_as_float(r[1]); }
DI float xor32_sum(float v) { const auto r = __builtin_amdgcn_permlane32_swap(__float_as_uint(v), __float_as_uint(v), false, false); return __uint_as_float(r[0]) + __uint_as_float(r[1]); }
DI float xor16_max(float v) { const auto r = __builtin_amdgcn_permlane16_swap(__float_as_uint(v), __float_as_uint(v), false, false); return fmaxf(__uint_as_float(r[0]), __uint_as_float(r[1])); }
DI float xor32_max(float v) { const auto r = __builtin_amdgcn_permlane32_swap(__float_as_uint(v), __float_as_uint(v), false, false); return fmaxf(__uint_as_float(r[0]), __uint_as_float(r[1])); }
DI float fq_sum(float v) { return xor32_sum(xor16_sum(v)); }
DI float fq_max(float v) { return xor32_max(xor16_max(v)); }
DI float quad_sum(float v) {
  int t = __builtin_amdgcn_update_dpp(0, __float_as_int(v), 0xB1, 0xF, 0xF, true);
  v += __int_as_float(t);
  t = __builtin_amdgcn_update_dpp(0, __float_as_int(v), 0x4E, 0xF, 0xF, true);
  v += __int_as_float(t);
  return v;
}
DI float oct_sum(float v) {
  v = quad_sum(v);
  const int t = __builtin_amdgcn_update_dpp(0, __float_as_int(v), 0x141, 0xF, 0xF, true);
  return v + __int_as_float(t);
}
DI float row_sum16(float v) {
  v = oct_sum(v);
  const int t = __builtin_amdgcn_update_dpp(0, __float_as_int(v), 0x140, 0xF, 0xF, true);
  return v + __int_as_float(t);
}
DI float wave_sum(float v) { return fq_sum(row_sum16(v)); }
DI void oct_sum_pair(float& a, float& b) {
#define OSP_STAGE(ctrl) { const int ta = __builtin_amdgcn_update_dpp(0, __float_as_int(a), ctrl, 0xF, 0xF, true); const int tb = __builtin_amdgcn_update_dpp(0, __float_as_int(b), ctrl, 0xF, 0xF, true); \
    a += __int_as_float(ta); b += __int_as_float(tb); asm volatile("" : "+v"(a)); asm volatile("" : "+v"(b)); }
  OSP_STAGE(0xB1) OSP_STAGE(0x4E) OSP_STAGE(0x141)
#undef OSP_STAGE
}
DI int otid() { int t = threadIdx.x; asm volatile("" : "+v"(t)); return t; }
DI float rcp_(float x) { return __builtin_amdgcn_rcpf(x); }
DI float sigmoidf_(float x) { return rcp_(1.0f + __expf(-x)); }

DI void convert_job(const float* __restrict__ src, int K, int N, bf16_t* __restrict__ dst, int mode, float* tile  ) {
  const int tid = otid();
  const int ntk = K / 64, ntn = N / 64, nt = ntk * ntn;
  for (int t = blockIdx.x; t < nt; t += gridDim.x) {
    const int tk = t / ntn, tn = t % ntn;
    const int k0 = tk * 64, n0 = tn * 64;
    __syncthreads();
#pragma unroll
    for (int i = 0; i < 8; ++i) {
      const int kk = (tid >> 6) + i * 8, nn = tid & 63;
      tile[kk * 65 + nn] = src[(size_t)(k0 + kk) * N + n0 + nn];
    }
    __syncthreads();
    const int nn = tid >> 3, kc = (tid & 7) * 8;
    const int n = n0 + nn;
    int row = n;
    if (mode == 1) row = (n >> 5) * 64 + (n & 31);
    else if (mode == 2) row = (n >> 5) * 64 + 32 + (n & 31);
    u32x4 pk;
#pragma unroll
    for (int i = 0; i < 4; ++i) pk[i] = pack2(tile[(kc + 2 * i) * 65 + nn], tile[(kc + 2 * i + 1) * 65 + nn]);
    *(u32x4*)(dst + (size_t)row * K + k0 + kc) = pk;
  }
}

DI void phase_convert(const Params& p, unsigned char* smem) {
  float* tile = (float*)smem;
  bf16_t* W = (bf16_t*)(p.ws + WS_W);
  for (int l = 0; l < NLAYER; ++l) {
    bf16_t* Wl = W + (size_t)l * W_LAYER;
    convert_job(p.in[3] + (size_t)l * D * DFF, D, DFF, Wl + W_GU, 1, tile);
    convert_job(p.in[4] + (size_t)l * D * DFF, D, DFF, Wl + W_GU, 2, tile);
    convert_job(p.in[5] + (size_t)l * DFF * D, DFF, D, Wl + W_WD, 0, tile);
    convert_job(p.in[27] + (size_t)l * D * DFF, D, DFF, Wl + W_GU2, 1, tile);
    convert_job(p.in[28] + (size_t)l * D * DFF, D, DFF, Wl + W_GU2, 2, tile);
    convert_job(p.in[29] + (size_t)l * DFF * D, DFF, D, Wl + W_WD2, 0, tile);
    convert_job(p.in[7] + (size_t)l * D * INC, D, INC, Wl + W_IN, 0, tile);
    convert_job(p.in[22] + (size_t)l * 512 * D, 512, D, Wl + W_PA, 0, tile);
    convert_job(p.in[23] + (size_t)l * 256 * D, 256, D, Wl + W_PB, 0, tile);
    convert_job(p.in[24] + (size_t)l * 256 * D, 256, D, Wl + W_PC, 0, tile);
    convert_job(p.in[25] + (size_t)l * D * D, D, D, Wl + W_OUT, 0, tile);
    convert_job(p.in[16] + (size_t)l * 128 * 512, 128, 512, Wl + W_G2, 0, tile);
  }
}

DI void phase_norm(const float* __restrict__ src, const float* __restrict__ gam, bf16_t* __restrict__ xn, float* __restrict__ fout) {
  const int tid_ = otid(), lane = tid_ & 63, w = tid_ >> 6;
  f32x4 g[4];
#pragma unroll
  for (int i = 0; i < 4; ++i) g[i] = *(const f32x4*)(gam + i * 256 + lane * 4);
  const int stride = gridDim.x * 8;
  auto ld = [&](f32x4 (&v)[4], int row) {
    if (row < HT) {
#pragma unroll
      for (int i = 0; i < 4; ++i) v[i] = *(const f32x4*)(src + (size_t)row * D + i * 256 + lane * 4);
    }
  };
  auto proc = [&](const f32x4 (&v)[4], int row) {
    float ss = 0.f;
#pragma unroll
    for (int i = 0; i < 4; ++i) ss += (v[i][0] * v[i][0] + v[i][1] * v[i][1]) + (v[i][2] * v[i][2] + v[i][3] * v[i][3]);
    ss = wave_sum(ss);
    const float rs = rsqrtf(ss * (1.0f / 1024.0f) + 1e-6f);
#pragma unroll
    for (int i = 0; i < 4; ++i) {
      const f32x4 y = v[i] * rs * g[i];
      if (fout) *(f32x4*)(fout + (size_t)row * D + i * 256 + lane * 4) = y;
      else *(uint2*)(xn + (size_t)row * D + i * 256 + lane * 4) = make_uint2(pack2(y[0], y[1]), pack2(y[2], y[3]));
    }
  };
  int t = blockIdx.x * 8 + w;
  f32x4 a[4], b[4];
  ld(a, t); ld(b, t + stride);
  for (; t < HT; t += 2 * stride) {
    f32x4 na[4], nb[4];
    ld(na, t + 2 * stride); ld(nb, t + 3 * stride);
    proc(a, t);
    if (t + stride < HT) proc(b, t + stride);
#pragma unroll
    for (int i = 0; i < 4; ++i) { a[i] = na[i]; b[i] = nb[i]; }
  }
}

constexpr int RS = 144;
typedef __attribute__((address_space(3))) unsigned lds_u32;
DI void glds16(const void* g, unsigned char* l) { __builtin_amdgcn_global_load_lds((const unsigned*)g, (lds_u32*)l, 16, 0, 0); }
template <int N> DI void wait_vm() { asm volatile("s_waitcnt vmcnt(%0)" :: "n"(N) : "memory"); }
template <int MT, int NT, int WR, int WC>
DI void gemm_block(const bf16_t* __restrict__ A, int lda, const bf16_t* __restrict__ B, int ldb, int K, f32x4 (&acc)[MT][NT], unsigned char* smem,
                   bool primed = false, const bf16_t* __restrict__ nA = nullptr, int nlda = 0, const bf16_t* __restrict__ nB = nullptr, int nldb = 0) {
  static_assert(WR * WC == 8, "8 waves");
  constexpr int AR = 16 * MT * WR, BR = 16 * NT * WC;
  constexpr int AB = AR * 128, BB = BR * 128, STG = AB + BB;
  constexpr int NA = AR * 8 / 512, NB = BR * 8 / 512;
  const int tid = otid(), lane = tid & 63, w = tid >> 6, wr = w / WC, wc = w % WC, fr = lane & 15, fq = lane >> 4;
  const int srow = tid >> 3, kch = (tid & 7) ^ ((tid >> 4) & 7);
  const unsigned voA = (unsigned)(srow * lda + kch * 8) * 2u, voB = (unsigned)(srow * ldb + kch * 8) * 2u;
  const char* Ab = (const char*)A;
  const char* Bb = (const char*)B;
  const int nk = K >> 6;
  if (!primed) {
#pragma unroll
    for (int i = 0; i < NA; ++i) glds16(Ab + (size_t)i * 128 * lda + voA, smem + (i * 512 + tid) * 16);
#pragma unroll
    for (int i = 0; i < NB; ++i) glds16(Bb + (size_t)i * 128 * ldb + voB, smem + AB + (i * 512 + tid) * 16);
  }
  const int sw = (fr >> 1) & 7;
  const unsigned lds_base = (unsigned)(size_t)(__attribute__((address_space(3))) unsigned char*)smem;
  const unsigned a_row = (wr * 16 * MT + fr) * 128, b_row = AB + (wc * 16 * NT + fr) * 128;
  for (int kt = 0; kt < nk; ++kt) {
    wait_vm<0>();
    __builtin_amdgcn_s_barrier();
    if (kt + 1 < nk) {
      unsigned char* sn = smem + ((kt + 1) & 1) * STG;
      const int ko = (kt + 1) * 64;
#pragma unroll
      for (int i = 0; i < NA; ++i) glds16(Ab + ((size_t)i * 128 * lda + ko * 2) + voA, sn + (i * 512 + tid) * 16);
#pragma unroll
      for (int i = 0; i < NB; ++i) glds16(Bb + ((size_t)i * 128 * ldb + ko * 2) + voB, sn + AB + (i * 512 + tid) * 16);
    } else if (nA) {
      const unsigned nvoA = (unsigned)(srow * nlda + kch * 8) * 2u, nvoB = (unsigned)(srow * nldb + kch * 8) * 2u;
#pragma unroll
      for (int i = 0; i < NA; ++i) glds16((const char*)nA + (size_t)i * 128 * nlda + nvoA, smem + (i * 512 + tid) * 16);
#pragma unroll
      for (int i = 0; i < NB; ++i) glds16((const char*)nB + (size_t)i * 128 * nldb + nvoB, smem + AB + (i * 512 + tid) * 16);
    }
    const unsigned stb = lds_base + (kt & 1) * STG;
#pragma unroll
    for (int ks = 0; ks < 2; ++ks) {
      const unsigned co = ((ks * 4 + fq) ^ sw) * 16;
      const unsigned sa = stb + a_row + co, sb = stb + b_row + co;
      bf16x8 af[4], bfr[NT];
#pragma unroll
      for (int n = 0; n < NT; ++n) asm volatile("ds_read_b128 %0, %1 offset:%2" : "=v"(bfr[n]) : "v"(sb), "n"(n * 2048) : "memory");
#pragma unroll
      for (int mg = 0; mg < MT / 4; ++mg) {
#pragma unroll
        for (int m = 0; m < 4; ++m) asm volatile("ds_read_b128 %0, %1 offset:%2" : "=v"(af[m]) : "v"(sa), "n"((mg * 4 + m) * 2048) : "memory");
        if (mg == 0) {
#pragma unroll
          for (int n = 0; n < NT; ++n) asm volatile("s_waitcnt lgkmcnt(%1)" : "+v"(bfr[n]) : "n"(4 + NT - 1 - n) : "memory");
        }
#pragma unroll
        for (int m = 0; m < 4; ++m) {
          asm volatile("s_waitcnt lgkmcnt(%1)" : "+v"(af[m]) : "n"(3 - m) : "memory");
#pragma unroll
          for (int n = 0; n < NT; ++n) acc[mg * 4 + m][n] = MFMA16(bfr[n], af[m], acc[mg * 4 + m][n]);
        }
      }
    }
  }
  if (!nA) __syncthreads();
}

template <int MT, int NT>
DI void zero_acc(f32x4 (&acc)[MT][NT]) {
#pragma unroll
  for (int m = 0; m < MT; ++m)
#pragma unroll
    for (int n = 0; n < NT; ++n) acc[m][n] = (f32x4){0.f, 0.f, 0.f, 0.f};
}

DI void tile_coords(int id, int nN, int& pm, int& pn) {
  const int band = id / (16 * nN), r = id % (16 * nN);
  pm = band * 16 + (r & 15); pn = r >> 4;
}

DI void phase_ffn_up(const bf16_t* __restrict__ xn, const bf16_t* __restrict__ gu, bf16_t* __restrict__ hid, unsigned char* smem) {
  const int tid_ = otid(), lane = tid_ & 63, w = tid_ >> 6, wr = w >> 2, wc = w & 3, fr = lane & 15, fq = lane >> 4;
  constexpr int nN = 2 * DFF / 256, nM = HT / 256;
  for (int id = blockIdx.x; id < nM * nN; id += gridDim.x) {
    int pm, pn; tile_coords(id, nN, pm, pn);
    f32x4 acc[8][4]; zero_acc(acc);
    {
      const int idn = id + gridDim.x; int pm2 = 0, pn2 = 0; const bool hn = idn < nM * nN; if (hn) tile_coords(idn, nN, pm2, pn2);
      gemm_block<8, 4, 2, 4>(xn + (size_t)pm * 256 * D, D, gu + (size_t)pn * 256 * D, D, D, acc, smem, id != (int)blockIdx.x,
                             hn ? xn + (size_t)pm2 * 256 * D : nullptr, D, gu + (size_t)pn2 * 256 * D, D);
    }
    const int hc0 = (pn * 4 + wc) * 32 + fq * 4;
#pragma unroll
    for (int m = 0; m < 8; ++m) {
      const size_t row = (size_t)pm * 256 + wr * 128 + m * 16 + fr;
#pragma unroll
      for (int n = 0; n < 2; ++n) {
        float h[4];
#pragma unroll
        for (int j = 0; j < 4; ++j) { const float g = acc[m][n][j], u = acc[m][n + 2][j]; h[j] = g * rcp_(1.0f + __expf(-g)) * u; }
        *(uint2*)(hid + row * DFF + hc0 + n * 16) = make_uint2(pack2(h[0], h[1]), pack2(h[2], h[3]));
      }
    }
  }
}

DI void phase_gemm_resid(const bf16_t* __restrict__ A, int K, const bf16_t* __restrict__ Bt, const float* __restrict__ xin, float* __restrict__ xout, float alpha, unsigned char* smem) {
  const int tid_ = otid(), lane = tid_ & 63, w = tid_ >> 6, wr = w >> 2, wc = w & 3, fr = lane & 15, fq = lane >> 4;
  constexpr int nN = D / 256, nM = HT / 256;
  for (int id = blockIdx.x; id < nM * nN; id += gridDim.x) {
    int pm, pn; tile_coords(id, nN, pm, pn);
    f32x4 acc[8][4]; zero_acc(acc);
    {
      const int idn = id + gridDim.x; int pm2 = 0, pn2 = 0; const bool hn = idn < nM * nN; if (hn) tile_coords(idn, nN, pm2, pn2);
      gemm_block<8, 4, 2, 4>(A + (size_t)pm * 256 * K, K, Bt + (size_t)pn * 256 * K, K, K, acc, smem, id != (int)blockIdx.x,
                             hn ? A + (size_t)pm2 * 256 * K : nullptr, K, Bt + (size_t)pn2 * 256 * K, K);
    }
#pragma unroll
    for (int m = 0; m < 8; ++m) {
      const size_t row = (size_t)pm * 256 + wr * 128 + m * 16 + fr;
#pragma unroll
      for (int n = 0; n < 4; ++n) {
        const size_t o = row * D + pn * 256 + wc * 64 + n * 16 + fq * 4;
        const f32x4 x = *(const f32x4*)(xin + o);
        *(f32x4*)(xout + o) = x + alpha * acc[m][n];
      }
    }
  }
}

DI void phase_proj(const bf16_t* __restrict__ xn, const bf16_t* __restrict__ wint, bf16_t* __restrict__ z, unsigned char* smem) {
  const int tid_ = otid(), lane = tid_ & 63, w = tid_ >> 6, wr = w >> 2, wc = w & 3, fr = lane & 15, fq = lane >> 4;
  constexpr int nN = ZC / 256, nM = HT / 256;
  for (int id = blockIdx.x; id < nM * nN; id += gridDim.x) {
    int pm, pn; tile_coords(id, nN, pm, pn);
    f32x4 acc[8][4]; zero_acc(acc);
    {
      const int idn = id + gridDim.x; int pm2 = 0, pn2 = 0; const bool hn = idn < nM * nN; if (hn) tile_coords(idn, nN, pm2, pn2);
      gemm_block<8, 4, 2, 4>(xn + (size_t)pm * 256 * D, D, wint + (size_t)pn * 256 * D, D, D, acc, smem, id != (int)blockIdx.x,
                             hn ? xn + (size_t)pm2 * 256 * D : nullptr, D, wint + (size_t)pn2 * 256 * D, D);
    }
#pragma unroll
    for (int m = 0; m < 8; ++m) {
      const size_t row = (size_t)pm * 256 + wr * 128 + m * 16 + fr;
#pragma unroll
      for (int n = 0; n < 4; ++n) {
        const f32x4 a = acc[m][n];
        *(uint2*)(z + row * ZC + pn * 256 + wc * 64 + n * 16 + fq * 4) = make_uint2(pack2(a[0], a[1]), pack2(a[2], a[3]));
      }
    }
  }
}

DI void phase_ya(const Params& p, int l, int L, const bf16_t* __restrict__ sg, const bf16_t* __restrict__ g2t, const bf16_t* __restrict__ z,
                 bf16_t* __restrict__ yf, const bf16_t* __restrict__ yb, const float* __restrict__ bon, unsigned char* smem) {
  const int tid_ = otid(), lane = tid_ & 63, w = tid_ >> 6, wr = w >> 2, wc = w & 3, fr = lane & 15, fq = lane >> 4;
  constexpr int nN = 2, nM = HT / 256;
  const float* mu0 = p.in[8] + (size_t)l * 2 * 1792;
  const float* mu1 = mu0 + 1792;
  const float* lng = p.in[17] + (size_t)l * CA;
  const float* lnb = p.in[18] + (size_t)l * CA;
  for (int id = blockIdx.x; id < nM * nN; id += gridDim.x) {
    int pm, pn; tile_coords(id, nN, pm, pn);
    f32x4 acc[8][4]; zero_acc(acc);
    {
      const int idn = id + gridDim.x; int pm2 = 0, pn2 = 0; const bool hn = idn < nM * nN; if (hn) tile_coords(idn, nN, pm2, pn2);
      gemm_block<8, 4, 2, 4>(sg + (size_t)pm * 256 * 128, 128, g2t + (size_t)pn * 256 * 128, 128, 128, acc, smem, id != (int)blockIdx.x,
                             hn ? sg + (size_t)pm2 * 256 * 128 : nullptr, 128, g2t + (size_t)pn2 * 256 * 128, 128);
    }
    const int h = pn * 4 + wc;
#pragma unroll
    for (int m = 0; m < 8; ++m) {
      const int row = pm * 256 + wr * 128 + m * 16 + fr;
      const int t = row % L;
      const bool hasp = t > 0, hasn = t < L - 1;
      float y[4][4];
      float s = 0.f;
#pragma unroll
      for (int n = 0; n < 4; ++n) {
        const int c = h * 64 + n * 16 + fq * 4;
        const uint2 a = *(const uint2*)(yf + (size_t)row * CA + c);
        const uint2 b = *(const uint2*)(yb + (size_t)row * CA + c);
        y[n][0] = lo2f(a.x) + lo2f(b.x); y[n][1] = hi2f(a.x) + hi2f(b.x); y[n][2] = lo2f(a.y) + lo2f(b.y); y[n][3] = hi2f(a.y) + hi2f(b.y);
        s += (y[n][0] + y[n][1]) + (y[n][2] + y[n][3]);
      }
      s = fq_sum(s);
      const float mean = s * (1.0f / 64.0f);
      float q = 0.f;
#pragma unroll
      for (int n = 0; n < 4; ++n)
#pragma unroll
        for (int j = 0; j < 4; ++j) { const float d = y[n][j] - mean; q += d * d; }
      q = fq_sum(q);
      const float rstd = rsqrtf(q * (1.0f / 64.0f) + 64e-5f);
      const float bsum = bon[(size_t)row * 8 + h] + bon[(size_t)HT * 8 + (size_t)row * 8 + h];
#pragma unroll
      for (int n = 0; n < 4; ++n) {
        const int c = h * 64 + n * 16 + fq * 4;
        const bf16_t* zr = z + (size_t)row * ZC + 1024 + c;
        const uint2 v0 = *(const uint2*)zr;
        uint2 vp = make_uint2(0u, 0u), vn = make_uint2(0u, 0u);
        if (hasp) vp = *(const uint2*)(zr - ZC);
        if (hasn) vn = *(const uint2*)(zr + ZC);
        const f32x4 m0 = *(const f32x4*)(mu0 + 1024 + c), m1 = *(const f32x4*)(mu1 + 1024 + c);
        const f32x4 gg = *(const f32x4*)(lng + c), bb = *(const f32x4*)(lnb + c);
        const float vc[4] = {lo2f(v0.x), hi2f(v0.x), lo2f(v0.y), hi2f(v0.y)};
        const float vpp[4] = {lo2f(vp.x), hi2f(vp.x), lo2f(vp.y), hi2f(vp.y)};
        const float vnn[4] = {lo2f(vn.x), hi2f(vn.x), lo2f(vn.y), hi2f(vn.y)};
        float o[4];
#pragma unroll
        for (int j = 0; j < 4; ++j) {
          const float vs = vc[j] + m0[j] * (vpp[j] - vc[j]) + m1[j] * (vnn[j] - vc[j]);
          o[j] = ((y[n][j] - mean) * rstd * gg[j] + bb[j] + bsum * vs) * acc[m][n][j];
        }
        *(uint2*)(yf + (size_t)row * CA + c) = make_uint2(pack2(o[0], o[1]), pack2(o[2], o[3]));
      }
    }
  }
}

DI void phase_merge(const bf16_t* __restrict__ xn, const bf16_t* __restrict__ Wl, const bf16_t* __restrict__ ya, const bf16_t* __restrict__ yn, const bf16_t* __restrict__ yd,
                    bf16_t* __restrict__ mo, unsigned char* smem) {
  const int tid_ = otid(), lane = tid_ & 63, w = tid_ >> 6, wr = w >> 1, wc = w & 1, fr = lane & 15, fq = lane >> 4;
  constexpr int nN = D / 128, nM = HT / 256;
  for (int id = blockIdx.x; id < nM * nN; id += gridDim.x) {
    int pm, pn; tile_coords(id, nN, pm, pn);
    unsigned tot[4][4][2];
#pragma unroll 1
    for (int i = 0; i < 3; ++i) {
      unsigned gp[4][4][2];
      {
        f32x4 ag[4][4]; zero_acc(ag);
        const bf16_t* Yn = (i == 0) ? ya : (i == 1 ? yn : yd);
        const int Kn = (i == 0) ? 512 : 256;
        const bf16_t* Pn = Wl + (i == 0 ? W_PA : (i == 1 ? W_PB : W_PC));
        gemm_block<4, 4, 4, 2>(xn + (size_t)pm * 256 * D, D, Wl + W_IN + (size_t)(ZC + i * 1024 + pn * 128) * D, D, D, ag, smem, !(i == 0 && id == (int)blockIdx.x),
                               Yn + (size_t)pm * 256 * Kn, Kn, Pn + (size_t)pn * 128 * Kn, Kn);
#pragma unroll
        for (int m = 0; m < 4; ++m)
#pragma unroll
          for (int n = 0; n < 4; ++n) {
            gp[m][n][0] = pack2(sigmoidf_(ag[m][n][0]), sigmoidf_(ag[m][n][1]));
            gp[m][n][1] = pack2(sigmoidf_(ag[m][n][2]), sigmoidf_(ag[m][n][3]));
          }
      }
      f32x4 ay[4][4]; zero_acc(ay);
      const bf16_t* Y = (i == 0) ? ya : (i == 1 ? yn : yd);
      const int Ki = (i == 0) ? 512 : 256;
      const bf16_t* P = Wl + (i == 0 ? W_PA : (i == 1 ? W_PB : W_PC));
      {
        const int idn = id + gridDim.x; int pm2 = pm, pn2 = pn, i2 = i + 1; bool hn = true;
        if (i == 2) { i2 = 0; hn = idn < nM * nN; if (hn) tile_coords(idn, nN, pm2, pn2); }
        gemm_block<4, 4, 4, 2>(Y + (size_t)pm * 256 * Ki, Ki, P + (size_t)pn * 128 * Ki, Ki, Ki, ay, smem, true,
                               hn ? xn + (size_t)pm2 * 256 * D : nullptr, D, Wl + W_IN + (size_t)(ZC + i2 * 1024 + pn2 * 128) * D, D);
      }
#pragma unroll
      for (int m = 0; m < 4; ++m)
#pragma unroll
        for (int n = 0; n < 4; ++n) {
          float t0 = ay[m][n][0] * lo2f(gp[m][n][0]), t1 = ay[m][n][1] * hi2f(gp[m][n][0]);
          float t2 = ay[m][n][2] * lo2f(gp[m][n][1]), t3 = ay[m][n][3] * hi2f(gp[m][n][1]);
          if (i > 0) { t0 += lo2f(tot[m][n][0]); t1 += hi2f(tot[m][n][0]); t2 += lo2f(tot[m][n][1]); t3 += hi2f(tot[m][n][1]); }
          tot[m][n][0] = pack2(t0, t1); tot[m][n][1] = pack2(t2, t3);
        }
    }
#pragma unroll
    for (int m = 0; m < 4; ++m) {
      const size_t row = (size_t)pm * 256 + wr * 64 + m * 16 + fr;
#pragma unroll
      for (int n = 0; n < 4; ++n)
        *(uint2*)(mo + row * D + pn * 128 + wc * 64 + n * 16 + fq * 4) = make_uint2(tot[m][n][0], tot[m][n][1]);
    }
  }
}

DI void item_sg(const Params& p, int l, int L, int item, const bf16_t* __restrict__ z, bf16_t* __restrict__ sg) {
  const int tid_ = otid() & 255, lane = tid_ & 63, w = tid_ >> 6;
  const float* mu0 = p.in[8] + (size_t)l * 2 * 1792 + 1664 + 2 * lane;
  const float* mu1 = mu0 + 1792;
  const float m0a = mu0[0], m0b = mu0[1], m1a = mu1[0], m1b = mu1[1];
  for (int i = w; i < 256; i += 4) {
    const int row = item * 256 + i;
    const int t = row % L;
    const bf16_t* zr = z + (size_t)row * ZC + 1664 + 2 * lane;
    const unsigned c = *(const unsigned*)zr;
    const unsigned pv = (t > 0) ? *(const unsigned*)(zr - ZC) : 0u;
    const unsigned nv = (t < L - 1) ? *(const unsigned*)(zr + ZC) : 0u;
    const float ca = lo2f(c), cb = hi2f(c);
    const float ga = ca + m0a * (lo2f(pv) - ca) + m1a * (lo2f(nv) - ca);
    const float gb = cb + m0b * (hi2f(pv) - cb) + m1b * (hi2f(nv) - cb);
    *(unsigned*)(sg + (size_t)row * 128 + 2 * lane) = pack2(sigmoidf_(ga), sigmoidf_(gb));
  }
}

DI void item_scan(const Params& p, int l, int L, int b, int h, int dir, const bf16_t* __restrict__ z, bf16_t* __restrict__ yout, float* __restrict__ bon, unsigned char* smem) {
  const int tid = otid() & 255, lane = tid & 63, w = tid >> 6, fr = lane & 15, fq = lane >> 4;
  unsigned* ZR = (unsigned*)smem;
  float* VR = (float*)(smem + 11520);
  float* VD = VR + 1024; float* VK = VD + 1024; float* VV = VK + 1024; float* VA = VV + 1024; float* VB = VA + 1024;
  float* YO = VB + 1024;
  float* BO = YO + 1024;
  unsigned char* WT = (unsigned char*)(BO + 16);
  unsigned char* AL = WT + 16 * RS;
  float* MU = (float*)(AL + 16 * RS);
  float* KKC = MU + 640;
  const size_t tok0 = (size_t)b * L;
  const float* mu0 = p.in[8] + (size_t)l * 2 * 1792;
  const float* mu1 = mu0 + 1792;
  const int cA = lane;
  __syncthreads();
  for (int i = tid; i < 640; i += 256) {
    const int s5 = i >> 7, d = (i >> 6) & 1, c = i & 63;
    const int col = (s5 < 3) ? (s5 * 512 + h * 64 + c) : (1536 + (s5 - 3) * 64 + c);
    MU[i] = (d ? mu1 : mu0)[col];
  }
  if (tid < 64) KKC[tid] = p.in[15][(size_t)l * CA + h * 64 + tid];
  const float rkc = p.in[14][((size_t)l * 2 + dir) * CA + h * 64 + cA];
  const int cB = w * 16 + fr;
  const float w0c = p.in[9][((size_t)l * 2 + dir) * CA + h * 64 + cB];
  const float a0c = p.in[11][((size_t)l * 2 + dir) * CA + h * 64 + cB];
  const float kac = p.in[13][((size_t)l * 2 + dir) * CA + h * 64 + cB];
  bf16x8 bw[2], ba[2];
  {
    const float* w2 = p.in[10] + ((size_t)l * 2 + dir) * 64 * CA + h * 64 + cB;
    const float* a2 = p.in[12] + ((size_t)l * 2 + dir) * 64 * CA + h * 64 + cB;
#pragma unroll
    for (int ks = 0; ks < 2; ++ks)
#pragma unroll
      for (int j = 0; j < 8; ++j) {
        bw[ks][j] = (short)f2bf(w2[(size_t)(ks * 32 + fq * 8 + j) * CA]);
        ba[ks][j] = (short)f2bf(a2[(size_t)(ks * 32 + fq * 8 + j) * CA]);
      }
  }
  const int kq = lane & 7, v0 = w * 16 + (lane >> 3) * 2;
  f32x2 S0[4], S1[4];
#pragma unroll
  for (int i = 0; i < 4; ++i) { S0[i] = (f32x2){0.f, 0.f}; S1[i] = (f32x2){0.f, 0.f}; }

  unsigned pf[12], poff[12];
  unsigned vbits = 0u, r0bits = 0u, r17bits = 0u, pf_ok = 0u;
#pragma unroll
  for (int i = 0; i < 12; ++i) {
    const int q = tid + i * 256;
    const int row = q / 160, pr = q - row * 160;
    const int col = (pr < 96) ? ((pr >> 5) * 512 + h * 64 + (pr & 31) * 2) : (1536 + (pr - 96) * 2);
    poff[i] = (q < 2880) ? (unsigned)(row * ZC + col) * 2u : 0u;
    if (q < 2880) vbits |= 1u << i;
    if (row == 0) r0bits |= 1u << i;
    if (row == 17) r17bits |= 1u << i;
  }
  auto prefetch = [&](int tc) {
    const char* zc = (const char*)(z + (tok0 + tc) * ZC) - (size_t)ZC * 2;
    pf_ok = vbits & ~((tc == 0) ? r0bits : 0u) & ~((tc == L - 16) ? r17bits : 0u);
#pragma unroll
    for (int i = 0; i < 12; ++i)
      pf[i] = *(const unsigned*)(zc + (((pf_ok >> i) & 1u) ? poff[i] : (unsigned)(ZC * 2)));
  };
  auto output = [&](int tco) {
    const int tt = tid >> 4, pj = tid & 15;
    const f32x2 ya = *(const f32x2*)(YO + tt * 64 + 2 * pj), yb2 = *(const f32x2*)(YO + tt * 64 + 32 + 2 * pj);
    bf16_t* yp = yout + (tok0 + tco + tt) * CA + h * 64 + 2 * pj;
    *(unsigned*)yp = pack2(ya[0], ya[1]);
    *(unsigned*)(yp + 32) = pack2(yb2[0], yb2[1]);
    if (tid < 16) bon[(tok0 + tco + tid) * 8 + h] = BO[tid];
  };
  const int nch = L / 16;
  prefetch(dir ? L - 16 : 0);
  int tc_prev = 0;
  for (int ci = 0; ci < nch; ++ci) {
    const int tc = dir ? (L - 16 - 16 * ci) : 16 * ci;
#pragma unroll
    for (int i = 0; i < 12; ++i) { const int q = tid + i * 256; if (q < 2880) ZR[q] = ((pf_ok >> i) & 1u) ? pf[i] : 0u; }
    __syncthreads();
    if (ci > 0) output(tc_prev);
    tc_prev = tc;
    if (ci + 1 < nch) prefetch(dir ? (tc - 16) : (tc + 16));
    {
      const int tt = tid >> 4, j = tid & 15;
      float kq2[4];
      float ksum = 0.f;
      unsigned zu[2][5][3];
      f32x2 mm[2][5][2];
#pragma unroll
      for (int hp = 0; hp < 2; ++hp)
#pragma unroll
        for (int s5 = 0; s5 < 5; ++s5) {
          const int pr = j + 16 * hp, pi = s5 * 32 + pr;
          zu[hp][s5][0] = ZR[tt * 160 + pi]; zu[hp][s5][1] = ZR[(tt + 1) * 160 + pi]; zu[hp][s5][2] = ZR[(tt + 2) * 160 + pi];
          mm[hp][s5][0] = *(const f32x2*)(MU + (s5 * 2) * 64 + 2 * pr); mm[hp][s5][1] = *(const f32x2*)(MU + (s5 * 2 + 1) * 64 + 2 * pr);
        }
#pragma unroll
      for (int hp = 0; hp < 2; ++hp) {
        const int pr = j + 16 * hp, c = 2 * pr;
        float zs[5][2];
#pragma unroll
        for (int s5 = 0; s5 < 5; ++s5) {
          const unsigned up = zu[hp][s5][0], uc = zu[hp][s5][1], un = zu[hp][s5][2];
          const f32x2 m0 = mm[hp][s5][0], m1 = mm[hp][s5][1];
          const float c0 = lo2f(uc), c1 = hi2f(uc);
          zs[s5][0] = c0 + m0[0] * (lo2f(up) - c0) + m1[0] * (lo2f(un) - c0);
          zs[s5][1] = c1 + m0[1] * (hi2f(up) - c1) + m1[1] * (hi2f(un) - c1);
        }
        *(f32x2*)(VR + tt * 64 + c) = (f32x2){zs[0][0], zs[0][1]};
        *(f32x2*)(VK + tt * 64 + c) = (f32x2){zs[1][0], zs[1][1]};
        *(f32x2*)(VV + tt * 64 + c) = (f32x2){zs[2][0], zs[2][1]};
        const f32x2 kc = *(const f32x2*)(KKC + c);
        kq2[2 * hp] = zs[1][0] * kc[0]; kq2[2 * hp + 1] = zs[1][1] * kc[1];
        ksum += kq2[2 * hp] * kq2[2 * hp] + kq2[2 * hp + 1] * kq2[2 * hp + 1];
        const float t0 = 1.0f - 2.0f * rcp_(__expf(2.0f * zs[3][0]) + 1.0f);
        const float t1 = 1.0f - 2.0f * rcp_(__expf(2.0f * zs[3][1]) + 1.0f);
        *(unsigned*)(WT + tt * RS + c * 2) = pack2(t0, t1);
        *(unsigned*)(AL + tt * RS + c * 2) = pack2(zs[4][0], zs[4][1]);
      }
      ksum = row_sum16(ksum);
      const float inv = rcp_(fmaxf(sqrtf(ksum), 1e-12f));
      *(f32x2*)(VA + tt * 64 + 2 * j) = (f32x2){kq2[0] * inv, kq2[1] * inv};
      *(f32x2*)(VA + tt * 64 + 2 * j + 32) = (f32x2){kq2[2] * inv, kq2[3] * inv};
    }
    __syncthreads();
    {
      f32x4 aw = {0.f, 0.f, 0.f, 0.f}, aa = {0.f, 0.f, 0.f, 0.f};
#pragma unroll
      for (int ks = 0; ks < 2; ++ks) {
        const bf16x8 fw = *(const bf16x8*)(WT + fr * RS + ks * 64 + fq * 16);
        const bf16x8 fa = *(const bf16x8*)(AL + fr * RS + ks * 64 + fq * 16);
        aw = MFMA16(fw, bw[ks], aw);
        aa = MFMA16(fa, ba[ks], aa);
      }
#pragma unroll
      for (int j = 0; j < 4; ++j) {
        const int tt = fq * 4 + j;
        const float x = w0c + aw[j];
        const float yv = -x;
        const float sp = fmaxf(yv, 0.f) + __logf(1.0f + __expf(-fabsf(yv)));
        const float e = __expf(-sp - 0.5f);
        const float dcy = __expf(-e);
        const float a = sigmoidf_(a0c + aa[j]);
        const float k = VK[tt * 64 + cB], kk = VA[tt * 64 + cB];
        VD[tt * 64 + cB] = dcy;
        VK[tt * 64 + cB] = k * (1.0f + (a - 1.0f) * kac);
        VA[tt * 64 + cB] = -kk;
        VB[tt * 64 + cB] = kk * a;
      }
    }
    __syncthreads();
    float pc[4];
#pragma unroll
    for (int i = 0; i < 4; ++i) { const int tt = w * 4 + i; pc[i] = VR[tt * 64 + cA] * VK[tt * 64 + cA] * rkc; }
#pragma unroll
    for (int i = 0; i < 4; ++i) {
      const int tt = w * 4 + i;
      const float s = wave_sum(pc[i]);
      if (lane == 0) BO[tt] = s;
    }
    {
      struct VA_ { f32x4 A0, A1; f32x2 V; };
      auto loada = [&](VA_& q, int off, int voff) {
        q.A0 = *(const f32x4*)(VA + off); q.A1 = *(const f32x4*)(VA + off + 4);
        q.V = *(const f32x2*)(VV + voff);
      };
      auto stepf = [&](const VA_& c, VA_& nx, int off, int voff, int offn, int voffn, bool has_next) {
        const f32x4 D0 = *(const f32x4*)(VD + off), D1 = *(const f32x4*)(VD + off + 4);
        const f32x4 B0 = *(const f32x4*)(VB + off), B1 = *(const f32x4*)(VB + off + 4);
        const f32x4 K0 = *(const f32x4*)(VK + off), K1 = *(const f32x4*)(VK + off + 4);
        const f32x4 R0 = *(const f32x4*)(VR + off), R1 = *(const f32x4*)(VR + off + 4);
        if (has_next) loada(nx, offn, voffn);
        const f32x2 a[4] = {{c.A0[0], c.A0[1]}, {c.A0[2], c.A0[3]}, {c.A1[0], c.A1[1]}, {c.A1[2], c.A1[3]}};
        const f32x2 d[4] = {{D0[0], D0[1]}, {D0[2], D0[3]}, {D1[0], D1[1]}, {D1[2], D1[3]}};
        const f32x2 bb[4] = {{B0[0], B0[1]}, {B0[2], B0[3]}, {B1[0], B1[1]}, {B1[2], B1[3]}};
        const f32x2 kk[4] = {{K0[0], K0[1]}, {K0[2], K0[3]}, {K1[0], K1[1]}, {K1[2], K1[3]}};
        const f32x2 rr[4] = {{R0[0], R0[1]}, {R0[2], R0[3]}, {R1[0], R1[1]}, {R1[2], R1[3]}};
        const f32x2 p0 = (S0[0] * a[0] + S0[1] * a[1]) + (S0[2] * a[2] + S0[3] * a[3]);
        const f32x2 p1 = (S1[0] * a[0] + S1[1] * a[1]) + (S1[2] * a[2] + S1[3] * a[3]);
        const float sa0 = oct_sum(p0[0] + p0[1]);
        const float sa1 = oct_sum(p1[0] + p1[1]);
        f32x2 y0a = {0.f, 0.f}, y0b = {0.f, 0.f}, y1a = {0.f, 0.f}, y1b = {0.f, 0.f};
#pragma unroll
        for (int i = 0; i < 4; ++i) {
          const f32x2 n0 = S0[i] * d[i] + (sa0 * bb[i] + c.V[0] * kk[i]);
          const f32x2 n1 = S1[i] * d[i] + (sa1 * bb[i] + c.V[1] * kk[i]);
          S0[i] = n0; S1[i] = n1;
          if (i & 1) { y0b += n0 * rr[i]; y1b += n1 * rr[i]; } else { y0a += n0 * rr[i]; y1a += n1 * rr[i]; }
        }
        const f32x2 y0 = y0a + y0b, y1 = y1a + y1b;
        float ys0 = y0[0] + y0[1], ys1 = y1[0] + y1[1];
        asm volatile("" : "+v"(ys0));
        asm volatile("" : "+v"(ys1));
        oct_sum_pair(ys0, ys1);
        *(f32x2*)(YO + voff) = (f32x2){ys0, ys1};
      };
      const int dstep = dir ? -64 : 64;
      int off = (dir ? 15 * 64 : 0) + kq * 8, voff = (dir ? 15 * 64 : 0) + v0;
      VA_ X, Y;
      loada(X, off, voff);
#pragma unroll 1
      for (int it2 = 0; it2 < 8; ++it2) {
        stepf(X, Y, off, voff, off + dstep, voff + dstep, true);
        stepf(Y, X, off + dstep, voff + dstep, off + 2 * dstep, voff + 2 * dstep, it2 < 7);
        off += 2 * dstep; voff += 2 * dstep;
      }
    }
  }
  __syncthreads();
  output(tc_prev);
  __syncthreads();
}

template <int MODE>
DI void item_attn(const Params& p, int l, int L, int b, int h, int qi, const bf16_t* __restrict__ z, bf16_t* __restrict__ yo, unsigned char* smem, unsigned char* smc) {
  const int tid = otid() & 255, lane = tid & 63, w = tid >> 6, fr = lane & 15, fq = lane >> 4;
  unsigned char* KV0 = (MODE == 1) ? smc : smem;
  constexpr int NLD = (MODE == 1) ? 1 : 2;
  const int t5 = (MODE == 1) ? (tid + (int)(smem - smc) / 256) : tid;
  const int vkey = (MODE == 1) ? (t5 & 63) : lane, vdc0 = (MODE == 1) ? (t5 >> 6) : 2 * w;
  float* RPB = (float*)(smem + 256 * RS);
  const size_t tok0 = (size_t)b * L;
  const int rows = L / 64;
  const int qcol = (MODE == 0 ? 1792 : 2560) + h * 64, kcol = qcol + 256, vcol = qcol + 512;
  const int ntile = (MODE == 0) ? 8 : rows;
  int rs = 0;
  if (MODE == 0) { rs = qi - 4; rs = rs < 0 ? 0 : (rs > rows - 8 ? rows - 8 : rs); }
  const int qc = w * 16 + fr;
  const size_t qtok = tok0 + (size_t)qi * 64 + qc;
  bf16x8 qf[2];
#pragma unroll
  for (int ks = 0; ks < 2; ++ks) qf[ks] = *(const bf16x8*)(z + qtok * ZC + qcol + ks * 32 + fq * 8);
  float lam = 0.f, lam_init = 0.f;
  if (MODE == 0) {
    __syncthreads();
    const float* rp = p.in[19] + ((size_t)l * 4 + h) * 465;
    for (int i = tid; i < 465; i += 256) RPB[i] = rp[i];
  } else {
    const float* lp = p.in[20] + (size_t)l * 128;
    float v1 = 0.f, v2 = 0.f;
    if (lane < 32) { v1 = lp[lane] * lp[32 + lane]; v2 = lp[64 + lane] * lp[96 + lane]; }
    v1 = wave_sum(v1); v2 = wave_sum(v2);
    lam_init = 0.8f - 0.6f * __expf(-0.3f * (float)l);
    lam = __expf(v1) - __expf(v2) + lam_init;
  }
  u32x4 rk[NLD], rv[NLD];
  auto load_tile = [&](int it) {
    const size_t kt0 = tok0 + (size_t)((MODE == 0) ? (rs + it) : it) * 64;
#pragma unroll
    for (int i = 0; i < NLD; ++i) {
      const int q = t5 + i * 256;
      rk[i] = *(const u32x4*)(z + (kt0 + (q >> 3)) * ZC + kcol + (q & 7) * 8);
      rv[i] = *(const u32x4*)(z + (kt0 + vkey) * ZC + vcol + (vdc0 + i) * 8);
    }
  };
  auto store_tile = [&](int buf) {
    unsigned char* KSw = KV0 + buf * (128 * RS);
    unsigned char* VTw = KSw + 64 * RS;
#pragma unroll
    for (int i = 0; i < NLD; ++i) {
      const int q = t5 + i * 256;
      *(u32x4*)(KSw + (q >> 3) * RS + (q & 7) * 16) = rk[i];
#pragma unroll
      for (int e = 0; e < 8; ++e) {
        const unsigned vwd = rv[i][e >> 1];
        const bf16_t val = (bf16_t)((e & 1) ? (vwd >> 16) : (vwd & 0xffffu));
        *(bf16_t*)(VTw + ((vdc0 + i) * 8 + e) * RS + vkey * 2) = val;
      }
    }
  };
  load_tile(0);
  store_tile(0);
  if (ntile > 1) load_tile(1);
  constexpr int NS = (MODE == 0) ? 1 : 2;
  f32x4 o[NS][4];
  float mrun[NS], lrun[NS];
#pragma unroll
  for (int s = 0; s < NS; ++s) { mrun[s] = -1e30f; lrun[s] = 0.f;
#pragma unroll
    for (int dt = 0; dt < 4; ++dt) o[s][dt] = (f32x4){0.f, 0.f, 0.f, 0.f}; }
  const float slope2 = (MODE == 1) ? exp2f(-2.0f * (float)(h + 1)) * LOG2E : 0.f;
  const float sc2 = (MODE == 0) ? 0.125f * LOG2E : 0.17677669529663687f * LOG2E;
  const int qpos = qi * 64 + qc;
  const float dbase = (float)(fq * 4 - qpos);
  int cs = qc - 8; cs = cs < 0 ? 0 : (cs > 48 ? 48 : cs);
  for (int it = 0; it < ntile; ++it) {
    __syncthreads();
    if (it + 1 < ntile) store_tile((it + 1) & 1);
    if (it + 2 < ntile) load_tile(it + 2);
    const unsigned char* KS = KV0 + (it & 1) * (128 * RS);
    const unsigned char* VT = KS + 64 * RS;
    f32x4 s[NS][4];
#pragma unroll
    for (int kt = 0; kt < 4; ++kt) {
      const bf16x8 k0 = *(const bf16x8*)(KS + (kt * 16 + fr) * RS + fq * 16);
      const bf16x8 k1 = *(const bf16x8*)(KS + (kt * 16 + fr) * RS + 64 + fq * 16);
      const f32x4 zf = {0.f, 0.f, 0.f, 0.f};
      if (MODE == 0) { s[0][kt] = MFMA16(k0, qf[0], zf); s[0][kt] = MFMA16(k1, qf[1], s[0][kt]); }
      else { s[0][kt] = MFMA16(k0, qf[0], zf); s[NS - 1][kt] = MFMA16(k1, qf[1], zf); }
    }
    float alpha[NS];
    float mx[NS];
#pragma unroll
    for (int sh = 0; sh < NS; ++sh) mx[sh] = -1e30f;
    if (MODE == 0) {
#pragma unroll
      for (int kt = 0; kt < 4; ++kt)
#pragma unroll
        for (int j = 0; j < 4; ++j) {
          const int kj = kt * 16 + fq * 4 + j;
          const bool valid = (kj >= cs) && (kj < cs + 16);
          int dc = kj - qc + 15; dc = dc < 0 ? 0 : (dc > 30 ? 30 : dc);
          const int dr = rs + it - qi + 7;
          const float t2 = valid ? (s[0][kt][j] * sc2 + RPB[dr * 31 + dc] * LOG2E) : -1e30f;
          s[0][kt][j] = t2;
          mx[0] = fmaxf(mx[0], t2);
        }
    } else {
      const float d0 = dbase + (float)(it * 64);
#pragma unroll
      for (int kt = 0; kt < 4; ++kt)
#pragma unroll
        for (int j = 0; j < 4; ++j) {
          const float ad = slope2 * fabsf(d0 + (float)(kt * 16 + j));
#pragma unroll
          for (int sh = 0; sh < NS; ++sh) {
            const float t2 = s[sh][kt][j] * sc2 - ad;
            s[sh][kt][j] = t2;
            mx[sh] = fmaxf(mx[sh], t2);
          }
        }
    }
#pragma unroll
    for (int sh = 0; sh < NS; ++sh) {
      float m1 = mx[sh];
      m1 = fq_max(m1);
      const float mn = fmaxf(mrun[sh], m1);
      alpha[sh] = __builtin_amdgcn_exp2f(mrun[sh] - mn);
      mrun[sh] = mn;
      float ps = 0.f;
#pragma unroll
      for (int kt = 0; kt < 4; ++kt)
#pragma unroll
        for (int j = 0; j < 4; ++j) { const float pe = __builtin_amdgcn_exp2f(s[sh][kt][j] - mn); s[sh][kt][j] = pe; ps += pe; }
      lrun[sh] = lrun[sh] * alpha[sh] + ps;
#pragma unroll
      for (int dt = 0; dt < 4; ++dt) o[sh][dt] = o[sh][dt] * alpha[sh];
    }
#pragma unroll
    for (int i2 = 0; i2 < 2; ++i2) {
      bf16x8 pfr[NS];
#pragma unroll
      for (int sh = 0; sh < NS; ++sh) {
        const unsigned u0 = pack2(s[sh][2 * i2][0], s[sh][2 * i2][1]), u1 = pack2(s[sh][2 * i2][2], s[sh][2 * i2][3]);
        const unsigned u2 = pack2(s[sh][2 * i2 + 1][0], s[sh][2 * i2 + 1][1]), u3 = pack2(s[sh][2 * i2 + 1][2], s[sh][2 * i2 + 1][3]);
        const u32x4 u = {u0, u1, u2, u3};
        pfr[sh] = __builtin_bit_cast(bf16x8, u);
      }
#pragma unroll
      for (int dt = 0; dt < 4; ++dt) {
        const u32x2 va = *(const u32x2*)(VT + (dt * 16 + fr) * RS + (32 * i2 + fq * 4) * 2);
        const u32x2 vb = *(const u32x2*)(VT + (dt * 16 + fr) * RS + (32 * i2 + 16 + fq * 4) * 2);
        const u32x4 vu = {va[0], va[1], vb[0], vb[1]};
        const bf16x8 vf = __builtin_bit_cast(bf16x8, vu);
#pragma unroll
        for (int sh = 0; sh < NS; ++sh) o[sh][dt] = MFMA16(vf, pfr[sh], o[sh][dt]);
      }
    }
  }
  float linv[NS];
#pragma unroll
  for (int sh = 0; sh < NS; ++sh) { float lt = lrun[sh]; lt = fq_sum(lt); linv[sh] = rcp_(lt); }
  if (MODE == 0) {
#pragma unroll
    for (int dt = 0; dt < 4; ++dt) {
      const f32x4 r = o[0][dt] * linv[0];
      *(uint2*)(yo + qtok * 256 + h * 64 + dt * 16 + fq * 4) = make_uint2(pack2(r[0], r[1]), pack2(r[2], r[3]));
    }
  } else {
    f32x4 r[4];
    float ss = 0.f;
#pragma unroll
    for (int dt = 0; dt < 4; ++dt) {
      r[dt] = o[0][dt] * linv[0] - lam * (o[NS - 1][dt] * linv[NS - 1]);
      ss += r[dt][0] * r[dt][0] + r[dt][1] * r[dt][1] + r[dt][2] * r[dt][2] + r[dt][3] * r[dt][3];
    }
    ss = fq_sum(ss);
    const float rn = rsqrtf(ss * (1.0f / 64.0f) + 1e-5f) * (1.0f - lam_init);
    const float* sg = p.in[21] + (size_t)l * 64;
#pragma unroll
    for (int dt = 0; dt < 4; ++dt) {
      const f32x4 g = *(const f32x4*)(sg + dt * 16 + fq * 4);
      const f32x4 q = r[dt] * rn * g;
      *(uint2*)(yo + qtok * 256 + h * 64 + dt * 16 + fq * 4) = make_uint2(pack2(q[0], q[1]), pack2(q[2], q[3]));
    }
  }
}

DI void phase_mixers(const Params& p, int l, int half, unsigned* counter, unsigned char* smem) {
  const int L = half ? 2048 : 4096, nseq = HT / L, rows = L / 64;
  const bf16_t* z = (const bf16_t*)(p.ws + WS_Z);
  bf16_t* yf = (bf16_t*)(p.ws + WS_YF);
  bf16_t* yb = (bf16_t*)(p.ws + WS_YB);
  bf16_t* yn = (bf16_t*)(p.ws + WS_YN);
  bf16_t* yd = (bf16_t*)(p.ws + WS_YD);
  bf16_t* sg = (bf16_t*)(p.ws + WS_SG);
  float* bon = (float*)(p.ws + WS_BON);
  const int n_scan = nseq * 16, n_diff = nseq * 4 * rows, n_na = nseq * rows * 4, n_sg = HT / 256;
  const int total = n_scan + n_diff + n_na + n_sg;
  const int hf = __builtin_amdgcn_readfirstlane(otid() >> 8);
  unsigned char* sm = smem + hf * 65536;
  __shared__ int s_item;
  for (;;) {
    __syncthreads();
    if (threadIdx.x == 0) s_item = (int)atomicAdd(counter, 1u);
    __syncthreads();
    int it = 2 * s_item + hf;
    if (it >= total) break;
    if (it < n_scan) {
      const int dir = it & 1, h = (it >> 1) & 7, b = it >> 4;
      item_scan(p, l, L, b, h, dir, z, dir ? yb : yf, bon + (size_t)dir * HT * 8, sm);
      continue;
    }
    it -= n_scan;
    if (it < n_diff) {
      const int qb = it % rows, h = (it / rows) & 3, b = it / (rows * 4);
      item_attn<1>(p, l, L, b, h, qb, z, yd, sm, smem);
      continue;
    }
    it -= n_diff;
    if (it < n_na) {
      const int r = it % rows, h = (it / rows) & 3, b = it / (rows * 4);
      item_attn<0>(p, l, L, b, h, r, z, yn, sm, smem);
      continue;
    }
    it -= n_na;
    item_sg(p, l, L, it, z, sg);
  }
}

#define XB_TMO      128
#define XB_XCNT(j)  (256  + 64 * (j))
#define XB_XSUB(j)  (1280 + 64 * (j))
#define XB_XGEN(j)  (2304 + 64 * (j))
#define XB_TOP      3328
#define XB_TOPGEN   3392
#define XB_SPIN_CAP (1u << 18)
#define LAS __attribute__((address_space(3)))
DI unsigned xb_ld(unsigned* p)              { return __hip_atomic_load(p, __ATOMIC_RELAXED, __HIP_MEMORY_SCOPE_AGENT); }
DI unsigned xb_add(unsigned* p, unsigned v) { return __hip_atomic_fetch_add(p, v, __ATOMIC_RELAXED, __HIP_MEMORY_SCOPE_AGENT); }
DI unsigned xb_xcc_id() { return (unsigned)__builtin_amdgcn_s_getreg((3 << 11) | 20) & 0xFu; }
#define XB_SPIN(cond, bar) do { unsigned _sp = 0; while (cond) { __builtin_amdgcn_s_sleep(1); \
    if ((++_sp & 255u) == 0u) { if (xb_ld(&(bar)[XB_TMO])) break; if (_sp > XB_SPIN_CAP) { atomicAdd(&(bar)[XB_TMO], 1u); break; } } } } while (0)
struct XcdBarrier { unsigned* bar; unsigned x; volatile LAS unsigned* st; };
DI XcdBarrier xcd_barrier_post(unsigned* bar, volatile LAS unsigned* st) {
  XcdBarrier b; b.bar = bar; b.x = xb_xcc_id(); b.st = st;
  if (threadIdx.x == 0) (void)xb_add(&bar[XB_XCNT(b.x)], 1u);
  return b;
}
DI void xcd_barrier_complete(unsigned* bar, unsigned x, unsigned& nloc, unsigned& nx) {
  const unsigned G = gridDim.x * gridDim.y * gridDim.z;
  unsigned sum, cnt, mine, sp = 0u;
  for (;;) {
    sum = 0u; cnt = 0u; mine = 0u;
#pragma unroll
    for (unsigned j = 0; j < 16; ++j) { const unsigned c = xb_ld(&bar[XB_XCNT(j)]); sum += c; cnt += (c > 0u) ? 1u : 0u; mine = (j == x) ? c : mine; }
    if (sum == G) break;
    __builtin_amdgcn_s_sleep(1);
    if ((++sp & 255u) == 0u) { if (xb_ld(&bar[XB_TMO])) break; if (sp > XB_SPIN_CAP) { atomicAdd(&bar[XB_TMO], 1u); break; } }
  }
  nloc = mine > 0u ? mine : 1u; nx = cnt > 0u ? cnt : 1u;
}
DI void xcd_barrier(const XcdBarrier& b) {
  asm volatile("s_waitcnt vmcnt(0)" ::: "memory");
  __syncthreads();
  if (threadIdx.x == 0) {
    unsigned* bar = b.bar;
    __builtin_amdgcn_s_waitcnt(0);
    unsigned nloc = b.st[0], nx = b.st[1];
    if (nloc == 0u) { xcd_barrier_complete(bar, b.x, nloc, nx); b.st[0] = nloc; b.st[1] = nx; }
    const unsigned old = xb_add(&bar[XB_XSUB(b.x)], 1u);
    const unsigned gen = old / nloc;
    if (old + 1u == (gen + 1u) * nloc) {
      __builtin_amdgcn_fence(__ATOMIC_RELEASE, "agent");
      asm volatile("s_waitcnt vmcnt(0)" ::: "memory");
      const unsigned og = xb_add(&bar[XB_TOP], 1u);
      const unsigned tg = og / nx;
      if (og + 1u == (tg + 1u) * nx) xb_add(&bar[XB_TOPGEN], 1u);
      else XB_SPIN(xb_ld(&bar[XB_TOPGEN]) == tg, bar);
      __builtin_amdgcn_fence(__ATOMIC_ACQUIRE, "agent");
      xb_add(&bar[XB_XGEN(b.x)], 1u);
      asm volatile("s_waitcnt vmcnt(0)" ::: "memory");
    } else {
      XB_SPIN(xb_ld(&bar[XB_XGEN(b.x)]) == gen, bar);
      __builtin_amdgcn_fence(__ATOMIC_ACQUIRE, "agent");
      asm volatile("s_waitcnt vmcnt(0)" ::: "memory");
    }
  }
  __syncthreads();
}

__global__ void __launch_bounds__(512, 2) fwd_megakernel(Params p) {
  cg::grid_group grid = cg::this_grid();
  __shared__ __attribute__((aligned(16))) unsigned char smem[131072];
  bf16_t* W = (bf16_t*)(p.ws + WS_W);
  bf16_t* xn = (bf16_t*)(p.ws + WS_XN);
  bf16_t* hid = (bf16_t*)(p.ws + WS_HID);
  bf16_t* z = (bf16_t*)(p.ws + WS_Z);
  bf16_t* mo = (bf16_t*)(p.ws + WS_M);
  unsigned* ctl = (unsigned*)(p.ws + WS_CTL);
  __shared__ uint4 xb_words;
  if (threadIdx.x == 0) xb_words = make_uint4(0u, 0u, 0u, 0u);
  __syncthreads();
  const XcdBarrier xb = xcd_barrier_post((unsigned*)(p.ws + WS_BAR), (volatile LAS unsigned*)&xb_words);

  phase_convert(p, smem);
  grid.sync();
  for (int half = 0; half < 2; ++half) {
    const float* xin = p.in[half];
    float* x = p.out + (size_t)half * HT * D;
    const int L = half ? 2048 : 4096;
    for (int l = 0; l < NLAYER; ++l) {
      const bf16_t* Wl = W + (size_t)l * W_LAYER;
      const float* xsrc = (l == 0) ? xin : x;
      phase_norm(xsrc, p.in[2] + (size_t)l * D, xn, nullptr);
      xcd_barrier(xb);
      phase_ffn_up(xn, Wl + W_GU, hid, smem);
      xcd_barrier(xb);
      phase_gemm_resid(hid, DFF, Wl + W_WD, xsrc, x, 0.5f, smem);
      xcd_barrier(xb);
      phase_norm(x, p.in[6] + (size_t)l * D, xn, nullptr);
      xcd_barrier(xb);
      phase_proj(xn, Wl + W_IN, z, smem);
      xcd_barrier(xb);
      phase_mixers(p, l, half, ctl + (half * NLAYER + l) * 16, smem);
      xcd_barrier(xb);
      phase_ya(p, l, L, (const bf16_t*)(p.ws + WS_SG), Wl + W_G2, z, (bf16_t*)(p.ws + WS_YF), (const bf16_t*)(p.ws + WS_YB), (const float*)(p.ws + WS_BON), smem);
      xcd_barrier(xb);
      phase_merge(xn, Wl, (const bf16_t*)(p.ws + WS_YF), (const bf16_t*)(p.ws + WS_YN), (const bf16_t*)(p.ws + WS_YD), mo, smem);
      xcd_barrier(xb);
      phase_gemm_resid(mo, D, Wl + W_OUT, x, x, 1.0f, smem);
      xcd_barrier(xb);
      phase_norm(x, p.in[26] + (size_t)l * D, xn, nullptr);
      xcd_barrier(xb);
      phase_ffn_up(xn, Wl + W_GU2, hid, smem);
      xcd_barrier(xb);
      phase_gemm_resid(hid, DFF, Wl + W_WD2, x, x, 0.5f, smem);
      xcd_barrier(xb);
    }
    phase_norm(x, p.in[30], nullptr, x);
    xcd_barrier(xb);
  }
}

extern "C" void kernel_launch(void* const* d_in, const int* in_sizes, int n_in, void* d_out, int out_size, void* d_ws, size_t ws_size, hipStream_t stream) {
  static int grid_blocks = 0;
  if (!grid_blocks) {
    int dev = 0, cus = 0, per_cu = 0;
    (void)hipGetDevice(&dev);
    (void)hipDeviceGetAttribute(&cus, hipDeviceAttributeMultiprocessorCount, dev);
    (void)hipOccupancyMaxActiveBlocksPerMultiprocessor(&per_cu, fwd_megakernel, 512, 0);
    if (per_cu < 1) per_cu = 1;
    if (per_cu > 1) per_cu = 1;
    grid_blocks = cus * per_cu;
    if (ws_size < WS_END) fprintf(stderr, "kernel_launch: workspace too small: need %zu have %zu\n", (size_t)WS_END, ws_size);
  }
  (void)hipMemsetAsync((char*)d_ws + WS_CTL, 0, WS_CTL_BYTES, stream);
  Params p{};
  for (int i = 0; i < 31; ++i) p.in[i] = (const float*)d_in[i];
  p.out = (float*)d_out;
  p.ws = (unsigned char*)d_ws;
  void* args[] = {&p};
  hipError_t e = hipLaunchCooperativeKernel((void*)fwd_megakernel, dim3(grid_blocks), dim3(512), args, 0, stream);
  if (e != hipSuccess) fprintf(stderr, "cooperative launch failed: %s (grid %d)\n", hipGetErrorString(e), grid_blocks);
}
```

```cpp
#include <hip/hip_runtime.h>
#include <hip/hip_cooperative_groups.h>
#include <cstdio>
#include <cstdint>
namespace cg = cooperative_groups;

typedef unsigned short bf16_t;
typedef short bf16x8 __attribute__((ext_vector_type(8)));
typedef short s16x4 __attribute__((ext_vector_type(4)));
typedef float f32x4 __attribute__((ext_vector_type(4)));
typedef float f32x2 __attribute__((ext_vector_type(2)));
typedef unsigned u32x4 __attribute__((ext_vector_type(4)));
typedef unsigned u32x2 __attribute__((ext_vector_type(2)));
#define DI __device__ __forceinline__
#define MFMA16(a, b, c) __builtin_amdgcn_mfma_f32_16x16x32_bf16((a), (b), (c), 0, 0, 0)

constexpr int D = 1024, DFF = 2816, HT = 65536  , NLAYER = 2;
constexpr int ZC = 3328;
constexpr int INC = 6400;
constexpr int CA = 512;
constexpr float LOG2E = 1.4426950408889634f;

constexpr size_t WS_CTL = 0;
constexpr size_t WS_BAR = 4096;
constexpr size_t WS_CTL_BYTES = 32768;
constexpr size_t WS_W = WS_CTL_BYTES;
constexpr size_t W_GU = 0;
constexpr size_t W_WD = W_GU + (size_t)2 * DFF * D;
constexpr size_t W_GU2 = W_WD + (size_t)D * DFF;
constexpr size_t W_WD2 = W_GU2 + (size_t)2 * DFF * D;
constexpr size_t W_IN = W_WD2 + (size_t)D * DFF;
constexpr size_t W_PA = W_IN + (size_t)INC * D;
constexpr size_t W_PB = W_PA + (size_t)D * 512;
constexpr size_t W_PC = W_PB + (size_t)D * 256;
constexpr size_t W_OUT = W_PC + (size_t)D * 256;
constexpr size_t W_G2 = W_OUT + (size_t)D * D;
constexpr size_t W_LAYER = W_G2 + (size_t)512 * 128;
constexpr size_t WS_XN = WS_W + 2 * W_LAYER * 2;
constexpr size_t WS_R = WS_XN + (size_t)HT * D * 2;
constexpr size_t WS_HID = WS_R;
constexpr size_t WS_Z = WS_R;
constexpr size_t WS_M = WS_R;
constexpr size_t WS_YF = WS_Z + (size_t)HT * ZC * 2;
constexpr size_t WS_YB = WS_YF + (size_t)HT * 512 * 2;
constexpr size_t WS_YN = WS_YB + (size_t)HT * 512 * 2;
constexpr size_t WS_YD = WS_YN + (size_t)HT * 256 * 2;
constexpr size_t WS_SG = WS_YD + (size_t)HT * 256 * 2;
constexpr size_t WS_BON = WS_SG + (size_t)HT * 128 * 2;
constexpr size_t WS_END = WS_BON + (size_t)2 * HT * 8 * 4;

struct Params {
  const float* in[31];
  float* out;
  unsigned char* ws;
};

typedef __bf16 bf16x2_t __attribute__((ext_vector_type(2)));
DI unsigned pack2(float lo, float hi) { const f32x2 v = {lo, hi}; const bf16x2_t b = __builtin_convertvector(v, bf16x2_t); return __builtin_bit_cast(unsigned, b); }
DI bf16_t f2bf(float x) { return (bf16_t)(pack2(x, x) & 0xffffu); }
DI float bf2f(bf16_t h) { return __uint_as_float(((unsigned)h) << 16); }
DI float lo2f(unsigned u) { return __uint_as_float(u << 16); }
DI float hi2f(unsigned u) { return __uint_as_float(u & 0xffff0000u); }
DI float xor16_sum(float v) { const auto r = __builtin_amdgcn_permlane16_swap(__float_as_uint(v), __float_as_uint(v), false, false); return __uint_as_float(r[0]) + __uint_as_float(r[1]); }
DI float xor32_sum(float v) { const auto r = __builtin_amdgcn_permlane32_swap(__float_as_uint(v), __float_as_uint(v), false, false); return __uint_as_float(r[0]) + __uint_as_float(r[1]); }
DI float xor16_max(float v) { const auto r = __builtin_amdgcn_permlane16_swap(__float_as_uint(v), __float_as_uint(v), false, false); return fmaxf(__uint_as_float(r[0]), __uint_as_float(r[1])); }
DI float xor32_max(float v) { const auto r = __builtin_amdgcn_permlane32_swap(__float_as_uint(v), __float_as_uint(v), false, false); return fmaxf(__uint_as_float(r[0]), __uint_as_float(r[1])); }
DI float fq_sum(float v) { return xor32_sum(xor16_sum(v)); }
DI float fq_max(float v) { return xor32_max(xor16_max(v)); }
DI float quad_sum(float v) {
  int t = __builtin_amdgcn_update_dpp(0, __float_as_int(v), 0xB1, 0xF, 0xF, true);
  v += __int_as_float(t);
  t = __builtin_amdgcn_update_dpp(0, __float_as_int(v), 0x4E, 0xF, 0xF, true);
  v += __int_as_float(t);
  return v;
}
DI float oct_sum(float v) {
  v = quad_sum(v);
  const int t = __builtin_amdgcn_update_dpp(0, __float_as_int(v), 0x141, 0xF, 0xF, true);
  return v + __int_as_float(t);
}
DI float row_sum16(float v) {
  v = oct_sum(v);
  const int t = __builtin_amdgcn_update_dpp(0, __float_as_int(v), 0x140, 0xF, 0xF, true);
  return v + __int_as_float(t);
}
DI float wave_sum(float v) { return fq_sum(row_sum16(v)); }
DI void oct_sum_pair(float& a, float& b) {
#define OSP_STAGE(ctrl) { const int ta = __builtin_amdgcn_update_dpp(0, __float_as_int(a), ctrl, 0xF, 0xF, true); const int tb = __builtin_amdgcn_update_dpp(0, __float_as_int(b), ctrl, 0xF, 0xF, true); \
    a += __int_as_float(ta); b += __int_as_float(tb); asm volatile("" : "+v"(a)); asm volatile("" : "+v"(b)); }
  OSP_STAGE(0xB1) OSP_STAGE(0x4E) OSP_STAGE(0x141)
#undef OSP_STAGE
}
DI int otid() { int t = threadIdx.x; asm volatile("" : "+v"(t)); return t; }
DI float rcp_(float x) { return __builtin_amdgcn_rcpf(x); }
DI float sigmoidf_(float x) { return rcp_(1.0f + __expf(-x)); }

DI void convert_job(const float* __restrict__ src, int K, int N, bf16_t* __restrict__ dst, int mode, float* tile  ) {
  const int tid = otid();
  const int ntk = K / 64, ntn = N / 64, nt = ntk * ntn;
  for (int t = blockIdx.x; t < nt; t += gridDim.x) {
    const int tk = t / ntn, tn = t % ntn;
    const int k0 = tk * 64, n0 = tn * 64;
    __syncthreads();
#pragma unroll
    for (int i = 0; i < 8; ++i) {
      const int kk = (tid >> 6) + i * 8, nn = tid & 63;
      tile[kk * 65 + nn] = src[(size_t)(k0 + kk) * N + n0 + nn];
    }
    __syncthreads();
    const int nn = tid >> 3, kc = (tid & 7) * 8;
    const int n = n0 + nn;
    int row = n;
    if (mode == 1) row = (n >> 5) * 64 + (n & 31);
    else if (mode == 2) row = (n >> 5) * 64 + 32 + (n & 31);
    u32x4 pk;
#pragma unroll
    for (int i = 0; i < 4; ++i) pk[i] = pack2(tile[(kc + 2 * i) * 65 + nn], tile[(kc + 2 * i + 1) * 65 + nn]);
    *(u32x4*)(dst + (size_t)row * K + k0 + kc) = pk;
  }
}

DI void phase_convert(const Params& p, unsigned char* smem) {
  float* tile = (float*)smem;
  bf16_t* W = (bf16_t*)(p.ws + WS_W);
  for (int l = 0; l < NLAYER; ++l) {
    bf16_t* Wl = W + (size_t)l * W_LAYER;
    convert_job(p.in[3] + (size_t)l * D * DFF, D, DFF, Wl + W_GU, 1, tile);
    convert_job(p.in[4] + (size_t)l * D * DFF, D, DFF, Wl + W_GU, 2, tile);
    convert_job(p.in[5] + (size_t)l * DFF * D, DFF, D, Wl + W_WD, 0, tile);
    convert_job(p.in[27] + (size_t)l * D * DFF, D, DFF, Wl + W_GU2, 1, tile);
    convert_job(p.in[28] + (size_t)l * D * DFF, D, DFF, Wl + W_GU2, 2, tile);
    convert_job(p.in[29] + (size_t)l * DFF * D, DFF, D, Wl + W_WD2, 0, tile);
    convert_job(p.in[7] + (size_t)l * D * INC, D, INC, Wl + W_IN, 0, tile);
    convert_job(p.in[22] + (size_t)l * 512 * D, 512, D, Wl + W_PA, 0, tile);
    convert_job(p.in[23] + (size_t)l * 256 * D, 256, D, Wl + W_PB, 0, tile);
    convert_job(p.in[24] + (size_t)l * 256 * D, 256, D, Wl + W_PC, 0, tile);
    convert_job(p.in[25] + (size_t)l * D * D, D, D, Wl + W_OUT, 0, tile);
    convert_job(p.in[16] + (size_t)l * 128 * 512, 128, 512, Wl + W_G2, 0, tile);
  }
}

DI void phase_norm(const float* __restrict__ src, const float* __restrict__ gam, bf16_t* __restrict__ xn, float* __restrict__ fout) {
  const int tid_ = otid(), lane = tid_ & 63, w = tid_ >> 6;
  f32x4 g[4];
#pragma unroll
  for (int i = 0; i < 4; ++i) g[i] = *(const f32x4*)(gam + i * 256 + lane * 4);
  const int stride = gridDim.x * 8;
  auto ld = [&](f32x4 (&v)[4], int row) {
    if (row < HT) {
#pragma unroll
      for (int i = 0; i < 4; ++i) v[i] = *(const f32x4*)(src + (size_t)row * D + i * 256 + lane * 4);
    }
  };
  auto proc = [&](const f32x4 (&v)[4], int row) {
    float ss = 0.f;
#pragma unroll
    for (int i = 0; i < 4; ++i) ss += (v[i][0] * v[i][0] + v[i][1] * v[i][1]) + (v[i][2] * v[i][2] + v[i][3] * v[i][3]);
    ss = wave_sum(ss);
    const float rs = rsqrtf(ss * (1.0f / 1024.0f) + 1e-6f);
#pragma unroll
    for (int i = 0; i < 4; ++i) {
      const f32x4 y = v[i] * rs * g[i];
      if (fout) *(f32x4*)(fout + (size_t)row * D + i * 256 + lane * 4) = y;
      else *(uint2*)(xn + (size_t)row * D + i * 256 + lane * 4) = make_uint2(pack2(y[0], y[1]), pack2(y[2], y[3]));
    }
  };
  int t = blockIdx.x * 8 + w;
  f32x4 a[4], b[4];
  ld(a, t); ld(b, t + stride);
  for (; t < HT; t += 2 * stride) {
    f32x4 na[4], nb[4];
    ld(na, t + 2 * stride); ld(nb, t + 3 * stride);
    proc(a, t);
    if (t + stride < HT) proc(b, t + stride);
#pragma unroll
    for (int i = 0; i < 4; ++i) { a[i] = na[i]; b[i] = nb[i]; }
  }
}

constexpr int RS = 144;
typedef __attribute__((address_space(3))) unsigned lds_u32;
DI void glds16(const void* g, unsigned char* l) { __builtin_amdgcn_global_load_lds((const unsigned*)g, (lds_u32*)l, 16, 0, 0); }
template <int N> DI void wait_vm() { asm volatile("s_waitcnt vmcnt(%0)" :: "n"(N) : "memory"); }
template <int MT, int NT, int WR, int WC>
DI void gemm_block(const bf16_t* __restrict__ A, int lda, const bf16_t* __restrict__ B, int ldb, int K, f32x4 (&acc)[MT][NT], unsigned char* smem,
                   bool primed = false, const bf16_t* __restrict__ nA = nullptr, int nlda = 0, const bf16_t* __restrict__ nB = nullptr, int nldb = 0) {
  static_assert(WR * WC == 8, "8 waves");
  constexpr int AR = 16 * MT * WR, BR = 16 * NT * WC;
  constexpr int AB = AR * 128, BB = BR * 128, STG = AB + BB;
  constexpr int NA = AR * 8 / 512, NB = BR * 8 / 512;
  const int tid = otid(), lane = tid & 63, w = tid >> 6, wr = w / WC, wc = w % WC, fr = lane & 15, fq = lane >> 4;
  const int srow = tid >> 3, kch = (tid & 7) ^ ((tid >> 4) & 7);
  const unsigned voA = (unsigned)(srow * lda + kch * 8) * 2u, voB = (unsigned)(srow * ldb + kch * 8) * 2u;
  const char* Ab = (const char*)A;
  const char* Bb = (const char*)B;
  const int nk = K >> 6;
  if (!primed) {
#pragma unroll
    for (int i = 0; i < NA; ++i) glds16(Ab + (size_t)i * 128 * lda + voA, smem + (i * 512 + tid) * 16);
#pragma unroll
    for (int i = 0; i < NB; ++i) glds16(Bb + (size_t)i * 128 * ldb + voB, smem + AB + (i * 512 + tid) * 16);
  }
  const int sw = (fr >> 1) & 7;
  const unsigned lds_base = (unsigned)(size_t)(__attribute__((address_space(3))) unsigned char*)smem;
  const unsigned a_row = (wr * 16 * MT + fr) * 128, b_row = AB + (wc * 16 * NT + fr) * 128;
  for (int kt = 0; kt < nk; ++kt) {
    wait_vm<0>();
    __builtin_amdgcn_s_barrier();
    if (kt + 1 < nk) {
      unsigned char* sn = smem + ((kt + 1) & 1) * STG;
      const int ko = (kt + 1) * 64;
#pragma unroll
      for (int i = 0; i < NA; ++i) glds16(Ab + ((size_t)i * 128 * lda + ko * 2) + voA, sn + (i * 512 + tid) * 16);
#pragma unroll
      for (int i = 0; i < NB; ++i) glds16(Bb + ((size_t)i * 128 * ldb + ko * 2) + voB, sn + AB + (i * 512 + tid) * 16);
    } else if (nA) {
      const unsigned nvoA = (unsigned)(srow * nlda + kch * 8) * 2u, nvoB = (unsigned)(srow * nldb + kch * 8) * 2u;
#pragma unroll
      for (int i = 0; i < NA; ++i) glds16((const char*)nA + (size_t)i * 128 * nlda + nvoA, smem + (i * 512 + tid) * 16);
#pragma unroll
      for (int i = 0; i < NB; ++i) glds16((const char*)nB + (size_t)i * 128 * nldb + nvoB, smem + AB + (i * 512 + tid) * 16);
    }
    const unsigned stb = lds_base + (kt & 1) * STG;
#pragma unroll
    for (int ks = 0; ks < 2; ++ks) {
      const unsigned co = ((ks * 4 + fq) ^ sw) * 16;
      const unsigned sa = stb + a_row + co, sb = stb + b_row + co;
      bf16x8 af[4], bfr[NT];
#pragma unroll
      for (int n = 0; n < NT; ++n) asm volatile("ds_read_b128 %0, %1 offset:%2" : "=v"(bfr[n]) : "v"(sb), "n"(n * 2048) : "memory");
#pragma unroll
      for (int mg = 0; mg < MT / 4; ++mg) {
#pragma unroll
        for (int m = 0; m < 4; ++m) asm volatile("ds_read_b128 %0, %1 offset:%2" : "=v"(af[m]) : "v"(sa), "n"((mg * 4 + m) * 2048) : "memory");
        if (mg == 0) {
#pragma unroll
          for (int n = 0; n < NT; ++n) asm volatile("s_waitcnt lgkmcnt(%1)" : "+v"(bfr[n]) : "n"(4 + NT - 1 - n) : "memory");
        }
#pragma unroll
        for (int m = 0; m < 4; ++m) {
          asm volatile("s_waitcnt lgkmcnt(%1)" : "+v"(af[m]) : "n"(3 - m) : "memory");
#pragma unroll
          for (int n = 0; n < NT; ++n) acc[mg * 4 + m][n] = MFMA16(bfr[n], af[m], acc[mg * 4 + m][n]);
        }
      }
    }
  }
  if (!nA) __syncthreads();
}

template <int MT, int NT>
DI void zero_acc(f32x4 (&acc)[MT][NT]) {
#pragma unroll
  for (int m = 0; m < MT; ++m)
#pragma unroll
    for (int n = 0; n < NT; ++n) acc[m][n] = (f32x4){0.f, 0.f, 0.f, 0.f};
}

DI void tile_coords(int id, int nN, int& pm, int& pn) {
  const int band = id / (16 * nN), r = id % (16 * nN);
  pm = band * 16 + (r & 15); pn = r >> 4;
}

DI void phase_ffn_up(const bf16_t* __restrict__ xn, const bf16_t* __restrict__ gu, bf16_t* __restrict__ hid, unsigned char* smem) {
  const int tid_ = otid(), lane = tid_ & 63, w = tid_ >> 6, wr = w >> 2, wc = w & 3, fr = lane & 15, fq = lane >> 4;
  constexpr int nN = 2 * DFF / 256, nM = HT / 256;
  for (int id = blockIdx.x; id < nM * nN; id += gridDim.x) {
    int pm, pn; tile_coords(id, nN, pm, pn);
    f32x4 acc[8][4]; zero_acc(acc);
    {
      const int idn = id + gridDim.x; int pm2 = 0, pn2 = 0; const bool hn = idn < nM * nN; if (hn) tile_coords(idn, nN, pm2, pn2);
      gemm_block<8, 4, 2, 4>(xn + (size_t)pm * 256 * D, D, gu + (size_t)pn * 256 * D, D, D, acc, smem, id != (int)blockIdx.x,
                             hn ? xn + (size_t)pm2 * 256 * D : nullptr, D, gu + (size_t)pn2 * 256 * D, D);
    }
    const int hc0 = (pn * 4 + wc) * 32 + fq * 4;
#pragma unroll
    for (int m = 0; m < 8; ++m) {
      const size_t row = (size_t)pm * 256 + wr * 128 + m * 16 + fr;
#pragma unroll
      for (int n = 0; n < 2; ++n) {
        float h[4];
#pragma unroll
        for (int j = 0; j < 4; ++j) { const float g = acc[m][n][j], u = acc[m][n + 2][j]; h[j] = g * rcp_(1.0f + __expf(-g)) * u; }
        *(uint2*)(hid + row * DFF + hc0 + n * 16) = make_uint2(pack2(h[0], h[1]), pack2(h[2], h[3]));
      }
    }
  }
}

DI void phase_gemm_resid(const bf16_t* __restrict__ A, int K, const bf16_t* __restrict__ Bt, const float* __restrict__ xin, float* __restrict__ xout, float alpha, unsigned char* smem) {
  const int tid_ = otid(), lane = tid_ & 63, w = tid_ >> 6, wr = w >> 2, wc = w & 3, fr = lane & 15, fq = lane >> 4;
  constexpr int nN = D / 256, nM = HT / 256;
  for (int id = blockIdx.x; id < nM * nN; id += gridDim.x) {
    int pm, pn; tile_coords(id, nN, pm, pn);
    f32x4 acc[8][4]; zero_acc(acc);
    {
      const int idn = id + gridDim.x; int pm2 = 0, pn2 = 0; const bool hn = idn < nM * nN; if (hn) tile_coords(idn, nN, pm2, pn2);
      gemm_block<8, 4, 2, 4>(A + (size_t)pm * 256 * K, K, Bt + (size_t)pn * 256 * K, K, K, acc, smem, id != (int)blockIdx.x,
                             hn ? A + (size_t)pm2 * 256 * K : nullptr, K, Bt + (size_t)pn2 * 256 * K, K);
    }
#pragma unroll
    for (int m = 0; m < 8; ++m) {
      const size_t row = (size_t)pm * 256 + wr * 128 + m * 16 + fr;
#pragma unroll
      for (int n = 0; n < 4; ++n) {
        const size_t o = row * D + pn * 256 + wc * 64 + n * 16 + fq * 4;
        const f32x4 x = *(const f32x4*)(xin + o);
        *(f32x4*)(xout + o) = x + alpha * acc[m][n];
      }
    }
  }
}

DI void phase_proj(const bf16_t* __restrict__ xn, const bf16_t* __restrict__ wint, bf16_t* __restrict__ z, unsigned char* smem) {
  const int tid_ = otid(), lane = tid_ & 63, w = tid_ >> 6, wr = w >> 2, wc = w & 3, fr = lane & 15, fq = lane >> 4;
  constexpr int nN = ZC / 256, nM = HT / 256;
  for (int id = blockIdx.x; id < nM * nN; id += gridDim.x) {
    int pm, pn; tile_coords(id, nN, pm, pn);
    f32x4 acc[8][4]; zero_acc(acc);
    {
      const int idn = id + gridDim.x; int pm2 = 0, pn2 = 0; const bool hn = idn < nM * nN; if (hn) tile_coords(idn, nN, pm2, pn2);
      gemm_block<8, 4, 2, 4>(xn + (size_t)pm * 256 * D, D, wint + (size_t)pn * 256 * D, D, D, acc, smem, id != (int)blockIdx.x,
                             hn ? xn + (size_t)pm2 * 256 * D : nullptr, D, wint + (size_t)pn2 * 256 * D, D);
    }
#pragma unroll
    for (int m = 0; m < 8; ++m) {
      const size_t row = (size_t)pm * 256 + wr * 128 + m * 16 + fr;
#pragma unroll
      for (int n = 0; n < 4; ++n) {
        const f32x4 a = acc[m][n];
        *(uint2*)(z + row * ZC + pn * 256 + wc * 64 + n * 16 + fq * 4) = make_uint2(pack2(a[0], a[1]), pack2(a[2], a[3]));
      }
    }
  }
}

DI void phase_ya(const Params& p, int l, int L, const bf16_t* __restrict__ sg, const bf16_t* __restrict__ g2t, const bf16_t* __restrict__ z,
                 bf16_t* __restrict__ yf, const bf16_t* __restrict__ yb, const float* __restrict__ bon, unsigned char* smem) {
  const int tid_ = otid(), lane = tid_ & 63, w = tid_ >> 6, wr = w >> 2, wc = w & 3, fr = lane & 15, fq = lane >> 4;
  constexpr int nN = 2, nM = HT / 256;
  const float* mu0 = p.in[8] + (size_t)l * 2 * 1792;
  const float* mu1 = mu0 + 1792;
  const float* lng = p.in[17] + (size_t)l * CA;
  const float* lnb = p.in[18] + (size_t)l * CA;
  for (int id = blockIdx.x; id < nM * nN; id += gridDim.x) {
    int pm, pn; tile_coords(id, nN, pm, pn);
    f32x4 acc[8][4]; zero_acc(acc);
    {
      const int idn = id + gridDim.x; int pm2 = 0, pn2 = 0; const bool hn = idn < nM * nN; if (hn) tile_coords(idn, nN, pm2, pn2);
      gemm_block<8, 4, 2, 4>(sg + (size_t)pm * 256 * 128, 128, g2t + (size_t)pn * 256 * 128, 128, 128, acc, smem, id != (int)blockIdx.x,
                             hn ? sg + (size_t)pm2 * 256 * 128 : nullptr, 128, g2t + (size_t)pn2 * 256 * 128, 128);
    }
    const int h = pn * 4 + wc;
#pragma unroll
    for (int m = 0; m < 8; ++m) {
      const int row = pm * 256 + wr * 128 + m * 16 + fr;
      const int t = row % L;
      const bool hasp = t > 0, hasn = t < L - 1;
      float y[4][4];
      float s = 0.f;
#pragma unroll
      for (int n = 0; n < 4; ++n) {
        const int c = h * 64 + n * 16 + fq * 4;
        const uint2 a = *(const uint2*)(yf + (size_t)row * CA + c);
        const uint2 b = *(const uint2*)(yb + (size_t)row * CA + c);
        y[n][0] = lo2f(a.x) + lo2f(b.x); y[n][1] = hi2f(a.x) + hi2f(b.x); y[n][2] = lo2f(a.y) + lo2f(b.y); y[n][3] = hi2f(a.y) + hi2f(b.y);
        s += (y[n][0] + y[n][1]) + (y[n][2] + y[n][3]);
      }
      s = fq_sum(s);
      const float mean = s * (1.0f / 64.0f);
      float q = 0.f;
#pragma unroll
      for (int n = 0; n < 4; ++n)
#pragma unroll
        for (int j = 0; j < 4; ++j) { const float d = y[n][j] - mean; q += d * d; }
      q = fq_sum(q);
      const float rstd = rsqrtf(q * (1.0f / 64.0f) + 64e-5f);
      const float bsum = bon[(size_t)row * 8 + h] + bon[(size_t)HT * 8 + (size_t)row * 8 + h];
#pragma unroll
      for (int n = 0; n < 4; ++n) {
        const int c = h * 64 + n * 16 + fq * 4;
        const bf16_t* zr = z + (size_t)row * ZC + 1024 + c;
        const uint2 v0 = *(const uint2*)zr;
        uint2 vp = make_uint2(0u, 0u), vn = make_uint2(0u, 0u);
        if (hasp) vp = *(const uint2*)(zr - ZC);
        if (hasn) vn = *(const uint2*)(zr + ZC);
        const f32x4 m0 = *(const f32x4*)(mu0 + 1024 + c), m1 = *(const f32x4*)(mu1 + 1024 + c);
        const f32x4 gg = *(const f32x4*)(lng + c), bb = *(const f32x4*)(lnb + c);
        const float vc[4] = {lo2f(v0.x), hi2f(v0.x), lo2f(v0.y), hi2f(v0.y)};
        const float vpp[4] = {lo2f(vp.x), hi2f(vp.x), lo2f(vp.y), hi2f(vp.y)};
        const float vnn[4] = {lo2f(vn.x), hi2f(vn.x), lo2f(vn.y), hi2f(vn.y)};
        float o[4];
#pragma unroll
        for (int j = 0; j < 4; ++j) {
          const float vs = vc[j] + m0[j] * (vpp[j] - vc[j]) + m1[j] * (vnn[j] - vc[j]);
          o[j] = ((y[n][j] - mean) * rstd * gg[j] + bb[j] + bsum * vs) * acc[m][n][j];
        }
        *(uint2*)(yf + (size_t)row * CA + c) = make_uint2(pack2(o[0], o[1]), pack2(o[2], o[3]));
      }
    }
  }
}

DI void phase_merge(const bf16_t* __restrict__ xn, const bf16_t* __restrict__ Wl, const bf16_t* __restrict__ ya, const bf16_t* __restrict__ yn, const bf16_t* __restrict__ yd,
                    bf16_t* __restrict__ mo, unsigned char* smem) {
  const int tid_ = otid(), lane = tid_ & 63, w = tid_ >> 6, wr = w >> 1, wc = w & 1, fr = lane & 15, fq = lane >> 4;
  constexpr int nN = D / 128, nM = HT / 256;
  for (int id = blockIdx.x; id < nM * nN; id += gridDim.x) {
    int pm, pn; tile_coords(id, nN, pm, pn);
    unsigned tot[4][4][2];
#pragma unroll 1
    for (int i = 0; i < 3; ++i) {
      unsigned gp[4][4][2];
      {
        f32x4 ag[4][4]; zero_acc(ag);
        const bf16_t* Yn = (i == 0) ? ya : (i == 1 ? yn : yd);
        const int Kn = (i == 0) ? 512 : 256;
        const bf16_t* Pn = Wl + (i == 0 ? W_PA : (i == 1 ? W_PB : W_PC));
        gemm_block<4, 4, 4, 2>(xn + (size_t)pm * 256 * D, D, Wl + W_IN + (size_t)(ZC + i * 1024 + pn * 128) * D, D, D, ag, smem, !(i == 0 && id == (int)blockIdx.x),
                               Yn + (size_t)pm * 256 * Kn, Kn, Pn + (size_t)pn * 128 * Kn, Kn);
#pragma unroll
        for (int m = 0; m < 4; ++m)
#pragma unroll
          for (int n = 0; n < 4; ++n) {
            gp[m][n][0] = pack2(sigmoidf_(ag[m][n][0]), sigmoidf_(ag[m][n][1]));
            gp[m][n][1] = pack2(sigmoidf_(ag[m][n][2]), sigmoidf_(ag[m][n][3]));
          }
      }
      f32x4 ay[4][4]; zero_acc(ay);
      const bf16_t* Y = (i == 0) ? ya : (i == 1 ? yn : yd);
      const int Ki = (i == 0) ? 512 : 256;
      const bf16_t* P = Wl + (i == 0 ? W_PA : (i == 1 ? W_PB : W_PC));
      {
        const int idn = id + gridDim.x; int pm2 = pm, pn2 = pn, i2 = i + 1; bool hn = true;
        if (i == 2) { i2 = 0; hn = idn < nM * nN; if (hn) tile_coords(idn, nN, pm2, pn2); }
        gemm_block<4, 4, 4, 2>(Y + (size_t)pm * 256 * Ki, Ki, P + (size_t)pn * 128 * Ki, Ki, Ki, ay, smem, true,
                               hn ? xn + (size_t)pm2 * 256 * D : nullptr, D, Wl + W_IN + (size_t)(ZC + i2 * 1024 + pn2 * 128) * D, D);
      }
#pragma unroll
      for (int m = 0; m < 4; ++m)
#pragma unroll
        for (int n = 0; n < 4; ++n) {
          float t0 = ay[m][n][0] * lo2f(gp[m][n][0]), t1 = ay[m][n][1] * hi2f(gp[m][n][0]);
          float t2 = ay[m][n][2] * lo2f(gp[m][n][1]), t3 = ay[m][n][3] * hi2f(gp[m][n][1]);
          if (i > 0) { t0 += lo2f(tot[m][n][0]); t1 += hi2f(tot[m][n][0]); t2 += lo2f(tot[m][n][1]); t3 += hi2f(tot[m][n][1]); }
          tot[m][n][0] = pack2(t0, t1); tot[m][n][1] = pack2(t2, t3);
        }
    }
#pragma unroll
    for (int m = 0; m < 4; ++m) {
      const size_t row = (size_t)pm * 256 + wr * 64 + m * 16 + fr;
#pragma unroll
      for (int n = 0; n < 4; ++n)
        *(uint2*)(mo + row * D + pn * 128 + wc * 64 + n * 16 + fq * 4) = make_uint2(tot[m][n][0], tot[m][n][1]);
    }
  }
}

DI void item_sg(const Params& p, int l, int L, int item, const bf16_t* __restrict__ z, bf16_t* __restrict__ sg) {
  const int tid_ = otid() & 255, lane = tid_ & 63, w = tid_ >> 6;
  const float* mu0 = p.in[8] + (size_t)l * 2 * 1792 + 1664 + 2 * lane;
  const float* mu1 = mu0 + 1792;
  const float m0a = mu0[0], m0b = mu0[1], m1a = mu1[0], m1b = mu1[1];
  for (int i = w; i < 256; i += 4) {
    const int row = item * 256 + i;
    const int t = row % L;
    const bf16_t* zr = z + (size_t)row * ZC + 1664 + 2 * lane;
    const unsigned c = *(const unsigned*)zr;
    const unsigned pv = (t > 0) ? *(const unsigned*)(zr - ZC) : 0u;
    const unsigned nv = (t < L - 1) ? *(const unsigned*)(zr + ZC) : 0u;
    const float ca = lo2f(c), cb = hi2f(c);
    const float ga = ca + m0a * (lo2f(pv) - ca) + m1a * (lo2f(nv) - ca);
    const float gb = cb + m0b * (hi2f(pv) - cb) + m1b * (hi2f(nv) - cb);
    *(unsigned*)(sg + (size_t)row * 128 + 2 * lane) = pack2(sigmoidf_(ga), sigmoidf_(gb));
  }
}

DI void item_scan(const Params& p, int l, int L, int b, int h, int dir, const bf16_t* __restrict__ z, bf16_t* __restrict__ yout, float* __restrict__ bon, unsigned char* smem) {
  const int tid = otid() & 255, lane = tid & 63, w = tid >> 6, fr = lane & 15, fq = lane >> 4;
  unsigned* ZR = (unsigned*)smem;
  float* VR = (float*)(smem + 11520);
  float* VD = VR + 1024; float* VK = VD + 1024; float* VV = VK + 1024; float* VA = VV + 1024; float* VB = VA + 1024;
  float* YO = VB + 1024;
  float* BO = YO + 1024;
  unsigned char* WT = (unsigned char*)(BO + 16);
  unsigned char* AL = WT + 16 * RS;
  float* MU = (float*)(AL + 16 * RS);
  float* KKC = MU + 640;
  const size_t tok0 = (size_t)b * L;
  const float* mu0 = p.in[8] + (size_t)l * 2 * 1792;
  const float* mu1 = mu0 + 1792;
  const int cA = lane;
  __syncthreads();
  for (int i = tid; i < 640; i += 256) {
    const int s5 = i >> 7, d = (i >> 6) & 1, c = i & 63;
    const int col = (s5 < 3) ? (s5 * 512 + h * 64 + c) : (1536 + (s5 - 3) * 64 + c);
    MU[i] = (d ? mu1 : mu0)[col];
  }
  if (tid < 64) KKC[tid] = p.in[15][(size_t)l * CA + h * 64 + tid];
  const float rkc = p.in[14][((size_t)l * 2 + dir) * CA + h * 64 + cA];
  const int cB = w * 16 + fr;
  const float w0c = p.in[9][((size_t)l * 2 + dir) * CA + h * 64 + cB];
  const float a0c = p.in[11][((size_t)l * 2 + dir) * CA + h * 64 + cB];
  const float kac = p.in[13][((size_t)l * 2 + dir) * CA + h * 64 + cB];
  bf16x8 bw[2], ba[2];
  {
    const float* w2 = p.in[10] + ((size_t)l * 2 + dir) * 64 * CA + h * 64 + cB;
    const float* a2 = p.in[12] + ((size_t)l * 2 + dir) * 64 * CA + h * 64 + cB;
#pragma unroll
    for (int ks = 0; ks < 2; ++ks)
#pragma unroll
      for (int j = 0; j < 8; ++j) {
        bw[ks][j] = (short)f2bf(w2[(size_t)(ks * 32 + fq * 8 + j) * CA]);
        ba[ks][j] = (short)f2bf(a2[(size_t)(ks * 32 + fq * 8 + j) * CA]);
      }
  }
  const int kq = lane & 7, v0 = w * 16 + (lane >> 3) * 2;
  f32x2 S0[4], S1[4];
#pragma unroll
  for (int i = 0; i < 4; ++i) { S0[i] = (f32x2){0.f, 0.f}; S1[i] = (f32x2){0.f, 0.f}; }

  unsigned pf[12], poff[12];
  unsigned vbits = 0u, r0bits = 0u, r17bits = 0u, pf_ok = 0u;
#pragma unroll
  for (int i = 0; i < 12; ++i) {
    const int q = tid + i * 256;
    const int row = q / 160, pr = q - row * 160;
    const int col = (pr < 96) ? ((pr >> 5) * 512 + h * 64 + (pr & 31) * 2) : (1536 + (pr - 96) * 2);
    poff[i] = (q < 2880) ? (unsigned)(row * ZC + col) * 2u : 0u;
    if (q < 2880) vbits |= 1u << i;
    if (row == 0) r0bits |= 1u << i;
    if (row == 17) r17bits |= 1u << i;
  }
  auto prefetch = [&](int tc) {
    const char* zc = (const char*)(z + (tok0 + tc) * ZC) - (size_t)ZC * 2;
    pf_ok = vbits & ~((tc == 0) ? r0bits : 0u) & ~((tc == L - 16) ? r17bits : 0u);
#pragma unroll
    for (int i = 0; i < 12; ++i)
      pf[i] = *(const unsigned*)(zc + (((pf_ok >> i) & 1u) ? poff[i] : (unsigned)(ZC * 2)));
  };
  auto output = [&](int tco) {
    const int tt = tid >> 4, pj = tid & 15;
    const f32x2 ya = *(const f32x2*)(YO + tt * 64 + 2 * pj), yb2 = *(const f32x2*)(YO + tt * 64 + 32 + 2 * pj);
    bf16_t* yp = yout + (tok0 + tco + tt) * CA + h * 64 + 2 * pj;
    *(unsigned*)yp = pack2(ya[0], ya[1]);
    *(unsigned*)(yp + 32) = pack2(yb2[0], yb2[1]);
    if (tid < 16) bon[(tok0 + tco + tid) * 8 + h] = BO[tid];
  };
  const int nch = L / 16;
  prefetch(dir ? L - 16 : 0);
  int tc_prev = 0;
  for (int ci = 0; ci < nch; ++ci) {
    const int tc = dir ? (L - 16 - 16 * ci) : 16 * ci;
#pragma unroll
    for (int i = 0; i < 12; ++i) { const int q = tid + i * 256; if (q < 2880) ZR[q] = ((pf_ok >> i) & 1u) ? pf[i] : 0u; }
    __syncthreads();
    if (ci > 0) output(tc_prev);
    tc_prev = tc;
    if (ci + 1 < nch) prefetch(dir ? (tc - 16) : (tc + 16));
    {
      const int tt = tid >> 4, j = tid & 15;
      float kq2[4];
      float ksum = 0.f;
      unsigned zu[2][5][3];
      f32x2 mm[2][5][2];
#pragma unroll
      for (int hp = 0; hp < 2; ++hp)
#pragma unroll
        for (int s5 = 0; s5 < 5; ++s5) {
          const int pr = j + 16 * hp, pi = s5 * 32 + pr;
          zu[hp][s5][0] = ZR[tt * 160 + pi]; zu[hp][s5][1] = ZR[(tt + 1) * 160 + pi]; zu[hp][s5][2] = ZR[(tt + 2) * 160 + pi];
          mm[hp][s5][0] = *(const f32x2*)(MU + (s5 * 2) * 64 + 2 * pr); mm[hp][s5][1] = *(const f32x2*)(MU + (s5 * 2 + 1) * 64 + 2 * pr);
        }
#pragma unroll
      for (int hp = 0; hp < 2; ++hp) {
        const int pr = j + 16 * hp, c = 2 * pr;
        float zs[5][2];
#pragma unroll
        for (int s5 = 0; s5 < 5; ++s5) {
          const unsigned up = zu[hp][s5][0], uc = zu[hp][s5][1], un = zu[hp][s5][2];
          const f32x2 m0 = mm[hp][s5][0], m1 = mm[hp][s5][1];
          const float c0 = lo2f(uc), c1 = hi2f(uc);
          zs[s5][0] = c0 + m0[0] * (lo2f(up) - c0) + m1[0] * (lo2f(un) - c0);
          zs[s5][1] = c1 + m0[1] * (hi2f(up) - c1) + m1[1] * (hi2f(un) - c1);
        }
        *(f32x2*)(VR + tt * 64 + c) = (f32x2){zs[0][0], zs[0][1]};
        *(f32x2*)(VK + tt * 64 + c) = (f32x2){zs[1][0], zs[1][1]};
        *(f32x2*)(VV + tt * 64 + c) = (f32x2){zs[2][0], zs[2][1]};
        const f32x2 kc = *(const f32x2*)(KKC + c);
        kq2[2 * hp] = zs[1][0] * kc[0]; kq2[2 * hp + 1] = zs[1][1] * kc[1];
        ksum += kq2[2 * hp] * kq2[2 * hp] + kq2[2 * hp + 1] * kq2[2 * hp + 1];
        const float t0 = 1.0f - 2.0f * rcp_(__expf(2.0f * zs[3][0]) + 1.0f);
        const float t1 = 1.0f - 2.0f * rcp_(__expf(2.0f * zs[3][1]) + 1.0f);
        *(unsigned*)(WT + tt * RS + c * 2) = pack2(t0, t1);
        *(unsigned*)(AL + tt * RS + c * 2) = pack2(zs[4][0], zs[4][1]);
      }
      ksum = row_sum16(ksum);
      const float inv = rcp_(fmaxf(sqrtf(ksum), 1e-12f));
      *(f32x2*)(VA + tt * 64 + 2 * j) = (f32x2){kq2[0] * inv, kq2[1] * inv};
      *(f32x2*)(VA + tt * 64 + 2 * j + 32) = (f32x2){kq2[2] * inv, kq2[3] * inv};
    }
    __syncthreads();
    {
      f32x4 aw = {0.f, 0.f, 0.f, 0.f}, aa = {0.f, 0.f, 0.f, 0.f};
#pragma unroll
      for (int ks = 0; ks < 2; ++ks) {
        const bf16x8 fw = *(const bf16x8*)(WT + fr * RS + ks * 64 + fq * 16);
        const bf16x8 fa = *(const bf16x8*)(AL + fr * RS + ks * 64 + fq * 16);
        aw = MFMA16(fw, bw[ks], aw);
        aa = MFMA16(fa, ba[ks], aa);
      }
#pragma unroll
      for (int j = 0; j < 4; ++j) {
        const int tt = fq * 4 + j;
        const float x = w0c + aw[j];
        const float e = 0.60653065971263342f * sigmoidf_(x);
        const float dcy = __expf(-e);
        const float a = sigmoidf_(a0c + aa[j]);
        const float k = VK[tt * 64 + cB], kk = VA[tt * 64 + cB];
        VD[tt * 64 + cB] = dcy;
        VK[tt * 64 + cB] = k * (1.0f + (a - 1.0f) * kac);
        VA[tt * 64 + cB] = -kk;
        VB[tt * 64 + cB] = kk * a;
      }
    }
    __syncthreads();
    float pc[4];
#pragma unroll
    for (int i = 0; i < 4; ++i) { const int tt = w * 4 + i; pc[i] = VR[tt * 64 + cA] * VK[tt * 64 + cA] * rkc; }
#pragma unroll
    for (int i = 0; i < 4; ++i) {
      const int tt = w * 4 + i;
      const float s = wave_sum(pc[i]);
      if (lane == 0) BO[tt] = s;
    }
    {
      struct VA_ { f32x4 A0, A1; f32x2 V; };
      auto loada = [&](VA_& q, int off, int voff) {
        q.A0 = *(const f32x4*)(VA + off); q.A1 = *(const f32x4*)(VA + off + 4);
        q.V = *(const f32x2*)(VV + voff);
      };
      auto stepf = [&](const VA_& c, VA_& nx, int off, int voff, int offn, int voffn, bool has_next) {
        const f32x4 D0 = *(const f32x4*)(VD + off), D1 = *(const f32x4*)(VD + off + 4);
        const f32x4 B0 = *(const f32x4*)(VB + off), B1 = *(const f32x4*)(VB + off + 4);
        const f32x4 K0 = *(const f32x4*)(VK + off), K1 = *(const f32x4*)(VK + off + 4);
        const f32x4 R0 = *(const f32x4*)(VR + off), R1 = *(const f32x4*)(VR + off + 4);
        if (has_next) loada(nx, offn, voffn);
        const f32x2 a[4] = {{c.A0[0], c.A0[1]}, {c.A0[2], c.A0[3]}, {c.A1[0], c.A1[1]}, {c.A1[2], c.A1[3]}};
        const f32x2 d[4] = {{D0[0], D0[1]}, {D0[2], D0[3]}, {D1[0], D1[1]}, {D1[2], D1[3]}};
        const f32x2 bb[4] = {{B0[0], B0[1]}, {B0[2], B0[3]}, {B1[0], B1[1]}, {B1[2], B1[3]}};
        const f32x2 kk[4] = {{K0[0], K0[1]}, {K0[2], K0[3]}, {K1[0], K1[1]}, {K1[2], K1[3]}};
        const f32x2 rr[4] = {{R0[0], R0[1]}, {R0[2], R0[3]}, {R1[0], R1[1]}, {R1[2], R1[3]}};
        const f32x2 p0 = (S0[0] * a[0] + S0[1] * a[1]) + (S0[2] * a[2] + S0[3] * a[3]);
        const f32x2 p1 = (S1[0] * a[0] + S1[1] * a[1]) + (S1[2] * a[2] + S1[3] * a[3]);
        const float sa0 = oct_sum(p0[0] + p0[1]);
        const float sa1 = oct_sum(p1[0] + p1[1]);
        f32x2 y0a = {0.f, 0.f}, y0b = {0.f, 0.f}, y1a = {0.f, 0.f}, y1b = {0.f, 0.f};
#pragma unroll
        for (int i = 0; i < 4; ++i) {
          const f32x2 n0 = S0[i] * d[i] + (sa0 * bb[i] + c.V[0] * kk[i]);
          const f32x2 n1 = S1[i] * d[i] + (sa1 * bb[i] + c.V[1] * kk[i]);
          S0[i] = n0; S1[i] = n1;
          if (i & 1) { y0b += n0 * rr[i]; y1b += n1 * rr[i]; } else { y0a += n0 * rr[i]; y1a += n1 * rr[i]; }
        }
        const f32x2 y0 = y0a + y0b, y1 = y1a + y1b;
        float ys0 = y0[0] + y0[1], ys1 = y1[0] + y1[1];
        asm volatile("" : "+v"(ys0));
        asm volatile("" : "+v"(ys1));
        oct_sum_pair(ys0, ys1);
        *(f32x2*)(YO + voff) = (f32x2){ys0, ys1};
      };
      const int dstep = dir ? -64 : 64;
      int off = (dir ? 15 * 64 : 0) + kq * 8, voff = (dir ? 15 * 64 : 0) + v0;
      VA_ X, Y;
      loada(X, off, voff);
#pragma unroll 1
      for (int it2 = 0; it2 < 8; ++it2) {
        stepf(X, Y, off, voff, off + dstep, voff + dstep, true);
        stepf(Y, X, off + dstep, voff + dstep, off + 2 * dstep, voff + 2 * dstep, it2 < 7);
        off += 2 * dstep; voff += 2 * dstep;
      }
    }
  }
  __syncthreads();
  output(tc_prev);
  __syncthreads();
}

template <int MODE>
DI void item_attn(const Params& p, int l, int L, int b, int h, int qi, const bf16_t* __restrict__ z, bf16_t* __restrict__ yo, unsigned char* smem, unsigned char* smc) {
  const int tid = otid() & 255, lane = tid & 63, w = tid >> 6, fr = lane & 15, fq = lane >> 4;
  unsigned char* KV0 = (MODE == 1) ? smc : smem;
  constexpr int NLD = (MODE == 1) ? 1 : 2;
  const int t5 = (MODE == 1) ? (tid + (int)(smem - smc) / 256) : tid;
  const int vkey = (MODE == 1) ? (t5 & 63) : lane, vdc0 = (MODE == 1) ? (t5 >> 6) : 2 * w;
  float* RPB = (float*)(smem + 256 * RS);
  const size_t tok0 = (size_t)b * L;
  const int rows = L / 64;
  const int qcol = (MODE == 0 ? 1792 : 2560) + h * 64, kcol = qcol + 256, vcol = qcol + 512;
  const int ntile = (MODE == 0) ? 8 : rows;
  int rs = 0;
  if (MODE == 0) { rs = qi - 4; rs = rs < 0 ? 0 : (rs > rows - 8 ? rows - 8 : rs); }
  const int qc = w * 16 + fr;
  const size_t qtok = tok0 + (size_t)qi * 64 + qc;
  bf16x8 qf[2];
#pragma unroll
  for (int ks = 0; ks < 2; ++ks) qf[ks] = *(const bf16x8*)(z + qtok * ZC + qcol + ks * 32 + fq * 8);
  float lam = 0.f, lam_init = 0.f;
  if (MODE == 0) {
    __syncthreads();
    const float* rp = p.in[19] + ((size_t)l * 4 + h) * 465;
    for (int i = tid; i < 465; i += 256) RPB[i] = rp[i];
  } else {
    const float* lp = p.in[20] + (size_t)l * 128;
    float v1 = 0.f, v2 = 0.f;
    if (lane < 32) { v1 = lp[lane] * lp[32 + lane]; v2 = lp[64 + lane] * lp[96 + lane]; }
    v1 = wave_sum(v1); v2 = wave_sum(v2);
    lam_init = 0.8f - 0.6f * __expf(-0.3f * (float)l);
    lam = __expf(v1) - __expf(v2) + lam_init;
  }
  u32x4 rk[NLD], rv[NLD];
  auto load_tile = [&](int it) {
    const size_t kt0 = tok0 + (size_t)((MODE == 0) ? (rs + it) : it) * 64;
#pragma unroll
    for (int i = 0; i < NLD; ++i) {
      const int q = t5 + i * 256;
      rk[i] = *(const u32x4*)(z + (kt0 + (q >> 3)) * ZC + kcol + (q & 7) * 8);
      rv[i] = *(const u32x4*)(z + (kt0 + vkey) * ZC + vcol + (vdc0 + i) * 8);
    }
  };
  auto store_tile = [&](int buf) {
    unsigned char* KSw = KV0 + buf * (128 * RS);
    unsigned char* VTw = KSw + 64 * RS;
#pragma unroll
    for (int i = 0; i < NLD; ++i) {
      const int q = t5 + i * 256;
      *(u32x4*)(KSw + (q >> 3) * RS + (q & 7) * 16) = rk[i];
#pragma unroll
      for (int e = 0; e < 8; ++e) {
        const unsigned vwd = rv[i][e >> 1];
        const bf16_t val = (bf16_t)((e & 1) ? (vwd >> 16) : (vwd & 0xffffu));
        *(bf16_t*)(VTw + ((vdc0 + i) * 8 + e) * RS + vkey * 2) = val;
      }
    }
  };
  load_tile(0);
  store_tile(0);
  if (ntile > 1) load_tile(1);
  constexpr int NS = (MODE == 0) ? 1 : 2;
  f32x4 o[NS][4];
  float mrun[NS], lrun[NS];
#pragma unroll
  for (int s = 0; s < NS; ++s) { mrun[s] = -1e30f; lrun[s] = 0.f;
#pragma unroll
    for (int dt = 0; dt < 4; ++dt) o[s][dt] = (f32x4){0.f, 0.f, 0.f, 0.f}; }
  const float slope2 = (MODE == 1) ? exp2f(-2.0f * (float)(h + 1)) * LOG2E : 0.f;
  const float sc2 = (MODE == 0) ? 0.125f * LOG2E : 0.17677669529663687f * LOG2E;
  const int qpos = qi * 64 + qc;
  const float dbase = (float)(fq * 4 - qpos);
  int cs = qc - 8; cs = cs < 0 ? 0 : (cs > 48 ? 48 : cs);
  for (int it = 0; it < ntile; ++it) {
    __syncthreads();
    if (it + 1 < ntile) store_tile((it + 1) & 1);
    if (it + 2 < ntile) load_tile(it + 2);
    const unsigned char* KS = KV0 + (it & 1) * (128 * RS);
    const unsigned char* VT = KS + 64 * RS;
    f32x4 s[NS][4];
#pragma unroll
    for (int kt = 0; kt < 4; ++kt) {
      const bf16x8 k0 = *(const bf16x8*)(KS + (kt * 16 + fr) * RS + fq * 16);
      const bf16x8 k1 = *(const bf16x8*)(KS + (kt * 16 + fr) * RS + 64 + fq * 16);
      const f32x4 zf = {0.f, 0.f, 0.f, 0.f};
      if (MODE == 0) { s[0][kt] = MFMA16(k0, qf[0], zf); s[0][kt] = MFMA16(k1, qf[1], s[0][kt]); }
      else { s[0][kt] = MFMA16(k0, qf[0], zf); s[NS - 1][kt] = MFMA16(k1, qf[1], zf); }
    }
    float alpha[NS];
    float mx[NS];
#pragma unroll
    for (int sh = 0; sh < NS; ++sh) mx[sh] = -1e30f;
    if (MODE == 0) {
#pragma unroll
      for (int kt = 0; kt < 4; ++kt)
#pragma unroll
        for (int j = 0; j < 4; ++j) {
          const int kj = kt * 16 + fq * 4 + j;
          const bool valid = (kj >= cs) && (kj < cs + 16);
          int dc = kj - qc + 15; dc = dc < 0 ? 0 : (dc > 30 ? 30 : dc);
          const int dr = rs + it - qi + 7;
          const float t2 = valid ? (s[0][kt][j] * sc2 + RPB[dr * 31 + dc] * LOG2E) : -1e30f;
          s[0][kt][j] = t2;
          mx[0] = fmaxf(mx[0], t2);
        }
    } else {
      const float d0 = dbase + (float)(it * 64);
#pragma unroll
      for (int kt = 0; kt < 4; ++kt)
#pragma unroll
        for (int j = 0; j < 4; ++j) {
          const float ad = slope2 * fabsf(d0 + (float)(kt * 16 + j));
#pragma unroll
          for (int sh = 0; sh < NS; ++sh) {
            const float t2 = s[sh][kt][j] * sc2 - ad;
            s[sh][kt][j] = t2;
            mx[sh] = fmaxf(mx[sh], t2);
          }
        }
    }
#pragma unroll
    for (int sh = 0; sh < NS; ++sh) {
      float m1 = mx[sh];
      m1 = fq_max(m1);
      const float mn = fmaxf(mrun[sh], m1);
      alpha[sh] = __builtin_amdgcn_exp2f(mrun[sh] - mn);
      mrun[sh] = mn;
      float ps = 0.f;
#pragma unroll
      for (int kt = 0; kt < 4; ++kt)
#pragma unroll
        for (int j = 0; j < 4; ++j) { const float pe = __builtin_amdgcn_exp2f(s[sh][kt][j] - mn); s[sh][kt][j] = pe; ps += pe; }
      lrun[sh] = lrun[sh] * alpha[sh] + ps;
#pragma unroll
      for (int dt = 0; dt < 4; ++dt) o[sh][dt] = o[sh][dt] * alpha[sh];
    }
#pragma unroll
    for (int i2 = 0; i2 < 2; ++i2) {
      bf16x8 pfr[NS];
#pragma unroll
      for (int sh = 0; sh < NS; ++sh) {
        const unsigned u0 = pack2(s[sh][2 * i2][0], s[sh][2 * i2][1]), u1 = pack2(s[sh][2 * i2][2], s[sh][2 * i2][3]);
        const unsigned u2 = pack2(s[sh][2 * i2 + 1][0], s[sh][2 * i2 + 1][1]), u3 = pack2(s[sh][2 * i2 + 1][2], s[sh][2 * i2 + 1][3]);
        const u32x4 u = {u0, u1, u2, u3};
        pfr[sh] = __builtin_bit_cast(bf16x8, u);
      }
#pragma unroll
      for (int dt = 0; dt < 4; ++dt) {
        const u32x2 va = *(const u32x2*)(VT + (dt * 16 + fr) * RS + (32 * i2 + fq * 4) * 2);
        const u32x2 vb = *(const u32x2*)(VT + (dt * 16 + fr) * RS + (32 * i2 + 16 + fq * 4) * 2);
        const u32x4 vu = {va[0], va[1], vb[0], vb[1]};
        const bf16x8 vf = __builtin_bit_cast(bf16x8, vu);
#pragma unroll
        for (int sh = 0; sh < NS; ++sh) o[sh][dt] = MFMA16(vf, pfr[sh], o[sh][dt]);
      }
    }
  }
  float linv[NS];
#pragma unroll
  for (int sh = 0; sh < NS; ++sh) { float lt = lrun[sh]; lt = fq_sum(lt); linv[sh] = rcp_(lt); }
  if (MODE == 0) {
#pragma unroll
    for (int dt = 0; dt < 4; ++dt) {
      const f32x4 r = o[0][dt] * linv[0];
      *(uint2*)(yo + qtok * 256 + h * 64 + dt * 16 + fq * 4) = make_uint2(pack2(r[0], r[1]), pack2(r[2], r[3]));
    }
  } else {
    f32x4 r[4];
    float ss = 0.f;
#pragma unroll
    for (int dt = 0; dt < 4; ++dt) {
      r[dt] = o[0][dt] * linv[0] - lam * (o[NS - 1][dt] * linv[NS - 1]);
      ss += r[dt][0] * r[dt][0] + r[dt][1] * r[dt][1] + r[dt][2] * r[dt][2] + r[dt][3] * r[dt][3];
    }
    ss = fq_sum(ss);
    const float rn = rsqrtf(ss * (1.0f / 64.0f) + 1e-5f) * (1.0f - lam_init);
    const float* sg = p.in[21] + (size_t)l * 64;
#pragma unroll
    for (int dt = 0; dt < 4; ++dt) {
      const f32x4 g = *(const f32x4*)(sg + dt * 16 + fq * 4);
      const f32x4 q = r[dt] * rn * g;
      *(uint2*)(yo + qtok * 256 + h * 64 + dt * 16 + fq * 4) = make_uint2(pack2(q[0], q[1]), pack2(q[2], q[3]));
    }
  }
}

DI void phase_mixers(const Params& p, int l, int half, unsigned* counter, unsigned char* smem) {
  const int L = half ? 2048 : 4096, nseq = HT / L, rows = L / 64;
  const bf16_t* z = (const bf16_t*)(p.ws + WS_Z);
  bf16_t* yf = (bf16_t*)(p.ws + WS_YF);
  bf16_t* yb = (bf16_t*)(p.ws + WS_YB);
  bf16_t* yn = (bf16_t*)(p.ws + WS_YN);
  bf16_t* yd = (bf16_t*)(p.ws + WS_YD);
  bf16_t* sg = (bf16_t*)(p.ws + WS_SG);
  float* bon = (float*)(p.ws + WS_BON);
  const int n_scan = nseq * 16, n_diff = nseq * 4 * rows, n_na = nseq * rows * 4, n_sg = HT / 256;
  const int total = n_scan + n_diff + n_na + n_sg;
  const int hf = __builtin_amdgcn_readfirstlane(otid() >> 8);
  unsigned char* sm = smem + hf * 65536;
  __shared__ int s_item;
  for (;;) {
    __syncthreads();
    if (threadIdx.x == 0) s_item = (int)atomicAdd(counter, 1u);
    __syncthreads();
    int it = 2 * s_item + hf;
    if (it >= total) break;
    if (it < n_scan) {
      const int dir = it & 1, h = (it >> 1) & 7, b = it >> 4;
      item_scan(p, l, L, b, h, dir, z, dir ? yb : yf, bon + (size_t)dir * HT * 8, sm);
      continue;
    }
    it -= n_scan;
    if (it < n_diff) {
      const int qb = it % rows, h = (it / rows) & 3, b = it / (rows * 4);
      item_attn<1>(p, l, L, b, h, qb, z, yd, sm, smem);
      continue;
    }
    it -= n_diff;
    if (it < n_na) {
      const int r = it % rows, h = (it / rows) & 3, b = it / (rows * 4);
      item_attn<0>(p, l, L, b, h, r, z, yn, sm, smem);
      continue;
    }
    it -= n_na;
    item_sg(p, l, L, it, z, sg);
  }
}

#define XB_TMO      128
#define XB_XCNT(j)  (256  + 64 * (j))
#define XB_XSUB(j)  (1280 + 64 * (j))
#define XB_XGEN(j)  (2304 + 64 * (j))
#define XB_TOP      3328
#define XB_TOPGEN   3392
#define XB_SPIN_CAP (1u << 18)
#define LAS __attribute__((address_space(3)))
DI unsigned xb_ld(unsigned* p)              { return __hip_atomic_load(p, __ATOMIC_RELAXED, __HIP_MEMORY_SCOPE_AGENT); }
DI unsigned xb_add(unsigned* p, unsigned v) { return __hip_atomic_fetch_add(p, v, __ATOMIC_RELAXED, __HIP_MEMORY_SCOPE_AGENT); }
DI unsigned xb_xcc_id() { return (unsigned)__builtin_amdgcn_s_getreg((3 << 11) | 20) & 0xFu; }
#define XB_SPIN(cond, bar) do { unsigned _sp = 0; while (cond) { __builtin_amdgcn_s_sleep(1); \
    if ((++_sp & 255u) == 0u) { if (xb_ld(&(bar)[XB_TMO])) break; if (_sp > XB_SPIN_CAP) { atomicAdd(&(bar)[XB_TMO], 1u); break; } } } } while (0)
struct XcdBarrier { unsigned* bar; unsigned x; volatile LAS unsigned* st; };
DI XcdBarrier xcd_barrier_post(unsigned* bar, volatile LAS unsigned* st) {
  XcdBarrier b; b.bar = bar; b.x = xb_xcc_id(); b.st = st;
  if (threadIdx.x == 0) (void)xb_add(&bar[XB_XCNT(b.x)], 1u);
  return b;
}
DI void xcd_barrier_complete(unsigned* bar, unsigned x, unsigned& nloc, unsigned& nx) {
  const unsigned G = gridDim.x * gridDim.y * gridDim.z;
  unsigned sum, cnt, mine, sp = 0u;
  for (;;) {
    sum = 0u; cnt = 0u; mine = 0u;
#pragma unroll
    for (unsigned j = 0; j < 16; ++j) { const unsigned c = xb_ld(&bar[XB_XCNT(j)]); sum += c; cnt += (c > 0u) ? 1u : 0u; mine = (j == x) ? c : mine; }
    if (sum == G) break;
    __builtin_amdgcn_s_sleep(1);
    if ((++sp & 255u) == 0u) { if (xb_ld(&bar[XB_TMO])) break; if (sp > XB_SPIN_CAP) { atomicAdd(&bar[XB_TMO], 1u); break; } }
  }
  nloc = mine > 0u ? mine : 1u; nx = cnt > 0u ? cnt : 1u;
}
DI void xcd_barrier(const XcdBarrier& b) {
  asm volatile("s_waitcnt vmcnt(0)" ::: "memory");
  __syncthreads();
  if (threadIdx.x == 0) {
    unsigned* bar = b.bar;
    __builtin_amdgcn_s_waitcnt(0);
    unsigned nloc = b.st[0], nx = b.st[1];
    if (nloc == 0u) { xcd_barrier_complete(bar, b.x, nloc, nx); b.st[0] = nloc; b.st[1] = nx; }
    const unsigned old = xb_add(&bar[XB_XSUB(b.x)], 1u);
    const unsigned gen = old / nloc;
    if (old + 1u == (gen + 1u) * nloc) {
      __builtin_amdgcn_fence(__ATOMIC_RELEASE, "agent");
      asm volatile("s_waitcnt vmcnt(0)" ::: "memory");
      const unsigned og = xb_add(&bar[XB_TOP], 1u);
      const unsigned tg = og / nx;
      if (og + 1u == (tg + 1u) * nx) xb_add(&bar[XB_TOPGEN], 1u);
      else XB_SPIN(xb_ld(&bar[XB_TOPGEN]) == tg, bar);
      __builtin_amdgcn_fence(__ATOMIC_ACQUIRE, "agent");
      xb_add(&bar[XB_XGEN(b.x)], 1u);
      asm volatile("s_waitcnt vmcnt(0)" ::: "memory");
    } else {
      XB_SPIN(xb_ld(&bar[XB_XGEN(b.x)]) == gen, bar);
      __builtin_amdgcn_fence(__ATOMIC_ACQUIRE, "agent");
      asm volatile("s_waitcnt vmcnt(0)" ::: "memory");
    }
  }
  __syncthreads();
}

__global__ void __launch_bounds__(512, 2) fwd_megakernel(Params p) {
  cg::grid_group grid = cg::this_grid();
  __shared__ __attribute__((aligned(16))) unsigned char smem[131072];
  bf16_t* W = (bf16_t*)(p.ws + WS_W);
  bf16_t* xn = (bf16_t*)(p.ws + WS_XN);
  bf16_t* hid = (bf16_t*)(p.ws + WS_HID);
  bf16_t* z = (bf16_t*)(p.ws + WS_Z);
  bf16_t* mo = (bf16_t*)(p.ws + WS_M);
  unsigned* ctl = (unsigned*)(p.ws + WS_CTL);
  __shared__ uint4 xb_words;
  if (threadIdx.x == 0) xb_words = make_uint4(0u, 0u, 0u, 0u);
  __syncthreads();
  const XcdBarrier xb = xcd_barrier_post((unsigned*)(p.ws + WS_BAR), (volatile LAS unsigned*)&xb_words);

  phase_convert(p, smem);
  grid.sync();
  for (int half = 0; half < 2; ++half) {
    const float* xin = p.in[half];
    float* x = p.out + (size_t)half * HT * D;
    const int L = half ? 2048 : 4096;
    for (int l = 0; l < NLAYER; ++l) {
      const bf16_t* Wl = W + (size_t)l * W_LAYER;
      const float* xsrc = (l == 0) ? xin : x;
      phase_norm(xsrc, p.in[2] + (size_t)l * D, xn, nullptr);
      xcd_barrier(xb);
      phase_ffn_up(xn, Wl + W_GU, hid, smem);
      xcd_barrier(xb);
      phase_gemm_resid(hid, DFF, Wl + W_WD, xsrc, x, 0.5f, smem);
      xcd_barrier(xb);
      phase_norm(x, p.in[6] + (size_t)l * D, xn, nullptr);
      xcd_barrier(xb);
      phase_proj(xn, Wl + W_IN, z, smem);
      xcd_barrier(xb);
      phase_mixers(p, l, half, ctl + (half * NLAYER + l) * 16, smem);
      xcd_barrier(xb);
      phase_ya(p, l, L, (const bf16_t*)(p.ws + WS_SG), Wl + W_G2, z, (bf16_t*)(p.ws + WS_YF), (const bf16_t*)(p.ws + WS_YB), (const float*)(p.ws + WS_BON), smem);
      xcd_barrier(xb);
      phase_merge(xn, Wl, (const bf16_t*)(p.ws + WS_YF), (const bf16_t*)(p.ws + WS_YN), (const bf16_t*)(p.ws + WS_YD), mo, smem);
      xcd_barrier(xb);
      phase_gemm_resid(mo, D, Wl + W_OUT, x, x, 1.0f, smem);
      xcd_barrier(xb);
      phase_norm(x, p.in[26] + (size_t)l * D, xn, nullptr);
      xcd_barrier(xb);
      phase_ffn_up(xn, Wl + W_GU2, hid, smem);
      xcd_barrier(xb);
      phase_gemm_resid(hid, DFF, Wl + W_WD2, x, x, 0.5f, smem);
      xcd_barrier(xb);
    }
    phase_norm(x, p.in[30], nullptr, x);
    xcd_barrier(xb);
  }
}

extern "C" void kernel_launch(void* const* d_in, const int* in_sizes, int n_in, void* d_out, int out_size, void* d_ws, size_t ws_size, hipStream_t stream) {
  static int grid_blocks = 0;
  if (!grid_blocks) {
    int dev = 0, cus = 0, per_cu = 0;
    (void)hipGetDevice(&dev);
    (void)hipDeviceGetAttribute(&cus, hipDeviceAttributeMultiprocessorCount, dev);
    (void)hipOccupancyMaxActiveBlocksPerMultiprocessor(&per_cu, fwd_megakernel, 512, 0);
    if (per_cu < 1) per_cu = 1;
    if (per_cu > 1) per_cu = 1;
    grid_blocks = cus * per_cu;
    if (ws_size < WS_END) fprintf(stderr, "kernel_launch: workspace too small: need %zu have %zu\n", (size_t)WS_END, ws_size);
  }
  (void)hipMemsetAsync((char*)d_ws + WS_CTL, 0, WS_CTL_BYTES, stream);
  Params p{};
  for (int i = 0; i < 31; ++i) p.in[i] = (const float*)d_in[i];
  p.out = (float*)d_out;
  p.ws = (unsigned char*)d_ws;
  void* args[] = {&p};
  hipError_t e = hipLaunchCooperativeKernel((void*)fwd_megakernel, dim3(grid_blocks), dim3(512), args, 0, stream);
  if (e != hipSuccess) fprintf(stderr, "cooperative launch failed: %s (grid %d)\n", hipGetErrorString(e), grid_blocks);
}
```

```cpp
#include <hip/hip_runtime.h>
#include <hip/hip_cooperative_groups.h>
#include <cstdio>
#include <cstdint>
namespace cg = cooperative_groups;

typedef unsigned short bf16_t;
typedef short bf16x8 __attribute__((ext_vector_type(8)));
typedef short s16x4 __attribute__((ext_vector_type(4)));
typedef float f32x4 __attribute__((ext_vector_type(4)));
typedef float f32x2 __attribute__((ext_vector_type(2)));
typedef unsigned u32x4 __attribute__((ext_vector_type(4)));
typedef unsigned u32x2 __attribute__((ext_vector_type(2)));
#define DI __device__ __forceinline__
#define MFMA16(a, b, c) __builtin_amdgcn_mfma_f32_16x16x32_bf16((a), (b), (c), 0, 0, 0)

constexpr int D = 1024, DFF = 2816, HT = 65536  , NLAYER = 2;
constexpr int ZC = 3328;
constexpr int INC = 6400;
constexpr int CA = 512;
constexpr float LOG2E = 1.4426950408889634f;

constexpr size_t WS_CTL = 0;
constexpr size_t WS_BAR = 4096;
constexpr size_t WS_CTL_BYTES = 32768;
constexpr size_t WS_W = WS_CTL_BYTES;
constexpr size_t W_GU = 0;
constexpr size_t W_WD = W_GU + (size_t)2 * DFF * D;
constexpr size_t W_GU2 = W_WD + (size_t)D * DFF;
constexpr size_t W_WD2 = W_GU2 + (size_t)2 * DFF * D;
constexpr size_t W_IN = W_WD2 + (size_t)D * DFF;
constexpr size_t W_PA = W_IN + (size_t)INC * D;
constexpr size_t W_PB = W_PA + (size_t)D * 512;
constexpr size_t W_PC = W_PB + (size_t)D * 256;
constexpr size_t W_OUT = W_PC + (size_t)D * 256;
constexpr size_t W_G2 = W_OUT + (size_t)D * D;
constexpr size_t W_LAYER = W_G2 + (size_t)512 * 128;
constexpr size_t WS_XN = WS_W + 2 * W_LAYER * 2;
constexpr size_t WS_R = WS_XN + (size_t)HT * D * 2;
constexpr size_t WS_HID = WS_R;
constexpr size_t WS_Z = WS_R;
constexpr size_t WS_M = WS_R;
constexpr size_t WS_YF = WS_Z + (size_t)HT * ZC * 2;
constexpr size_t WS_YB = WS_YF + (size_t)HT * 512 * 2;
constexpr size_t WS_YN = WS_YB + (size_t)HT * 512 * 2;
constexpr size_t WS_YD = WS_YN + (size_t)HT * 256 * 2;
constexpr size_t WS_SG = WS_YD + (size_t)HT * 256 * 2;
constexpr size_t WS_BON = WS_SG + (size_t)HT * 128 * 2;
constexpr size_t WS_END = WS_BON + (size_t)2 * HT * 8 * 4;

struct Params {
  const float* in[31];
  float* out;
  unsigned char* ws;
};

typedef __bf16 bf16x2_t __attribute__((ext_vector_type(2)));
DI unsigned pack2(float lo, float hi) { const f32x2 v = {lo, hi}; const bf16x2_t b = __builtin_convertvector(v, bf16x2_t); return __builtin_bit_cast(unsigned, b); }
DI bf16_t f2bf(float x) { return (bf16_t)(pack2(x, x) & 0xffffu); }
DI float bf2f(bf16_t h) { return __uint_as_float(((unsigned)h) << 16); }
DI float lo2f(unsigned u) { return __uint_as_float(u << 16); }
DI float hi2f(unsigned u) { return __uint_as_float(u & 0xffff0000u); }
DI float xor16_sum(float v) { const auto r = __builtin_amdgcn_permlane16_swap(__float_as_uint(v), __float_as_uint(v), false, false); return __uint_as_float(r[0]) + __uint_as_float(r[1]); }
DI float xor32_sum(float v) { const auto r = __builtin_amdgcn_permlane32_swap(__float_as_uint(v), __float_as_uint(v), false, false); return __uint_as_float(r[0]) + __uint_as_float(r[1]); }
DI float xor16_max(float v) { const auto r = __builtin_amdgcn_permlane16_swap(__float_as_uint(v), __float_as_uint(v), false, false); return fmaxf(__uint_as_float(r[0]), __uint_as_float(r[1])); }
DI float xor32_max(float v) { const auto r = __builtin_amdgcn_permlane32_swap(__float_as_uint(v), __float_as_uint(v), false, false); return fmaxf(__uint_as_float(r[0]), __uint_as_float(r[1])); }
DI float fq_sum(float v) { return xor32_sum(xor16_sum(v)); }
DI float fq_max(float v) { return xor32_max(xor16_max(v)); }
DI float quad_sum(float v) {
  int t = __builtin_amdgcn_update_dpp(0, __float_as_int(v), 0xB1, 0xF, 0xF, true);
  v += __int_as_float(t);
  t = __builtin_amdgcn_update_dpp(0, __float_as_int(v), 0x4E, 0xF, 0xF, true);
  v += __int_as_float(t);
  return v;
}
DI float oct_sum(float v) {
  v = quad_sum(v);
  const int t = __builtin_amdgcn_update_dpp(0, __float_as_int(v), 0x141, 0xF, 0xF, true);
  return v + __int_as_float(t);
}
DI float row_sum16(float v) {
  v = oct_sum(v);
  const int t = __builtin_amdgcn_update_dpp(0, __float_as_int(v), 0x140, 0xF, 0xF, true);
  return v + __int_as_float(t);
}
DI float wave_sum(float v) { return fq_sum(row_sum16(v)); }
DI void oct_sum_pair(float& a, float& b) {
#define OSP_STAGE(ctrl) { const int ta = __builtin_amdgcn_update_dpp(0, __float_as_int(a), ctrl, 0xF, 0xF, true); const int tb = __builtin_amdgcn_update_dpp(0, __float_as_int(b), ctrl, 0xF, 0xF, true); \
    a += __int_as_float(ta); b += __int_as_float(tb); asm volatile("" : "+v"(a)); asm volatile("" : "+v"(b)); }
  OSP_STAGE(0xB1) OSP_STAGE(0x4E) OSP_STAGE(0x141)
#undef OSP_STAGE
}
DI int otid() { int t = threadIdx.x; asm volatile("" : "+v"(t)); return t; }
DI float rcp_(float x) { return __builtin_amdgcn_rcpf(x); }
DI float sigmoidf_(float x) { return rcp_(1.0f + __expf(-x)); }

DI void convert_job(const float* __restrict__ src, int K, int N, bf16_t* __restrict__ dst, int mode, float* tile  ) {
  const int tid = otid();
  const int ntk = K / 64, ntn = N / 64, nt = ntk * ntn;
  for (int t = blockIdx.x; t < nt; t += gridDim.x) {
    const int tk = t / ntn, tn = t % ntn;
    const int k0 = tk * 64, n0 = tn * 64;
    __syncthreads();
#pragma unroll
    for (int i = 0; i < 8; ++i) {
      const int kk = (tid >> 6) + i * 8, nn = tid & 63;
      tile[kk * 65 + nn] = src[(size_t)(k0 + kk) * N + n0 + nn];
    }
    __syncthreads();
    const int nn = tid >> 3, kc = (tid & 7) * 8;
    const int n = n0 + nn;
    int row = n;
    if (mode == 1) row = (n >> 5) * 64 + (n & 31);
    else if (mode == 2) row = (n >> 5) * 64 + 32 + (n & 31);
    u32x4 pk;
#pragma unroll
    for (int i = 0; i < 4; ++i) pk[i] = pack2(tile[(kc + 2 * i) * 65 + nn], tile[(kc + 2 * i + 1) * 65 + nn]);
    *(u32x4*)(dst + (size_t)row * K + k0 + kc) = pk;
  }
}

DI void phase_convert(const Params& p, unsigned char* smem) {
  float* tile = (float*)smem;
  bf16_t* W = (bf16_t*)(p.ws + WS_W);
  for (int l = 0; l < NLAYER; ++l) {
    bf16_t* Wl = W + (size_t)l * W_LAYER;
    convert_job(p.in[3] + (size_t)l * D * DFF, D, DFF, Wl + W_GU, 1, tile);
    convert_job(p.in[4] + (size_t)l * D * DFF, D, DFF, Wl + W_GU, 2, tile);
    convert_job(p.in[5] + (size_t)l * DFF * D, DFF, D, Wl + W_WD, 0, tile);
    convert_job(p.in[27] + (size_t)l * D * DFF, D, DFF, Wl + W_GU2, 1, tile);
    convert_job(p.in[28] + (size_t)l * D * DFF, D, DFF, Wl + W_GU2, 2, tile);
    convert_job(p.in[29] + (size_t)l * DFF * D, DFF, D, Wl + W_WD2, 0, tile);
    convert_job(p.in[7] + (size_t)l * D * INC, D, INC, Wl + W_IN, 0, tile);
    convert_job(p.in[22] + (size_t)l * 512 * D, 512, D, Wl + W_PA, 0, tile);
    convert_job(p.in[23] + (size_t)l * 256 * D, 256, D, Wl + W_PB, 0, tile);
    convert_job(p.in[24] + (size_t)l * 256 * D, 256, D, Wl + W_PC, 0, tile);
    convert_job(p.in[25] + (size_t)l * D * D, D, D, Wl + W_OUT, 0, tile);
    convert_job(p.in[16] + (size_t)l * 128 * 512, 128, 512, Wl + W_G2, 0, tile);
  }
}

DI void phase_norm(const float* __restrict__ src, const float* __restrict__ gam, bf16_t* __restrict__ xn, float* __restrict__ fout) {
  const int tid_ = otid(), lane = tid_ & 63, w = tid_ >> 6;
  f32x4 g[4];
#pragma unroll
  for (int i = 0; i < 4; ++i) g[i] = *(const f32x4*)(gam + i * 256 + lane * 4);
  const int stride = gridDim.x * 8;
  auto ld = [&](f32x4 (&v)[4], int row) {
    if (row < HT) {
#pragma unroll
      for (int i = 0; i < 4; ++i) v[i] = *(const f32x4*)(src + (size_t)row * D + i * 256 + lane * 4);
    }
  };
  auto proc = [&](const f32x4 (&v)[4], int row) {
    float ss = 0.f;
#pragma unroll
    for (int i = 0; i < 4; ++i) ss += (v[i][0] * v[i][0] + v[i][1] * v[i][1]) + (v[i][2] * v[i][2] + v[i][3] * v[i][3]);
    ss = wave_sum(ss);
    const float rs = rsqrtf(ss * (1.0f / 1024.0f) + 1e-6f);
#pragma unroll
    for (int i = 0; i < 4; ++i) {
      const f32x4 y = v[i] * rs * g[i];
      if (fout) *(f32x4*)(fout + (size_t)row * D + i * 256 + lane * 4) = y;
      else *(uint2*)(xn + (size_t)row * D + i * 256 + lane * 4) = make_uint2(pack2(y[0], y[1]), pack2(y[2], y[3]));
    }
  };
  int t = blockIdx.x * 8 + w;
  f32x4 a[4], b[4];
  ld(a, t); ld(b, t + stride);
  for (; t < HT; t += 2 * stride) {
    f32x4 na[4], nb[4];
    ld(na, t + 2 * stride); ld(nb, t + 3 * stride);
    proc(a, t);
    if (t + stride < HT) proc(b, t + stride);
#pragma unroll
    for (int i = 0; i < 4; ++i) { a[i] = na[i]; b[i] = nb[i]; }
  }
}

constexpr int RS = 144;
typedef __attribute__((address_space(3))) unsigned lds_u32;
DI void glds16(const void* g, unsigned char* l) { __builtin_amdgcn_global_load_lds((const unsigned*)g, (lds_u32*)l, 16, 0, 0); }
template <int N> DI void wait_vm() { asm volatile("s_waitcnt vmcnt(%0)" :: "n"(N) : "memory"); }
template <int MT, int NT, int WR, int WC>
DI void gemm_block(const bf16_t* __restrict__ A, int lda, const bf16_t* __restrict__ B, int ldb, int K, f32x4 (&acc)[MT][NT], unsigned char* smem,
                   bool primed = false, const bf16_t* __restrict__ nA = nullptr, int nlda = 0, const bf16_t* __restrict__ nB = nullptr, int nldb = 0) {
  static_assert(WR * WC == 8, "8 waves");
  constexpr int AR = 16 * MT * WR, BR = 16 * NT * WC;
  constexpr int AB = AR * 128, BB = BR * 128, STG = AB + BB;
  constexpr int NA = AR * 8 / 512, NB = BR * 8 / 512;
  const int tid = otid(), lane = tid & 63, w = tid >> 6, wr = w / WC, wc = w % WC, fr = lane & 15, fq = lane >> 4;
  const int srow = tid >> 3, kch = (tid & 7) ^ ((tid >> 4) & 7);
  const unsigned voA = (unsigned)(srow * lda + kch * 8) * 2u, voB = (unsigned)(srow * ldb + kch * 8) * 2u;
  const char* Ab = (const char*)A;
  const char* Bb = (const char*)B;
  const int nk = K >> 6;
  if (!primed) {
#pragma unroll
    for (int i = 0; i < NA; ++i) glds16(Ab + (size_t)i * 128 * lda + voA, smem + (i * 512 + tid) * 16);
#pragma unroll
    for (int i = 0; i < NB; ++i) glds16(Bb + (size_t)i * 128 * ldb + voB, smem + AB + (i * 512 + tid) * 16);
  }
  const int sw = (fr >> 1) & 7;
  const unsigned lds_base = (unsigned)(size_t)(__attribute__((address_space(3))) unsigned char*)smem;
  const unsigned a_row = (wr * 16 * MT + fr) * 128, b_row = AB + (wc * 16 * NT + fr) * 128;
  for (int kt = 0; kt < nk; ++kt) {
    wait_vm<0>();
    __builtin_amdgcn_s_barrier();
    if (kt + 1 < nk) {
      unsigned char* sn = smem + ((kt + 1) & 1) * STG;
      const int ko = (kt + 1) * 64;
#pragma unroll
      for (int i = 0; i < NA; ++i) glds16(Ab + ((size_t)i * 128 * lda + ko * 2) + voA, sn + (i * 512 + tid) * 16);
#pragma unroll
      for (int i = 0; i < NB; ++i) glds16(Bb + ((size_t)i * 128 * ldb + ko * 2) + voB, sn + AB + (i * 512 + tid) * 16);
    } else if (nA) {
      const unsigned nvoA = (unsigned)(srow * nlda + kch * 8) * 2u, nvoB = (unsigned)(srow * nldb + kch * 8) * 2u;
#pragma unroll
      for (int i = 0; i < NA; ++i) glds16((const char*)nA + (size_t)i * 128 * nlda + nvoA, smem + (i * 512 + tid) * 16);
#pragma unroll
      for (int i = 0; i < NB; ++i) glds16((const char*)nB + (size_t)i * 128 * nldb + nvoB, smem + AB + (i * 512 + tid) * 16);
    }
    const unsigned stb = lds_base + (kt & 1) * STG;
#pragma unroll
    for (int ks = 0; ks < 2; ++ks) {
      const unsigned co = ((ks * 4 + fq) ^ sw) * 16;
      const unsigned sa = stb + a_row + co, sb = stb + b_row + co;
      bf16x8 af[4], bfr[NT];
#pragma unroll
      for (int n = 0; n < NT; ++n) asm volatile("ds_read_b128 %0, %1 offset:%2" : "=v"(bfr[n]) : "v"(sb), "n"(n * 2048) : "memory");
#pragma unroll
      for (int mg = 0; mg < MT / 4; ++mg) {
#pragma unroll
        for (int m = 0; m < 4; ++m) asm volatile("ds_read_b128 %0, %1 offset:%2" : "=v"(af[m]) : "v"(sa), "n"((mg * 4 + m) * 2048) : "memory");
        if (mg == 0) {
#pragma unroll
          for (int n = 0; n < NT; ++n) asm volatile("s_waitcnt lgkmcnt(%1)" : "+v"(bfr[n]) : "n"(4 + NT - 1 - n) : "memory");
        }
#pragma unroll
        for (int m = 0; m < 4; ++m) {
          asm volatile("s_waitcnt lgkmcnt(%1)" : "+v"(af[m]) : "n"(3 - m) : "memory");
#pragma unroll
          for (int n = 0; n < NT; ++n) acc[mg * 4 + m][n] = MFMA16(bfr[n], af[m], acc[mg * 4 + m][n]);
        }
      }
    }
  }
  if (!nA) __syncthreads();
}

template <int MT, int NT>
DI void zero_acc(f32x4 (&acc)[MT][NT]) {
#pragma unroll
  for (int m = 0; m < MT; ++m)
#pragma unroll
    for (int n = 0; n < NT; ++n) acc[m][n] = (f32x4){0.f, 0.f, 0.f, 0.f};
}

DI void tile_coords(int id, int nN, int& pm, int& pn) {
  const int band = id / (16 * nN), r = id % (16 * nN);
  pm = band * 16 + (r & 15); pn = r >> 4;
}

DI void phase_ffn_up(const bf16_t* __restrict__ xn, const bf16_t* __restrict__ gu, bf16_t* __restrict__ hid, unsigned char* smem) {
  const int tid_ = otid(), lane = tid_ & 63, w = tid_ >> 6, wr = w >> 2, wc = w & 3, fr = lane & 15, fq = lane >> 4;
  constexpr int nN = 2 * DFF / 256, nM = HT / 256;
  for (int id = blockIdx.x; id < nM * nN; id += gridDim.x) {
    int pm, pn; tile_coords(id, nN, pm, pn);
    f32x4 acc[8][4]; zero_acc(acc);
    {
      const int idn = id + gridDim.x; int pm2 = 0, pn2 = 0; const bool hn = idn < nM * nN; if (hn) tile_coords(idn, nN, pm2, pn2);
      gemm_block<8, 4, 2, 4>(xn + (size_t)pm * 256 * D, D, gu + (size_t)pn * 256 * D, D, D, acc, smem, id != (int)blockIdx.x,
                             hn ? xn + (size_t)pm2 * 256 * D : nullptr, D, gu + (size_t)pn2 * 256 * D, D);
    }
    const int hc0 = (pn * 4 + wc) * 32 + fq * 4;
#pragma unroll
    for (int m = 0; m < 8; ++m) {
      const size_t row = (size_t)pm * 256 + wr * 128 + m * 16 + fr;
#pragma unroll
      for (int n = 0; n < 2; ++n) {
        float h[4];
#pragma unroll
        for (int j = 0; j < 4; ++j) { const float g = acc[m][n][j], u = acc[m][n + 2][j]; h[j] = g * rcp_(1.0f + __expf(-g)) * u; }
        *(uint2*)(hid + row * DFF + hc0 + n * 16) = make_uint2(pack2(h[0], h[1]), pack2(h[2], h[3]));
      }
    }
  }
}

DI void phase_gemm_resid(const bf16_t* __restrict__ A, int K, const bf16_t* __restrict__ Bt, const float* __restrict__ xin, float* __restrict__ xout, float alpha, unsigned char* smem) {
  const int tid_ = otid(), lane = tid_ & 63, w = tid_ >> 6, wr = w >> 2, wc = w & 3, fr = lane & 15, fq = lane >> 4;
  constexpr int nN = D / 256, nM = HT / 256;
  for (int id = blockIdx.x; id < nM * nN; id += gridDim.x) {
    int pm, pn; tile_coords(id, nN, pm, pn);
    f32x4 acc[8][4]; zero_acc(acc);
    {
      const int idn = id + gridDim.x; int pm2 = 0, pn2 = 0; const bool hn = idn < nM * nN; if (hn) tile_coords(idn, nN, pm2, pn2);
      gemm_block<8, 4, 2, 4>(A + (size_t)pm * 256 * K, K, Bt + (size_t)pn * 256 * K, K, K, acc, smem, id != (int)blockIdx.x,
                             hn ? A + (size_t)pm2 * 256 * K : nullptr, K, Bt + (size_t)pn2 * 256 * K, K);
    }
#pragma unroll
    for (int m = 0; m < 8; ++m) {
      const size_t row = (size_t)pm * 256 + wr * 128 + m * 16 + fr;
#pragma unroll
      for (int n = 0; n < 4; ++n) {
        const size_t o = row * D + pn * 256 + wc * 64 + n * 16 + fq * 4;
        const f32x4 x = *(const f32x4*)(xin + o);
        *(f32x4*)(xout + o) = x + alpha * acc[m][n];
      }
    }
  }
}

DI void phase_proj(const bf16_t* __restrict__ xn, const bf16_t* __restrict__ wint, bf16_t* __restrict__ z, unsigned char* smem) {
  const int tid_ = otid(), lane = tid_ & 63, w = tid_ >> 6, wr = w >> 2, wc = w & 3, fr = lane & 15, fq = lane >> 4;
  constexpr int nN = ZC / 256, nM = HT / 256;
  for (int id = blockIdx.x; id < nM * nN; id += gridDim.x) {
    int pm, pn; tile_coords(id, nN, pm, pn);
    f32x4 acc[8][4]; zero_acc(acc);
    {
      const int idn = id + gridDim.x; int pm2 = 0, pn2 = 0; const bool hn = idn < nM * nN; if (hn) tile_coords(idn, nN, pm2, pn2);
      gemm_block<8, 4, 2, 4>(xn + (size_t)pm * 256 * D, D, wint + (size_t)pn * 256 * D, D, D, acc, smem, id != (int)blockIdx.x,
                             hn ? xn + (size_t)pm2 * 256 * D : nullptr, D, wint + (size_t)pn2 * 256 * D, D);
    }
#pragma unroll
    for (int m = 0; m < 8; ++m) {
      const size_t row = (size_t)pm * 256 + wr * 128 + m * 16 + fr;
#pragma unroll
      for (int n = 0; n < 4; ++n) {
        const f32x4 a = acc[m][n];
        *(uint2*)(z + row * ZC + pn * 256 + wc * 64 + n * 16 + fq * 4) = make_uint2(pack2(a[0], a[1]), pack2(a[2], a[3]));
      }
    }
  }
}

DI void phase_ya(const Params& p, int l, int L, const bf16_t* __restrict__ sg, const bf16_t* __restrict__ g2t, const bf16_t* __restrict__ z,
                 bf16_t* __restrict__ yf, const bf16_t* __restrict__ yb, const float* __restrict__ bon, unsigned char* smem) {
  const int tid_ = otid(), lane = tid_ & 63, w = tid_ >> 6, wr = w >> 2, wc = w & 3, fr = lane & 15, fq = lane >> 4;
  constexpr int nN = 2, nM = HT / 256;
  const float* mu0 = p.in[8] + (size_t)l * 2 * 1792;
  const float* mu1 = mu0 + 1792;
  const float* lng = p.in[17] + (size_t)l * CA;
  const float* lnb = p.in[18] + (size_t)l * CA;
  for (int id = blockIdx.x; id < nM * nN; id += gridDim.x) {
    int pm, pn; tile_coords(id, nN, pm, pn);
    f32x4 acc[8][4]; zero_acc(acc);
    {
      const int idn = id + gridDim.x; int pm2 = 0, pn2 = 0; const bool hn = idn < nM * nN; if (hn) tile_coords(idn, nN, pm2, pn2);
      gemm_block<8, 4, 2, 4>(sg + (size_t)pm * 256 * 128, 128, g2t + (size_t)pn * 256 * 128, 128, 128, acc, smem, id != (int)blockIdx.x,
                             hn ? sg + (size_t)pm2 * 256 * 128 : nullptr, 128, g2t + (size_t)pn2 * 256 * 128, 128);
    }
    const int h = pn * 4 + wc;
#pragma unroll
    for (int m = 0; m < 8; ++m) {
      const int row = pm * 256 + wr * 128 + m * 16 + fr;
      const int t = row % L;
      const bool hasp = t > 0, hasn = t < L - 1;
      float y[4][4];
      float s = 0.f;
#pragma unroll
      for (int n = 0; n < 4; ++n) {
        const int c = h * 64 + n * 16 + fq * 4;
        const uint2 a = *(const uint2*)(yf + (size_t)row * CA + c);
        const uint2 b = *(const uint2*)(yb + (size_t)row * CA + c);
        y[n][0] = lo2f(a.x) + lo2f(b.x); y[n][1] = hi2f(a.x) + hi2f(b.x); y[n][2] = lo2f(a.y) + lo2f(b.y); y[n][3] = hi2f(a.y) + hi2f(b.y);
        s += (y[n][0] + y[n][1]) + (y[n][2] + y[n][3]);
      }
      s = fq_sum(s);
      const float mean = s * (1.0f / 64.0f);
      float q = 0.f;
#pragma unroll
      for (int n = 0; n < 4; ++n)
#pragma unroll
        for (int j = 0; j < 4; ++j) { const float d = y[n][j] - mean; q += d * d; }
      q = fq_sum(q);
      const float rstd = rsqrtf(q * (1.0f / 64.0f) + 64e-5f);
      const float bsum = bon[(size_t)row * 8 + h] + bon[(size_t)HT * 8 + (size_t)row * 8 + h];
#pragma unroll
      for (int n = 0; n < 4; ++n) {
        const int c = h * 64 + n * 16 + fq * 4;
        const bf16_t* zr = z + (size_t)row * ZC + 1024 + c;
        const uint2 v0 = *(const uint2*)zr;
        uint2 vp = make_uint2(0u, 0u), vn = make_uint2(0u, 0u);
        if (hasp) vp = *(const uint2*)(zr - ZC);
        if (hasn) vn = *(const uint2*)(zr + ZC);
        const f32x4 m0 = *(const f32x4*)(mu0 + 1024 + c), m1 = *(const f32x4*)(mu1 + 1024 + c);
        const f32x4 gg = *(const f32x4*)(lng + c), bb = *(const f32x4*)(lnb + c);
        const float vc[4] = {lo2f(v0.x), hi2f(v0.x), lo2f(v0.y), hi2f(v0.y)};
        const float vpp[4] = {lo2f(vp.x), hi2f(vp.x), lo2f(vp.y), hi2f(vp.y)};
        const float vnn[4] = {lo2f(vn.x), hi2f(vn.x), lo2f(vn.y), hi2f(vn.y)};
        float o[4];
#pragma unroll
        for (int j = 0; j < 4; ++j) {
          const float vs = vc[j] + m0[j] * (vpp[j] - vc[j]) + m1[j] * (vnn[j] - vc[j]);
          o[j] = ((y[n][j] - mean) * rstd * gg[j] + bb[j] + bsum * vs) * acc[m][n][j];
        }
        *(uint2*)(yf + (size_t)row * CA + c) = make_uint2(pack2(o[0], o[1]), pack2(o[2], o[3]));
      }
    }
  }
}

DI void phase_merge(const bf16_t* __restrict__ xn, const bf16_t* __restrict__ Wl, const bf16_t* __restrict__ ya, const bf16_t* __restrict__ yn, const bf16_t* __restrict__ yd,
                    bf16_t* __restrict__ mo, unsigned char* smem) {
  const int tid_ = otid(), lane = tid_ & 63, w = tid_ >> 6, wr = w >> 1, wc = w & 1, fr = lane & 15, fq = lane >> 4;
  constexpr int nN = D / 128, nM = HT / 256;
  for (int id = blockIdx.x; id < nM * nN; id += gridDim.x) {
    int pm, pn; tile_coords(id, nN, pm, pn);
    unsigned tot[4][4][2];
#pragma unroll 1
    for (int i = 0; i < 3; ++i) {
      unsigned gp[4][4][2];
      {
        f32x4 ag[4][4]; zero_acc(ag);
        const bf16_t* Yn = (i == 0) ? ya : (i == 1 ? yn : yd);
        const int Kn = (i == 0) ? 512 : 256;
        const bf16_t* Pn = Wl + (i == 0 ? W_PA : (i == 1 ? W_PB : W_PC));
        gemm_block<4, 4, 4, 2>(xn + (size_t)pm * 256 * D, D, Wl + W_IN + (size_t)(ZC + i * 1024 + pn * 128) * D, D, D, ag, smem, !(i == 0 && id == (int)blockIdx.x),
                               Yn + (size_t)pm * 256 * Kn, Kn, Pn + (size_t)pn * 128 * Kn, Kn);
#pragma unroll
        for (int m = 0; m < 4; ++m)
#pragma unroll
          for (int n = 0; n < 4; ++n) {
            gp[m][n][0] = pack2(sigmoidf_(ag[m][n][0]), sigmoidf_(ag[m][n][1]));
            gp[m][n][1] = pack2(sigmoidf_(ag[m][n][2]), sigmoidf_(ag[m][n][3]));
          }
      }
      f32x4 ay[4][4]; zero_acc(ay);
      const bf16_t* Y = (i == 0) ? ya : (i == 1 ? yn : yd);
      const int Ki = (i == 0) ? 512 : 256;
      const bf16_t* P = Wl + (i == 0 ? W_PA : (i == 1 ? W_PB : W_PC));
      {
        const int idn = id + gridDim.x; int pm2 = pm, pn2 = pn, i2 = i + 1; bool hn = true;
        if (i == 2) { i2 = 0; hn = idn < nM * nN; if (hn) tile_coords(idn, nN, pm2, pn2); }
        gemm_block<4, 4, 4, 2>(Y + (size_t)pm * 256 * Ki, Ki, P + (size_t)pn * 128 * Ki, Ki, Ki, ay, smem, true,
                               hn ? xn + (size_t)pm2 * 256 * D : nullptr, D, Wl + W_IN + (size_t)(ZC + i2 * 1024 + pn2 * 128) * D, D);
      }
#pragma unroll
      for (int m = 0; m < 4; ++m)
#pragma unroll
        for (int n = 0; n < 4; ++n) {
          float t0 = ay[m][n][0] * lo2f(gp[m][n][0]), t1 = ay[m][n][1] * hi2f(gp[m][n][0]);
          float t2 = ay[m][n][2] * lo2f(gp[m][n][1]), t3 = ay[m][n][3] * hi2f(gp[m][n][1]);
          if (i > 0) { t0 += lo2f(tot[m][n][0]); t1 += hi2f(tot[m][n][0]); t2 += lo2f(tot[m][n][1]); t3 += hi2f(tot[m][n][1]); }
          tot[m][n][0] = pack2(t0, t1); tot[m][n][1] = pack2(t2, t3);
        }
    }
#pragma unroll
    for (int m = 0; m < 4; ++m) {
      const size_t row = (size_t)pm * 256 + wr * 64 + m * 16 + fr;
#pragma unroll
      for (int n = 0; n < 4; ++n)
        *(uint2*)(mo + row * D + pn * 128 + wc * 64 + n * 16 + fq * 4) = make_uint2(tot[m][n][0], tot[m][n][1]);
    }
  }
}

DI void item_sg(const Params& p, int l, int L, int item, const bf16_t* __restrict__ z, bf16_t* __restrict__ sg) {
  const int tid_ = otid() & 255, lane = tid_ & 63, w = tid_ >> 6;
  const float* mu0 = p.in[8] + (size_t)l * 2 * 1792 + 1664 + 2 * lane;
  const float* mu1 = mu0 + 1792;
  const float m0a = mu0[0], m0b = mu0[1], m1a = mu1[0], m1b = mu1[1];
  for (int i = w; i < 256; i += 4) {
    const int row = item * 256 + i;
    const int t = row % L;
    const bf16_t* zr = z + (size_t)row * ZC + 1664 + 2 * lane;
    const unsigned c = *(const unsigned*)zr;
    const unsigned pv = (t > 0) ? *(const unsigned*)(zr - ZC) : 0u;
    const unsigned nv = (t < L - 1) ? *(const unsigned*)(zr + ZC) : 0u;
    const float ca = lo2f(c), cb = hi2f(c);
    const float ga = ca + m0a * (lo2f(pv) - ca) + m1a * (lo2f(nv) - ca);
    const float gb = cb + m0b * (hi2f(pv) - cb) + m1b * (hi2f(nv) - cb);
    *(unsigned*)(sg + (size_t)row * 128 + 2 * lane) = pack2(sigmoidf_(ga), sigmoidf_(gb));
  }
}

DI void item_scan(const Params& p, int l, int L, int b, int h, int dir, const bf16_t* __restrict__ z, bf16_t* __restrict__ yout, float* __restrict__ bon, unsigned char* smem) {
  const int tid = otid() & 255, lane = tid & 63, w = tid >> 6, fr = lane & 15, fq = lane >> 4;
  unsigned* ZR = (unsigned*)smem;
  float* VR = (float*)(smem + 11520);
  float* VD = VR + 1024; float* VK = VD + 1024; float* VV = VK + 1024; float* VA = VV + 1024; float* VB = VA + 1024;
  float* YO = VB + 1024;
  float* BO = YO + 1024;
  unsigned char* WT = (unsigned char*)(BO + 16);
  unsigned char* AL = WT + 16 * RS;
  float* MU = (float*)(AL + 16 * RS);
  float* KKC = MU + 640;
  const size_t tok0 = (size_t)b * L;
  const float* mu0 = p.in[8] + (size_t)l * 2 * 1792;
  const float* mu1 = mu0 + 1792;
  const int cA = lane;
  __syncthreads();
  for (int i = tid; i < 640; i += 256) {
    const int s5 = i >> 7, d = (i >> 6) & 1, c = i & 63;
    const int col = (s5 < 3) ? (s5 * 512 + h * 64 + c) : (1536 + (s5 - 3) * 64 + c);
    MU[i] = (d ? mu1 : mu0)[col];
  }
  if (tid < 64) KKC[tid] = p.in[15][(size_t)l * CA + h * 64 + tid];
  const float rkc = p.in[14][((size_t)l * 2 + dir) * CA + h * 64 + cA];
  const int cB = w * 16 + fr;
  const float w0c = p.in[9][((size_t)l * 2 + dir) * CA + h * 64 + cB];
  const float a0c = p.in[11][((size_t)l * 2 + dir) * CA + h * 64 + cB];
  const float kac = p.in[13][((size_t)l * 2 + dir) * CA + h * 64 + cB];
  bf16x8 bw[2], ba[2];
  {
    const float* w2 = p.in[10] + ((size_t)l * 2 + dir) * 64 * CA + h * 64 + cB;
    const float* a2 = p.in[12] + ((size_t)l * 2 + dir) * 64 * CA + h * 64 + cB;
#pragma unroll
    for (int ks = 0; ks < 2; ++ks)
#pragma unroll
      for (int j = 0; j < 8; ++j) {
        bw[ks][j] = (short)f2bf(w2[(size_t)(ks * 32 + fq * 8 + j) * CA]);
        ba[ks][j] = (short)f2bf(a2[(size_t)(ks * 32 + fq * 8 + j) * CA]);
      }
  }
  const int kq = lane & 7, v0 = w * 16 + (lane >> 3) * 2;
  f32x2 S0[4], S1[4];
#pragma unroll
  for (int i = 0; i < 4; ++i) { S0[i] = (f32x2){0.f, 0.f}; S1[i] = (f32x2){0.f, 0.f}; }

  unsigned pf[12], poff[12];
  unsigned vbits = 0u, r0bits = 0u, r17bits = 0u, pf_ok = 0u;
#pragma unroll
  for (int i = 0; i < 12; ++i) {
    const int q = tid + i * 256;
    const int row = q / 160, pr = q - row * 160;
    const int col = (pr < 96) ? ((pr >> 5) * 512 + h * 64 + (pr & 31) * 2) : (1536 + (pr - 96) * 2);
    poff[i] = (q < 2880) ? (unsigned)(row * ZC + col) * 2u : 0u;
    if (q < 2880) vbits |= 1u << i;
    if (row == 0) r0bits |= 1u << i;
    if (row == 17) r17bits |= 1u << i;
  }
  auto prefetch = [&](int tc) {
    const char* zc = (const char*)(z + (tok0 + tc) * ZC) - (size_t)ZC * 2;
    pf_ok = vbits & ~((tc == 0) ? r0bits : 0u) & ~((tc == L - 16) ? r17bits : 0u);
#pragma unroll
    for (int i = 0; i < 12; ++i)
      pf[i] = *(const unsigned*)(zc + (((pf_ok >> i) & 1u) ? poff[i] : (unsigned)(ZC * 2)));
  };
  auto output = [&](int tco) {
    const int tt = tid >> 4, pj = tid & 15;
    const f32x2 ya = *(const f32x2*)(YO + tt * 64 + 2 * pj), yb2 = *(const f32x2*)(YO + tt * 64 + 32 + 2 * pj);
    bf16_t* yp = yout + (tok0 + tco + tt) * CA + h * 64 + 2 * pj;
    *(unsigned*)yp = pack2(ya[0], ya[1]);
    *(unsigned*)(yp + 32) = pack2(yb2[0], yb2[1]);
    if (tid < 16) bon[(tok0 + tco + tid) * 8 + h] = BO[tid];
  };
  const int nch = L / 16;
  prefetch(dir ? L - 16 : 0);
  int tc_prev = 0;
  for (int ci = 0; ci < nch; ++ci) {
    const int tc = dir ? (L - 16 - 16 * ci) : 16 * ci;
#pragma unroll
    for (int i = 0; i < 12; ++i) { const int q = tid + i * 256; if (q < 2880) ZR[q] = ((pf_ok >> i) & 1u) ? pf[i] : 0u; }
    __syncthreads();
    if (ci > 0) output(tc_prev);
    tc_prev = tc;
    if (ci + 1 < nch) prefetch(dir ? (tc - 16) : (tc + 16));
    {
      const int tt = tid >> 4, j = tid & 15, c = 4 * j;
      u32x2 zu[5][3];
      f32x4 mm[5][2];
#pragma unroll
      for (int s5 = 0; s5 < 5; ++s5) {
#pragma unroll
        for (int d3 = 0; d3 < 3; ++d3) zu[s5][d3] = *(const u32x2*)(ZR + (tt + d3) * 160 + s5 * 32 + 2 * j);
        mm[s5][0] = *(const f32x4*)(MU + (s5 * 2) * 64 + c);
        mm[s5][1] = *(const f32x4*)(MU + (s5 * 2 + 1) * 64 + c);
      }
      float zs[5][4];
#pragma unroll
      for (int s5 = 0; s5 < 5; ++s5)
#pragma unroll
        for (int e = 0; e < 4; ++e) {
          const unsigned up = zu[s5][0][e >> 1], uc = zu[s5][1][e >> 1], un = zu[s5][2][e >> 1];
          const float pv = (e & 1) ? hi2f(up) : lo2f(up), cv = (e & 1) ? hi2f(uc) : lo2f(uc), nv = (e & 1) ? hi2f(un) : lo2f(un);
          zs[s5][e] = cv + mm[s5][0][e] * (pv - cv) + mm[s5][1][e] * (nv - cv);
        }
      *(f32x4*)(VR + tt * 64 + c) = (f32x4){zs[0][0], zs[0][1], zs[0][2], zs[0][3]};
      *(f32x4*)(VK + tt * 64 + c) = (f32x4){zs[1][0], zs[1][1], zs[1][2], zs[1][3]};
      *(f32x4*)(VV + tt * 64 + c) = (f32x4){zs[2][0], zs[2][1], zs[2][2], zs[2][3]};
      const f32x4 kc = *(const f32x4*)(KKC + c);
      float kq4[4], th[4];
      float ksum = 0.f;
#pragma unroll
      for (int e = 0; e < 4; ++e) {
        kq4[e] = zs[1][e] * kc[e];
        ksum += kq4[e] * kq4[e];
        th[e] = 1.0f - 2.0f * rcp_(__expf(2.0f * zs[3][e]) + 1.0f);
      }
      *(u32x2*)(WT + tt * RS + c * 2) = (u32x2){pack2(th[0], th[1]), pack2(th[2], th[3])};
      *(u32x2*)(AL + tt * RS + c * 2) = (u32x2){pack2(zs[4][0], zs[4][1]), pack2(zs[4][2], zs[4][3])};
      ksum = row_sum16(ksum);
      const float inv = rcp_(fmaxf(sqrtf(ksum), 1e-12f));
      *(f32x4*)(VA + tt * 64 + c) = (f32x4){kq4[0] * inv, kq4[1] * inv, kq4[2] * inv, kq4[3] * inv};
    }
    __syncthreads();
    {
      f32x4 aw = {0.f, 0.f, 0.f, 0.f}, aa = {0.f, 0.f, 0.f, 0.f};
#pragma unroll
      for (int ks = 0; ks < 2; ++ks) {
        const bf16x8 fw = *(const bf16x8*)(WT + fr * RS + ks * 64 + fq * 16);
        const bf16x8 fa = *(const bf16x8*)(AL + fr * RS + ks * 64 + fq * 16);
        aw = MFMA16(fw, bw[ks], aw);
        aa = MFMA16(fa, ba[ks], aa);
      }
#pragma unroll
      for (int j = 0; j < 4; ++j) {
        const int tt = fq * 4 + j;
        const float x = w0c + aw[j];
        const float e = 0.60653065971263342f * sigmoidf_(x);
        const float dcy = __expf(-e);
        const float a = sigmoidf_(a0c + aa[j]);
        const float k = VK[tt * 64 + cB], kk = VA[tt * 64 + cB];
        VD[tt * 64 + cB] = dcy;
        VK[tt * 64 + cB] = k * (1.0f + (a - 1.0f) * kac);
        VA[tt * 64 + cB] = -kk;
        VB[tt * 64 + cB] = kk * a;
      }
    }
    __syncthreads();
    float pc[4];
#pragma unroll
    for (int i = 0; i < 4; ++i) { const int tt = w * 4 + i; pc[i] = VR[tt * 64 + cA] * VK[tt * 64 + cA] * rkc; }
#pragma unroll
    for (int i = 0; i < 4; ++i) {
      const int tt = w * 4 + i;
      const float s = wave_sum(pc[i]);
      if (lane == 0) BO[tt] = s;
    }
    {
      struct VA_ { f32x4 A0, A1; f32x2 V; };
      auto loada = [&](VA_& q, int off, int voff) {
        q.A0 = *(const f32x4*)(VA + off); q.A1 = *(const f32x4*)(VA + off + 4);
        q.V = *(const f32x2*)(VV + voff);
      };
      auto stepf = [&](const VA_& c, VA_& nx, int off, int voff, int offn, int voffn, bool has_next) {
        const f32x4 D0 = *(const f32x4*)(VD + off), D1 = *(const f32x4*)(VD + off + 4);
        const f32x4 B0 = *(const f32x4*)(VB + off), B1 = *(const f32x4*)(VB + off + 4);
        const f32x4 K0 = *(const f32x4*)(VK + off), K1 = *(const f32x4*)(VK + off + 4);
        const f32x4 R0 = *(const f32x4*)(VR + off), R1 = *(const f32x4*)(VR + off + 4);
        if (has_next) loada(nx, offn, voffn);
        const f32x2 a[4] = {{c.A0[0], c.A0[1]}, {c.A0[2], c.A0[3]}, {c.A1[0], c.A1[1]}, {c.A1[2], c.A1[3]}};
        const f32x2 d[4] = {{D0[0], D0[1]}, {D0[2], D0[3]}, {D1[0], D1[1]}, {D1[2], D1[3]}};
        const f32x2 bb[4] = {{B0[0], B0[1]}, {B0[2], B0[3]}, {B1[0], B1[1]}, {B1[2], B1[3]}};
        const f32x2 kk[4] = {{K0[0], K0[1]}, {K0[2], K0[3]}, {K1[0], K1[1]}, {K1[2], K1[3]}};
        const f32x2 rr[4] = {{R0[0], R0[1]}, {R0[2], R0[3]}, {R1[0], R1[1]}, {R1[2], R1[3]}};
        const f32x2 p0 = (S0[0] * a[0] + S0[1] * a[1]) + (S0[2] * a[2] + S0[3] * a[3]);
        const f32x2 p1 = (S1[0] * a[0] + S1[1] * a[1]) + (S1[2] * a[2] + S1[3] * a[3]);
        const float sa0 = oct_sum(p0[0] + p0[1]);
        const float sa1 = oct_sum(p1[0] + p1[1]);
        f32x2 y0a = {0.f, 0.f}, y0b = {0.f, 0.f}, y1a = {0.f, 0.f}, y1b = {0.f, 0.f};
#pragma unroll
        for (int i = 0; i < 4; ++i) {
          const f32x2 n0 = S0[i] * d[i] + (sa0 * bb[i] + c.V[0] * kk[i]);
          const f32x2 n1 = S1[i] * d[i] + (sa1 * bb[i] + c.V[1] * kk[i]);
          S0[i] = n0; S1[i] = n1;
          if (i & 1) { y0b += n0 * rr[i]; y1b += n1 * rr[i]; } else { y0a += n0 * rr[i]; y1a += n1 * rr[i]; }
        }
        const f32x2 y0 = y0a + y0b, y1 = y1a + y1b;
        float ys0 = y0[0] + y0[1], ys1 = y1[0] + y1[1];
        asm volatile("" : "+v"(ys0));
        asm volatile("" : "+v"(ys1));
        oct_sum_pair(ys0, ys1);
        *(f32x2*)(YO + voff) = (f32x2){ys0, ys1};
      };
      const int dstep = dir ? -64 : 64;
      int off = (dir ? 15 * 64 : 0) + kq * 8, voff = (dir ? 15 * 64 : 0) + v0;
      VA_ X, Y;
      loada(X, off, voff);
#pragma unroll 1
      for (int it2 = 0; it2 < 8; ++it2) {
        stepf(X, Y, off, voff, off + dstep, voff + dstep, true);
        stepf(Y, X, off + dstep, voff + dstep, off + 2 * dstep, voff + 2 * dstep, it2 < 7);
        off += 2 * dstep; voff += 2 * dstep;
      }
    }
  }
  __syncthreads();
  output(tc_prev);
  __syncthreads();
}

template <int MODE>
DI void item_attn(const Params& p, int l, int L, int b, int h, int qi, const bf16_t* __restrict__ z, bf16_t* __restrict__ yo, unsigned char* smem, unsigned char* smc) {
  const int tid = otid() & 255, lane = tid & 63, w = tid >> 6, fr = lane & 15, fq = lane >> 4;
  unsigned char* KV0 = (MODE == 1) ? smc : smem;
  constexpr int NLD = (MODE == 1) ? 1 : 2;
  const int t5 = (MODE == 1) ? (tid + (int)(smem - smc) / 256) : tid;
  const int vkey = (MODE == 1) ? (t5 & 63) : lane, vdc0 = (MODE == 1) ? (t5 >> 6) : 2 * w;
  float* RPB = (float*)(smem + 256 * RS);
  const size_t tok0 = (size_t)b * L;
  const int rows = L / 64;
  const int qcol = (MODE == 0 ? 1792 : 2560) + h * 64, kcol = qcol + 256, vcol = qcol + 512;
  const int ntile = (MODE == 0) ? 8 : rows;
  int rs = 0;
  if (MODE == 0) { rs = qi - 4; rs = rs < 0 ? 0 : (rs > rows - 8 ? rows - 8 : rs); }
  const int qc = w * 16 + fr;
  const size_t qtok = tok0 + (size_t)qi * 64 + qc;
  bf16x8 qf[2];
#pragma unroll
  for (int ks = 0; ks < 2; ++ks) qf[ks] = *(const bf16x8*)(z + qtok * ZC + qcol + ks * 32 + fq * 8);
  float lam = 0.f, lam_init = 0.f;
  if (MODE == 0) {
    __syncthreads();
    const float* rp = p.in[19] + ((size_t)l * 4 + h) * 465;
    for (int i = tid; i < 465; i += 256) RPB[i] = rp[i];
  } else {
    const float* lp = p.in[20] + (size_t)l * 128;
    float v1 = 0.f, v2 = 0.f;
    if (lane < 32) { v1 = lp[lane] * lp[32 + lane]; v2 = lp[64 + lane] * lp[96 + lane]; }
    v1 = wave_sum(v1); v2 = wave_sum(v2);
    lam_init = 0.8f - 0.6f * __expf(-0.3f * (float)l);
    lam = __expf(v1) - __expf(v2) + lam_init;
  }
  u32x4 rk[NLD], rv[NLD];
  auto load_tile = [&](int it) {
    const size_t kt0 = tok0 + (size_t)((MODE == 0) ? (rs + it) : it) * 64;
#pragma unroll
    for (int i = 0; i < NLD; ++i) {
      const int q = t5 + i * 256;
      rk[i] = *(const u32x4*)(z + (kt0 + (q >> 3)) * ZC + kcol + (q & 7) * 8);
      rv[i] = *(const u32x4*)(z + (kt0 + vkey) * ZC + vcol + (vdc0 + i) * 8);
    }
  };
  auto store_tile = [&](int buf) {
    unsigned char* KSw = KV0 + buf * (128 * RS);
    unsigned char* VTw = KSw + 64 * RS;
#pragma unroll
    for (int i = 0; i < NLD; ++i) {
      const int q = t5 + i * 256;
      *(u32x4*)(KSw + (q >> 3) * RS + (q & 7) * 16) = rk[i];
#pragma unroll
      for (int e = 0; e < 8; ++e) {
        const unsigned vwd = rv[i][e >> 1];
        const bf16_t val = (bf16_t)((e & 1) ? (vwd >> 16) : (vwd & 0xffffu));
        *(bf16_t*)(VTw + ((vdc0 + i) * 8 + e) * RS + vkey * 2) = val;
      }
    }
  };
  load_tile(0);
  store_tile(0);
  if (ntile > 1) load_tile(1);
  constexpr int NS = (MODE == 0) ? 1 : 2;
  f32x4 o[NS][4];
  float mrun[NS], lrun[NS];
#pragma unroll
  for (int s = 0; s < NS; ++s) { mrun[s] = -1e30f; lrun[s] = 0.f;
#pragma unroll
    for (int dt = 0; dt < 4; ++dt) o[s][dt] = (f32x4){0.f, 0.f, 0.f, 0.f}; }
  const float slope2 = (MODE == 1) ? exp2f(-2.0f * (float)(h + 1)) * LOG2E : 0.f;
  const float sc2 = (MODE == 0) ? 0.125f * LOG2E : 0.17677669529663687f * LOG2E;
  const int qpos = qi * 64 + qc;
  const float dbase = (float)(fq * 4 - qpos);
  int cs = qc - 8; cs = cs < 0 ? 0 : (cs > 48 ? 48 : cs);
  for (int it = 0; it < ntile; ++it) {
    __syncthreads();
    if (it + 1 < ntile) store_tile((it + 1) & 1);
    if (it + 2 < ntile) load_tile(it + 2);
    const unsigned char* KS = KV0 + (it & 1) * (128 * RS);
    const unsigned char* VT = KS + 64 * RS;
    f32x4 s[NS][4];
#pragma unroll
    for (int kt = 0; kt < 4; ++kt) {
      const bf16x8 k0 = *(const bf16x8*)(KS + (kt * 16 + fr) * RS + fq * 16);
      const bf16x8 k1 = *(const bf16x8*)(KS + (kt * 16 + fr) * RS + 64 + fq * 16);
      const f32x4 zf = {0.f, 0.f, 0.f, 0.f};
      if (MODE == 0) { s[0][kt] = MFMA16(k0, qf[0], zf); s[0][kt] = MFMA16(k1, qf[1], s[0][kt]); }
      else { s[0][kt] = MFMA16(k0, qf[0], zf); s[NS - 1][kt] = MFMA16(k1, qf[1], zf); }
    }
    float alpha[NS];
    float mx[NS];
#pragma unroll
    for (int sh = 0; sh < NS; ++sh) mx[sh] = -1e30f;
    if (MODE == 0) {
#pragma unroll
      for (int kt = 0; kt < 4; ++kt)
#pragma unroll
        for (int j = 0; j < 4; ++j) {
          const int kj = kt * 16 + fq * 4 + j;
          const bool valid = (kj >= cs) && (kj < cs + 16);
          int dc = kj - qc + 15; dc = dc < 0 ? 0 : (dc > 30 ? 30 : dc);
          const int dr = rs + it - qi + 7;
          const float t2 = valid ? (s[0][kt][j] * sc2 + RPB[dr * 31 + dc] * LOG2E) : -1e30f;
          s[0][kt][j] = t2;
          mx[0] = fmaxf(mx[0], t2);
        }
    } else {
      const float d0 = dbase + (float)(it * 64);
#pragma unroll
      for (int kt = 0; kt < 4; ++kt)
#pragma unroll
        for (int j = 0; j < 4; ++j) {
          const float ad = slope2 * fabsf(d0 + (float)(kt * 16 + j));
#pragma unroll
          for (int sh = 0; sh < NS; ++sh) {
            const float t2 = s[sh][kt][j] * sc2 - ad;
            s[sh][kt][j] = t2;
            mx[sh] = fmaxf(mx[sh], t2);
          }
        }
    }
#pragma unroll
    for (int sh = 0; sh < NS; ++sh) {
      float m1 = mx[sh];
      m1 = fq_max(m1);
      const float mn = fmaxf(mrun[sh], m1);
      alpha[sh] = __builtin_amdgcn_exp2f(mrun[sh] - mn);
      mrun[sh] = mn;
      float ps = 0.f;
#pragma unroll
      for (int kt = 0; kt < 4; ++kt)
#pragma unroll
        for (int j = 0; j < 4; ++j) { const float pe = __builtin_amdgcn_exp2f(s[sh][kt][j] - mn); s[sh][kt][j] = pe; ps += pe; }
      lrun[sh] = lrun[sh] * alpha[sh] + ps;
#pragma unroll
      for (int dt = 0; dt < 4; ++dt) o[sh][dt] = o[sh][dt] * alpha[sh];
    }
#pragma unroll
    for (int i2 = 0; i2 < 2; ++i2) {
      bf16x8 pfr[NS];
#pragma unroll
      for (int sh = 0; sh < NS; ++sh) {
        const unsigned u0 = pack2(s[sh][2 * i2][0], s[sh][2 * i2][1]), u1 = pack2(s[sh][2 * i2][2], s[sh][2 * i2][3]);
        const unsigned u2 = pack2(s[sh][2 * i2 + 1][0], s[sh][2 * i2 + 1][1]), u3 = pack2(s[sh][2 * i2 + 1][2], s[sh][2 * i2 + 1][3]);
        const u32x4 u = {u0, u1, u2, u3};
        pfr[sh] = __builtin_bit_cast(bf16x8, u);
      }
#pragma unroll
      for (int dt = 0; dt < 4; ++dt) {
        const u32x2 va = *(const u32x2*)(VT + (dt * 16 + fr) * RS + (32 * i2 + fq * 4) * 2);
        const u32x2 vb = *(const u32x2*)(VT + (dt * 16 + fr) * RS + (32 * i2 + 16 + fq * 4) * 2);
        const u32x4 vu = {va[0], va[1], vb[0], vb[1]};
        const bf16x8 vf = __builtin_bit_cast(bf16x8, vu);
#pragma unroll
        for (int sh = 0; sh < NS; ++sh) o[sh][dt] = MFMA16(vf, pfr[sh], o[sh][dt]);
      }
    }
  }
  float linv[NS];
#pragma unroll
  for (int sh = 0; sh < NS; ++sh) { float lt = lrun[sh]; lt = fq_sum(lt); linv[sh] = rcp_(lt); }
  if (MODE == 0) {
#pragma unroll
    for (int dt = 0; dt < 4; ++dt) {
      const f32x4 r = o[0][dt] * linv[0];
      *(uint2*)(yo + qtok * 256 + h * 64 + dt * 16 + fq * 4) = make_uint2(pack2(r[0], r[1]), pack2(r[2], r[3]));
    }
  } else {
    f32x4 r[4];
    float ss = 0.f;
#pragma unroll
    for (int dt = 0; dt < 4; ++dt) {
      r[dt] = o[0][dt] * linv[0] - lam * (o[NS - 1][dt] * linv[NS - 1]);
      ss += r[dt][0] * r[dt][0] + r[dt][1] * r[dt][1] + r[dt][2] * r[dt][2] + r[dt][3] * r[dt][3];
    }
    ss = fq_sum(ss);
    const float rn = rsqrtf(ss * (1.0f / 64.0f) + 1e-5f) * (1.0f - lam_init);
    const float* sg = p.in[21] + (size_t)l * 64;
#pragma unroll
    for (int dt = 0; dt < 4; ++dt) {
      const f32x4 g = *(const f32x4*)(sg + dt * 16 + fq * 4);
      const f32x4 q = r[dt] * rn * g;
      *(uint2*)(yo + qtok * 256 + h * 64 + dt * 16 + fq * 4) = make_uint2(pack2(q[0], q[1]), pack2(q[2], q[3]));
    }
  }
}

DI void phase_mixers(const Params& p, int l, int half, unsigned* counter, unsigned char* smem) {
  const int L = half ? 2048 : 4096, nseq = HT / L, rows = L / 64;
  const bf16_t* z = (const bf16_t*)(p.ws + WS_Z);
  bf16_t* yf = (bf16_t*)(p.ws + WS_YF);
  bf16_t* yb = (bf16_t*)(p.ws + WS_YB);
  bf16_t* yn = (bf16_t*)(p.ws + WS_YN);
  bf16_t* yd = (bf16_t*)(p.ws + WS_YD);
  bf16_t* sg = (bf16_t*)(p.ws + WS_SG);
  float* bon = (float*)(p.ws + WS_BON);
  const int n_scan = nseq * 16, n_diff = nseq * 4 * rows, n_na = nseq * rows * 4, n_sg = HT / 256;
  const int total = n_scan + n_diff + n_na + n_sg;
  const int hf = __builtin_amdgcn_readfirstlane(otid() >> 8);
  unsigned char* sm = smem + hf * 65536;
  __shared__ int s_item;
  for (;;) {
    __syncthreads();
    if (threadIdx.x == 0) s_item = (int)atomicAdd(counter, 1u);
    __syncthreads();
    int it = 2 * s_item + hf;
    if (it >= total) break;
    if (it < n_scan) {
      const int dir = it & 1, h = (it >> 1) & 7, b = it >> 4;
      item_scan(p, l, L, b, h, dir, z, dir ? yb : yf, bon + (size_t)dir * HT * 8, sm);
      continue;
    }
    it -= n_scan;
    if (it < n_diff) {
      const int qb = it % rows, h = (it / rows) & 3, b = it / (rows * 4);
      item_attn<1>(p, l, L, b, h, qb, z, yd, sm, smem);
      continue;
    }
    it -= n_diff;
    if (it < n_na) {
      const int r = it % rows, h = (it / rows) & 3, b = it / (rows * 4);
      item_attn<0>(p, l, L, b, h, r, z, yn, sm, smem);
      continue;
    }
    it -= n_na;
    item_sg(p, l, L, it, z, sg);
  }
}

#define XB_TMO      128
#define XB_XCNT(j)  (256  + 64 * (j))
#define XB_XSUB(j)  (1280 + 64 * (j))
#define XB_XGEN(j)  (2304 + 64 * (j))
#define XB_TOP      3328
#define XB_TOPGEN   3392
#define XB_SPIN_CAP (1u << 18)
#define LAS __attribute__((address_space(3)))
DI unsigned xb_ld(unsigned* p)              { return __hip_atomic_load(p, __ATOMIC_RELAXED, __HIP_MEMORY_SCOPE_AGENT); }
DI unsigned xb_add(unsigned* p, unsigned v) { return __hip_atomic_fetch_add(p, v, __ATOMIC_RELAXED, __HIP_MEMORY_SCOPE_AGENT); }
DI unsigned xb_xcc_id() { return (unsigned)__builtin_amdgcn_s_getreg((3 << 11) | 20) & 0xFu; }
#define XB_SPIN(cond, bar) do { unsigned _sp = 0; while (cond) { __builtin_amdgcn_s_sleep(1); \
    if ((++_sp & 255u) == 0u) { if (xb_ld(&(bar)[XB_TMO])) break; if (_sp > XB_SPIN_CAP) { atomicAdd(&(bar)[XB_TMO], 1u); break; } } } } while (0)
struct XcdBarrier { unsigned* bar; unsigned x; volatile LAS unsigned* st; };
DI XcdBarrier xcd_barrier_post(unsigned* bar, volatile LAS unsigned* st) {
  XcdBarrier b; b.bar = bar; b.x = xb_xcc_id(); b.st = st;
  if (threadIdx.x == 0) (void)xb_add(&bar[XB_XCNT(b.x)], 1u);
  return b;
}
DI void xcd_barrier_complete(unsigned* bar, unsigned x, unsigned& nloc, unsigned& nx) {
  const unsigned G = gridDim.x * gridDim.y * gridDim.z;
  unsigned sum, cnt, mine, sp = 0u;
  for (;;) {
    sum = 0u; cnt = 0u; mine = 0u;
#pragma unroll
    for (unsigned j = 0; j < 16; ++j) { const unsigned c = xb_ld(&bar[XB_XCNT(j)]); sum += c; cnt += (c > 0u) ? 1u : 0u; mine = (j == x) ? c : mine; }
    if (sum == G) break;
    __builtin_amdgcn_s_sleep(1);
    if ((++sp & 255u) == 0u) { if (xb_ld(&bar[XB_TMO])) break; if (sp > XB_SPIN_CAP) { atomicAdd(&bar[XB_TMO], 1u); break; } }
  }
  nloc = mine > 0u ? mine : 1u; nx = cnt > 0u ? cnt : 1u;
}
DI void xcd_barrier(const XcdBarrier& b) {
  asm volatile("s_waitcnt vmcnt(0)" ::: "memory");
  __syncthreads();
  if (threadIdx.x == 0) {
    unsigned* bar = b.bar;
    __builtin_amdgcn_s_waitcnt(0);
    unsigned nloc = b.st[0], nx = b.st[1];
    if (nloc == 0u) { xcd_barrier_complete(bar, b.x, nloc, nx); b.st[0] = nloc; b.st[1] = nx; }
    const unsigned old = xb_add(&bar[XB_XSUB(b.x)], 1u);
    const unsigned gen = old / nloc;
    if (old + 1u == (gen + 1u) * nloc) {
      __builtin_amdgcn_fence(__ATOMIC_RELEASE, "agent");
      asm volatile("s_waitcnt vmcnt(0)" ::: "memory");
      const unsigned og = xb_add(&bar[XB_TOP], 1u);
      const unsigned tg = og / nx;
      if (og + 1u == (tg + 1u) * nx) xb_add(&bar[XB_TOPGEN], 1u);
      else XB_SPIN(xb_ld(&bar[XB_TOPGEN]) == tg, bar);
      __builtin_amdgcn_fence(__ATOMIC_ACQUIRE, "agent");
      xb_add(&bar[XB_XGEN(b.x)], 1u);
      asm volatile("s_waitcnt vmcnt(0)" ::: "memory");
    } else {
      XB_SPIN(xb_ld(&bar[XB_XGEN(b.x)]) == gen, bar);
      __builtin_amdgcn_fence(__ATOMIC_ACQUIRE, "agent");
      asm volatile("s_waitcnt vmcnt(0)" ::: "memory");
    }
  }
  __syncthreads();
}

__global__ void __launch_bounds__(512, 2) fwd_megakernel(Params p) {
  cg::grid_group grid = cg::this_grid();
  __shared__ __attribute__((aligned(16))) unsigned char smem[131072];
  bf16_t* W = (bf16_t*)(p.ws + WS_W);
  bf16_t* xn = (bf16_t*)(p.ws + WS_XN);
  bf16_t* hid = (bf16_t*)(p.ws + WS_HID);
  bf16_t* z = (bf16_t*)(p.ws + WS_Z);
  bf16_t* mo = (bf16_t*)(p.ws + WS_M);
  unsigned* ctl = (unsigned*)(p.ws + WS_CTL);
  __shared__ uint4 xb_words;
  if (threadIdx.x == 0) xb_words = make_uint4(0u, 0u, 0u, 0u);
  __syncthreads();
  const XcdBarrier xb = xcd_barrier_post((unsigned*)(p.ws + WS_BAR), (volatile LAS unsigned*)&xb_words);

  phase_convert(p, smem);
  grid.sync();
  for (int half = 0; half < 2; ++half) {
    const float* xin = p.in[half];
    float* x = p.out + (size_t)half * HT * D;
    const int L = half ? 2048 : 4096;
    for (int l = 0; l < NLAYER; ++l) {
      const bf16_t* Wl = W + (size_t)l * W_LAYER;
      const float* xsrc = (l == 0) ? xin : x;
      phase_norm(xsrc, p.in[2] + (size_t)l * D, xn, nullptr);
      xcd_barrier(xb);
      phase_ffn_up(xn, Wl + W_GU, hid, smem);
      xcd_barrier(xb);
      phase_gemm_resid(hid, DFF, Wl + W_WD, xsrc, x, 0.5f, smem);
      xcd_barrier(xb);
      phase_norm(x, p.in[6] + (size_t)l * D, xn, nullptr);
      xcd_barrier(xb);
      phase_proj(xn, Wl + W_IN, z, smem);
      xcd_barrier(xb);
      phase_mixers(p, l, half, ctl + (half * NLAYER + l) * 16, smem);
      xcd_barrier(xb);
      phase_ya(p, l, L, (const bf16_t*)(p.ws + WS_SG), Wl + W_G2, z, (bf16_t*)(p.ws + WS_YF), (const bf16_t*)(p.ws + WS_YB), (const float*)(p.ws + WS_BON), smem);
      xcd_barrier(xb);
      phase_merge(xn, Wl, (const bf16_t*)(p.ws + WS_YF), (const bf16_t*)(p.ws + WS_YN), (const bf16_t*)(p.ws + WS_YD), mo, smem);
      xcd_barrier(xb);
      phase_gemm_resid(mo, D, Wl + W_OUT, x, x, 1.0f, smem);
      xcd_barrier(xb);
      phase_norm(x, p.in[26] + (size_t)l * D, xn, nullptr);
      xcd_barrier(xb);
      phase_ffn_up(xn, Wl + W_GU2, hid, smem);
      xcd_barrier(xb);
      phase_gemm_resid(hid, DFF, Wl + W_WD2, x, x, 0.5f, smem);
      xcd_barrier(xb);
    }
    phase_norm(x, p.in[30], nullptr, x);
    xcd_barrier(xb);
  }
}

extern "C" void kernel_launch(void* const* d_in, const int* in_sizes, int n_in, void* d_out, int out_size, void* d_ws, size_t ws_size, hipStream_t stream) {
  static int grid_blocks = 0;
  if (!grid_blocks) {
    int dev = 0, cus = 0, per_cu = 0;
    (void)hipGetDevice(&dev);
    (void)hipDeviceGetAttribute(&cus, hipDeviceAttributeMultiprocessorCount, dev);
    (void)hipOccupancyMaxActiveBlocksPerMultiprocessor(&per_cu, fwd_megakernel, 512, 0);
    if (per_cu < 1) per_cu = 1;
    if (per_cu > 1) per_cu = 1;
    grid_blocks = cus * per_cu;
    if (ws_size < WS_END) fprintf(stderr, "kernel_launch: workspace too small: need %zu have %zu\n", (size_t)WS_END, ws_size);
  }
  (void)hipMemsetAsync((char*)d_ws + WS_CTL, 0, WS_CTL_BYTES, stream);
  Params p{};
  for (int i = 0; i < 31; ++i) p.in[i] = (const float*)d_in[i];
  p.out = (float*)d_out;
  p.ws = (unsigned char*)d_ws;
  void* args[] = {&p};
  hipError_t e = hipLaunchCooperativeKernel((void*)fwd_megakernel, dim3(grid_blocks), dim3(512), args, 0, stream);
  if (e != hipSuccess) fprintf(stderr, "cooperative launch failed: %s (grid %d)\n", hipGetErrorString(e), grid_blocks);
}
```

```cpp
#include <hip/hip_runtime.h>
#include <hip/hip_cooperative_groups.h>
#include <cstdio>
#include <cstdint>
namespace cg = cooperative_groups;

typedef unsigned short bf16_t;
typedef short bf16x8 __attribute__((ext_vector_type(8)));
typedef short s16x4 __attribute__((ext_vector_type(4)));
typedef float f32x4 __attribute__((ext_vector_type(4)));
typedef float f32x2 __attribute__((ext_vector_type(2)));
typedef unsigned u32x4 __attribute__((ext_vector_type(4)));
typedef unsigned u32x2 __attribute__((ext_vector_type(2)));
#define DI __device__ __forceinline__
#define MFMA16(a, b, c) __builtin_amdgcn_mfma_f32_16x16x32_bf16((a), (b), (c), 0, 0, 0)

constexpr int D = 1024, DFF = 2816, HT = 65536  , NLAYER = 2;
constexpr int ZC = 3328;
constexpr int INC = 6400;
constexpr int CA = 512;
constexpr float LOG2E = 1.4426950408889634f;

constexpr size_t WS_CTL = 0;
constexpr size_t WS_BAR = 4096;
constexpr size_t WS_CTL_BYTES = 32768;
constexpr size_t WS_W = WS_CTL_BYTES;
constexpr size_t W_GU = 0;
constexpr size_t W_WD = W_GU + (size_t)2 * DFF * D;
constexpr size_t W_GU2 = W_WD + (size_t)D * DFF;
constexpr size_t W_WD2 = W_GU2 + (size_t)2 * DFF * D;
constexpr size_t W_IN = W_WD2 + (size_t)D * DFF;
constexpr size_t W_PA = W_IN + (size_t)INC * D;
constexpr size_t W_PB = W_PA + (size_t)D * 512;
constexpr size_t W_PC = W_PB + (size_t)D * 256;
constexpr size_t W_OUT = W_PC + (size_t)D * 256;
constexpr size_t W_G2 = W_OUT + (size_t)D * D;
constexpr size_t W_LAYER = W_G2 + (size_t)512 * 128;
constexpr size_t WS_XN = WS_W + 2 * W_LAYER * 2;
constexpr size_t WS_R = WS_XN + (size_t)HT * D * 2;
constexpr size_t WS_HID = WS_R;
constexpr size_t WS_Z = WS_R;
constexpr size_t WS_M = WS_R;
constexpr size_t WS_YF = WS_Z + (size_t)HT * ZC * 2;
constexpr size_t WS_YB = WS_YF + (size_t)HT * 512 * 2;
constexpr size_t WS_YN = WS_YB + (size_t)HT * 512 * 2;
constexpr size_t WS_YD = WS_YN + (size_t)HT * 256 * 2;
constexpr size_t WS_SG = WS_YD + (size_t)HT * 256 * 2;
constexpr size_t WS_BON = WS_SG + (size_t)HT * 128 * 2;
constexpr size_t WS_END = WS_BON + (size_t)2 * HT * 8 * 4;

struct Params {
  const float* in[31];
  float* out;
  unsigned char* ws;
};

typedef __bf16 bf16x2_t __attribute__((ext_vector_type(2)));
DI unsigned pack2(float lo, float hi) { const f32x2 v = {lo, hi}; const bf16x2_t b = __builtin_convertvector(v, bf16x2_t); return __builtin_bit_cast(unsigned, b); }
DI bf16_t f2bf(float x) { return (bf16_t)(pack2(x, x) & 0xffffu); }
DI float bf2f(bf16_t h) { return __uint_as_float(((unsigned)h) << 16); }
DI float lo2f(unsigned u) { return __uint_as_float(u << 16); }
DI float hi2f(unsigned u) { return __uint_as_float(u & 0xffff0000u); }
DI float xor16_sum(float v) { const auto r = __builtin_amdgcn_permlane16_swap(__float_as_uint(v), __float_as_uint(v), false, false); return __uint_as_float(r[0]) + __uint_as_float(r[1]); }
DI float xor32_sum(float v) { const auto r = __builtin_amdgcn_permlane32_swap(__float_as_uint(v), __float_as_uint(v), false, false); return __uint_as_float(r[0]) + __uint_as_float(r[1]); }
DI float xor16_max(float v) { const auto r = __builtin_amdgcn_permlane16_swap(__float_as_uint(v), __float_as_uint(v), false, false); return fmaxf(__uint_as_float(r[0]), __uint_as_float(r[1])); }
DI float xor32_max(float v) { const auto r = __builtin_amdgcn_permlane32_swap(__float_as_uint(v), __float_as_uint(v), false, false); return fmaxf(__uint_as_float(r[0]), __uint_as_float(r[1])); }
DI float fq_sum(float v) { return xor32_sum(xor16_sum(v)); }
DI float fq_max(float v) { return xor32_max(xor16_max(v)); }
DI float quad_sum(float v) {
  int t = __builtin_amdgcn_update_dpp(0, __float_as_int(v), 0xB1, 0xF, 0xF, true);
  v += __int_as_float(t);
  t = __builtin_amdgcn_update_dpp(0, __float_as_int(v), 0x4E, 0xF, 0xF, true);
  v += __int_as_float(t);
  return v;
}
DI float oct_sum(float v) {
  v = quad_sum(v);
  const int t = __builtin_amdgcn_update_dpp(0, __float_as_int(v), 0x141, 0xF, 0xF, true);
  return v + __int_as_float(t);
}
DI float row_sum16(float v) {
  v = oct_sum(v);
  const int t = __builtin_amdgcn_update_dpp(0, __float_as_int(v), 0x140, 0xF, 0xF, true);
  return v + __int_as_float(t);
}
DI float wave_sum(float v) { return fq_sum(row_sum16(v)); }
DI void oct_sum_pair(float& a, float& b) {
#define OSP_STAGE(ctrl) { const int ta = __builtin_amdgcn_update_dpp(0, __float_as_int(a), ctrl, 0xF, 0xF, true); const int tb = __builtin_amdgcn_update_dpp(0, __float_as_int(b), ctrl, 0xF, 0xF, true); \
    a += __int_as_float(ta); b += __int_as_float(tb); asm volatile("" : "+v"(a)); asm volatile("" : "+v"(b)); }
  OSP_STAGE(0xB1) OSP_STAGE(0x4E) OSP_STAGE(0x141)
#undef OSP_STAGE
}
DI int otid() { int t = threadIdx.x; asm volatile("" : "+v"(t)); return t; }
DI float rcp_(float x) { return __builtin_amdgcn_rcpf(x); }
DI float sigmoidf_(float x) { return rcp_(1.0f + __expf(-x)); }

DI void convert_job(const float* __restrict__ src, int K, int N, bf16_t* __restrict__ dst, int mode, float* tile  ) {
  const int tid = otid();
  const int ntk = K / 64, ntn = N / 64, nt = ntk * ntn;
  for (int t = blockIdx.x; t < nt; t += gridDim.x) {
    const int tk = t / ntn, tn = t % ntn;
    const int k0 = tk * 64, n0 = tn * 64;
    __syncthreads();
#pragma unroll
    for (int i = 0; i < 8; ++i) {
      const int kk = (tid >> 6) + i * 8, nn = tid & 63;
      tile[kk * 65 + nn] = src[(size_t)(k0 + kk) * N + n0 + nn];
    }
    __syncthreads();
    const int nn = tid >> 3, kc = (tid & 7) * 8;
    const int n = n0 + nn;
    int row = n;
    if (mode == 1) row = (n >> 5) * 64 + (n & 31);
    else if (mode == 2) row = (n >> 5) * 64 + 32 + (n & 31);
    u32x4 pk;
#pragma unroll
    for (int i = 0; i < 4; ++i) pk[i] = pack2(tile[(kc + 2 * i) * 65 + nn], tile[(kc + 2 * i + 1) * 65 + nn]);
    *(u32x4*)(dst + (size_t)row * K + k0 + kc) = pk;
  }
}

DI void phase_convert(const Params& p, unsigned char* smem) {
  float* tile = (float*)smem;
  bf16_t* W = (bf16_t*)(p.ws + WS_W);
  for (int l = 0; l < NLAYER; ++l) {
    bf16_t* Wl = W + (size_t)l * W_LAYER;
    convert_job(p.in[3] + (size_t)l * D * DFF, D, DFF, Wl + W_GU, 1, tile);
    convert_job(p.in[4] + (size_t)l * D * DFF, D, DFF, Wl + W_GU, 2, tile);
    convert_job(p.in[5] + (size_t)l * DFF * D, DFF, D, Wl + W_WD, 0, tile);
    convert_job(p.in[27] + (size_t)l * D * DFF, D, DFF, Wl + W_GU2, 1, tile);
    convert_job(p.in[28] + (size_t)l * D * DFF, D, DFF, Wl + W_GU2, 2, tile);
    convert_job(p.in[29] + (size_t)l * DFF * D, DFF, D, Wl + W_WD2, 0, tile);
    convert_job(p.in[7] + (size_t)l * D * INC, D, INC, Wl + W_IN, 0, tile);
    convert_job(p.in[22] + (size_t)l * 512 * D, 512, D, Wl + W_PA, 0, tile);
    convert_job(p.in[23] + (size_t)l * 256 * D, 256, D, Wl + W_PB, 0, tile);
    convert_job(p.in[24] + (size_t)l * 256 * D, 256, D, Wl + W_PC, 0, tile);
    convert_job(p.in[25] + (size_t)l * D * D, D, D, Wl + W_OUT, 0, tile);
    convert_job(p.in[16] + (size_t)l * 128 * 512, 128, 512, Wl + W_G2, 0, tile);
  }
}

DI void phase_norm(const float* __restrict__ src, const float* __restrict__ gam, bf16_t* __restrict__ xn, float* __restrict__ fout) {
  const int tid_ = otid(), lane = tid_ & 63, w = tid_ >> 6;
  f32x4 g[4];
#pragma unroll
  for (int i = 0; i < 4; ++i) g[i] = *(const f32x4*)(gam + i * 256 + lane * 4);
  const int stride = gridDim.x * 8;
  auto ld = [&](f32x4 (&v)[4], int row) {
    if (row < HT) {
#pragma unroll
      for (int i = 0; i < 4; ++i) v[i] = *(const f32x4*)(src + (size_t)row * D + i * 256 + lane * 4);
    }
  };
  auto proc = [&](const f32x4 (&v)[4], int row) {
    float ss = 0.f;
#pragma unroll
    for (int i = 0; i < 4; ++i) ss += (v[i][0] * v[i][0] + v[i][1] * v[i][1]) + (v[i][2] * v[i][2] + v[i][3] * v[i][3]);
    ss = wave_sum(ss);
    const float rs = rsqrtf(ss * (1.0f / 1024.0f) + 1e-6f);
#pragma unroll
    for (int i = 0; i < 4; ++i) {
      const f32x4 y = v[i] * rs * g[i];
      if (fout) *(f32x4*)(fout + (size_t)row * D + i * 256 + lane * 4) = y;
      else *(uint2*)(xn + (size_t)row * D + i * 256 + lane * 4) = make_uint2(pack2(y[0], y[1]), pack2(y[2], y[3]));
    }
  };
  int t = blockIdx.x * 8 + w;
  f32x4 a[4], b[4];
  ld(a, t); ld(b, t + stride);
  for (; t < HT; t += 2 * stride) {
    f32x4 na[4], nb[4];
    ld(na, t + 2 * stride); ld(nb, t + 3 * stride);
    proc(a, t);
    if (t + stride < HT) proc(b, t + stride);
#pragma unroll
    for (int i = 0; i < 4; ++i) { a[i] = na[i]; b[i] = nb[i]; }
  }
}

constexpr int RS = 144;
typedef __attribute__((address_space(3))) unsigned lds_u32;
DI void glds16(const void* g, unsigned char* l) { __builtin_amdgcn_global_load_lds((const unsigned*)g, (lds_u32*)l, 16, 0, 0); }
template <int N> DI void wait_vm() { asm volatile("s_waitcnt vmcnt(%0)" :: "n"(N) : "memory"); }
template <int MT, int NT, int WR, int WC>
DI void gemm_block(const bf16_t* __restrict__ A, int lda, const bf16_t* __restrict__ B, int ldb, int K, f32x4 (&acc)[MT][NT], unsigned char* smem,
                   bool primed = false, const bf16_t* __restrict__ nA = nullptr, int nlda = 0, const bf16_t* __restrict__ nB = nullptr, int nldb = 0) {
  static_assert(WR * WC == 8, "8 waves");
  constexpr int AR = 16 * MT * WR, BR = 16 * NT * WC;
  constexpr int AB = AR * 128, BB = BR * 128, STG = AB + BB;
  constexpr int NA = AR * 8 / 512, NB = BR * 8 / 512;
  const int tid = otid(), lane = tid & 63, w = tid >> 6, wr = w / WC, wc = w % WC, fr = lane & 15, fq = lane >> 4;
  const int srow = tid >> 3, kch = (tid & 7) ^ ((tid >> 4) & 7);
  const unsigned voA = (unsigned)(srow * lda + kch * 8) * 2u, voB = (unsigned)(srow * ldb + kch * 8) * 2u;
  const char* Ab = (const char*)A;
  const char* Bb = (const char*)B;
  const int nk = K >> 6;
  if (!primed) {
#pragma unroll
    for (int i = 0; i < NA; ++i) glds16(Ab + (size_t)i * 128 * lda + voA, smem + (i * 512 + tid) * 16);
#pragma unroll
    for (int i = 0; i < NB; ++i) glds16(Bb + (size_t)i * 128 * ldb + voB, smem + AB + (i * 512 + tid) * 16);
  }
  const int sw = (fr >> 1) & 7;
  const unsigned lds_base = (unsigned)(size_t)(__attribute__((address_space(3))) unsigned char*)smem;
  const unsigned a_row = (wr * 16 * MT + fr) * 128, b_row = AB + (wc * 16 * NT + fr) * 128;
  for (int kt = 0; kt < nk; ++kt) {
    wait_vm<0>();
    __builtin_amdgcn_s_barrier();
    if (kt + 1 < nk) {
      unsigned char* sn = smem + ((kt + 1) & 1) * STG;
      const int ko = (kt + 1) * 64;
#pragma unroll
      for (int i = 0; i < NA; ++i) glds16(Ab + ((size_t)i * 128 * lda + ko * 2) + voA, sn + (i * 512 + tid) * 16);
#pragma unroll
      for (int i = 0; i < NB; ++i) glds16(Bb + ((size_t)i * 128 * ldb + ko * 2) + voB, sn + AB + (i * 512 + tid) * 16);
    } else if (nA) {
      const unsigned nvoA = (unsigned)(srow * nlda + kch * 8) * 2u, nvoB = (unsigned)(srow * nldb + kch * 8) * 2u;
#pragma unroll
      for (int i = 0; i < NA; ++i) glds16((const char*)nA + (size_t)i * 128 * nlda + nvoA, smem + (i * 512 + tid) * 16);
#pragma unroll
      for (int i = 0; i < NB; ++i) glds16((const char*)nB + (size_t)i * 128 * nldb + nvoB, smem + AB + (i * 512 + tid) * 16);
    }
    const unsigned stb = lds_base + (kt & 1) * STG;
#pragma unroll
    for (int ks = 0; ks < 2; ++ks) {
      const unsigned co = ((ks * 4 + fq) ^ sw) * 16;
      const unsigned sa = stb + a_row + co, sb = stb + b_row + co;
      bf16x8 af[4], bfr[NT];
#pragma unroll
      for (int n = 0; n < NT; ++n) asm volatile("ds_read_b128 %0, %1 offset:%2" : "=v"(bfr[n]) : "v"(sb), "n"(n * 2048) : "memory");
#pragma unroll
      for (int mg = 0; mg < MT / 4; ++mg) {
#pragma unroll
        for (int m = 0; m < 4; ++m) asm volatile("ds_read_b128 %0, %1 offset:%2" : "=v"(af[m]) : "v"(sa), "n"((mg * 4 + m) * 2048) : "memory");
        if (mg == 0) {
#pragma unroll
          for (int n = 0; n < NT; ++n) asm volatile("s_waitcnt lgkmcnt(%1)" : "+v"(bfr[n]) : "n"(4 + NT - 1 - n) : "memory");
        }
#pragma unroll
        for (int m = 0; m < 4; ++m) {
          asm volatile("s_waitcnt lgkmcnt(%1)" : "+v"(af[m]) : "n"(3 - m) : "memory");
#pragma unroll
          for (int n = 0; n < NT; ++n) acc[mg * 4 + m][n] = MFMA16(bfr[n], af[m], acc[mg * 4 + m][n]);
        }
      }
    }
  }
  if (!nA) __syncthreads();
}

template <int MT, int NT>
DI void zero_acc(f32x4 (&acc)[MT][NT]) {
#pragma unroll
  for (int m = 0; m < MT; ++m)
#pragma unroll
    for (int n = 0; n < NT; ++n) acc[m][n] = (f32x4){0.f, 0.f, 0.f, 0.f};
}

DI void tile_coords(int id, int nN, int& pm, int& pn) {
  const int band = id / (16 * nN), r = id % (16 * nN);
  pm = band * 16 + (r & 15); pn = r >> 4;
}

DI void phase_ffn_up(const bf16_t* __restrict__ xn, const bf16_t* __restrict__ gu, bf16_t* __restrict__ hid, unsigned char* smem) {
  const int tid_ = otid(), lane = tid_ & 63, w = tid_ >> 6, wr = w >> 2, wc = w & 3, fr = lane & 15, fq = lane >> 4;
  constexpr int nN = 2 * DFF / 256, nM = HT / 256;
  for (int id = blockIdx.x; id < nM * nN; id += gridDim.x) {
    int pm, pn; tile_coords(id, nN, pm, pn);
    f32x4 acc[8][4]; zero_acc(acc);
    {
      const int idn = id + gridDim.x; int pm2 = 0, pn2 = 0; const bool hn = idn < nM * nN; if (hn) tile_coords(idn, nN, pm2, pn2);
      gemm_block<8, 4, 2, 4>(xn + (size_t)pm * 256 * D, D, gu + (size_t)pn * 256 * D, D, D, acc, smem, id != (int)blockIdx.x,
                             hn ? xn + (size_t)pm2 * 256 * D : nullptr, D, gu + (size_t)pn2 * 256 * D, D);
    }
    const int hc0 = (pn * 4 + wc) * 32 + fq * 4;
#pragma unroll
    for (int m = 0; m < 8; ++m) {
      const size_t row = (size_t)pm * 256 + wr * 128 + m * 16 + fr;
#pragma unroll
      for (int n = 0; n < 2; ++n) {
        float h[4];
#pragma unroll
        for (int j = 0; j < 4; ++j) { const float g = acc[m][n][j], u = acc[m][n + 2][j]; h[j] = g * rcp_(1.0f + __expf(-g)) * u; }
        *(uint2*)(hid + row * DFF + hc0 + n * 16) = make_uint2(pack2(h[0], h[1]), pack2(h[2], h[3]));
      }
    }
  }
}

DI void phase_gemm_resid(const bf16_t* __restrict__ A, int K, const bf16_t* __restrict__ Bt, const float* __restrict__ xin, float* __restrict__ xout, float alpha, unsigned char* smem) {
  const int tid_ = otid(), lane = tid_ & 63, w = tid_ >> 6, wr = w >> 2, wc = w & 3, fr = lane & 15, fq = lane >> 4;
  constexpr int nN = D / 256, nM = HT / 256;
  for (int id = blockIdx.x; id < nM * nN; id += gridDim.x) {
    int pm, pn; tile_coords(id, nN, pm, pn);
    f32x4 acc[8][4]; zero_acc(acc);
    {
      const int idn = id + gridDim.x; int pm2 = 0, pn2 = 0; const bool hn = idn < nM * nN; if (hn) tile_coords(idn, nN, pm2, pn2);
      gemm_block<8, 4, 2, 4>(A + (size_t)pm * 256 * K, K, Bt + (size_t)pn * 256 * K, K, K, acc, smem, id != (int)blockIdx.x,
                             hn ? A + (size_t)pm2 * 256 * K : nullptr, K, Bt + (size_t)pn2 * 256 * K, K);
    }
#pragma unroll
    for (int m = 0; m < 8; ++m) {
      const size_t row = (size_t)pm * 256 + wr * 128 + m * 16 + fr;
#pragma unroll
      for (int n = 0; n < 4; ++n) {
        const size_t o = row * D + pn * 256 + wc * 64 + n * 16 + fq * 4;
        const f32x4 x = *(const f32x4*)(xin + o);
        *(f32x4*)(xout + o) = x + alpha * acc[m][n];
      }
    }
  }
}

DI void phase_proj(const bf16_t* __restrict__ xn, const bf16_t* __restrict__ wint, bf16_t* __restrict__ z, unsigned char* smem) {
  const int tid_ = otid(), lane = tid_ & 63, w = tid_ >> 6, wr = w >> 2, wc = w & 3, fr = lane & 15, fq = lane >> 4;
  constexpr int nN = ZC / 256, nM = HT / 256;
  for (int id = blockIdx.x; id < nM * nN; id += gridDim.x) {
    int pm, pn; tile_coords(id, nN, pm, pn);
    f32x4 acc[8][4]; zero_acc(acc);
    {
      const int idn = id + gridDim.x; int pm2 = 0, pn2 = 0; const bool hn = idn < nM * nN; if (hn) tile_coords(idn, nN, pm2, pn2);
      gemm_block<8, 4, 2, 4>(xn + (size_t)pm * 256 * D, D, wint + (size_t)pn * 256 * D, D, D, acc, smem, id != (int)blockIdx.x,
                             hn ? xn + (size_t)pm2 * 256 * D : nullptr, D, wint + (size_t)pn2 * 256 * D, D);
    }
#pragma unroll
    for (int m = 0; m < 8; ++m) {
      const size_t row = (size_t)pm * 256 + wr * 128 + m * 16 + fr;
#pragma unroll
      for (int n = 0; n < 4; ++n) {
        const f32x4 a = acc[m][n];
        *(uint2*)(z + row * ZC + pn * 256 + wc * 64 + n * 16 + fq * 4) = make_uint2(pack2(a[0], a[1]), pack2(a[2], a[3]));
      }
    }
  }
}

DI void phase_ya(const Params& p, int l, int L, const bf16_t* __restrict__ sg, const bf16_t* __restrict__ g2t, const bf16_t* __restrict__ z,
                 bf16_t* __restrict__ yf, const bf16_t* __restrict__ yb, const float* __restrict__ bon, unsigned char* smem) {
  const int tid_ = otid(), lane = tid_ & 63, w = tid_ >> 6, wr = w >> 1, wc = w & 1, fr = lane & 15, fq = lane >> 4;
  constexpr int nN = 4, nM = HT / 256;
  const float* mu0 = p.in[8] + (size_t)l * 2 * 1792;
  const float* mu1 = mu0 + 1792;
  const float* lng = p.in[17] + (size_t)l * CA;
  const float* lnb = p.in[18] + (size_t)l * CA;
  for (int id = blockIdx.x; id < nM * nN; id += gridDim.x) {
    int pm, pn; tile_coords(id, nN, pm, pn);
    f32x4 acc[4][4]; zero_acc(acc);
    {
      const int idn = id + gridDim.x; int pm2 = 0, pn2 = 0; const bool hn = idn < nM * nN; if (hn) tile_coords(idn, nN, pm2, pn2);
      gemm_block<4, 4, 4, 2>(sg + (size_t)pm * 256 * 128, 128, g2t + (size_t)pn * 128 * 128, 128, 128, acc, smem, id != (int)blockIdx.x,
                             hn ? sg + (size_t)pm2 * 256 * 128 : nullptr, 128, g2t + (size_t)pn2 * 128 * 128, 128);
    }
    const int h = pn * 2 + wc;
    const int c0 = h * 64 + fq * 4;
    f32x4 M0[4], M1[4], GG[4], BB[4];
#pragma unroll
    for (int n = 0; n < 4; ++n) {
      M0[n] = *(const f32x4*)(mu0 + 1024 + c0 + n * 16); M1[n] = *(const f32x4*)(mu1 + 1024 + c0 + n * 16);
      GG[n] = *(const f32x4*)(lng + c0 + n * 16); BB[n] = *(const f32x4*)(lnb + c0 + n * 16);
    }
#pragma unroll
    for (int m = 0; m < 4; ++m) {
      const int row = pm * 256 + wr * 64 + m * 16 + fr;
      const int t = row % L;
      const bool hasp = t > 0, hasn = t < L - 1;
      const bf16_t* zr = z + (size_t)row * ZC + 1024 + c0;
      const bf16_t* zp = hasp ? zr - ZC : zr;
      const bf16_t* zn = hasn ? zr + ZC : zr;
      uint2 A[4], B[4], V0[4], VP[4], VN[4];
#pragma unroll
      for (int n = 0; n < 4; ++n) {
        A[n] = *(const uint2*)(yf + (size_t)row * CA + c0 + n * 16);
        B[n] = *(const uint2*)(yb + (size_t)row * CA + c0 + n * 16);
        V0[n] = *(const uint2*)(zr + n * 16);
        VP[n] = *(const uint2*)(zp + n * 16);
        VN[n] = *(const uint2*)(zn + n * 16);
      }
      const float bsum = bon[(size_t)row * 8 + h] + bon[(size_t)HT * 8 + (size_t)row * 8 + h];
      float y[4][4];
      float s = 0.f;
#pragma unroll
      for (int n = 0; n < 4; ++n) {
        y[n][0] = lo2f(A[n].x) + lo2f(B[n].x); y[n][1] = hi2f(A[n].x) + hi2f(B[n].x); y[n][2] = lo2f(A[n].y) + lo2f(B[n].y); y[n][3] = hi2f(A[n].y) + hi2f(B[n].y);
        s += (y[n][0] + y[n][1]) + (y[n][2] + y[n][3]);
      }
      s = fq_sum(s);
      const float mean = s * (1.0f / 64.0f);
      float q = 0.f;
#pragma unroll
      for (int n = 0; n < 4; ++n)
#pragma unroll
        for (int j = 0; j < 4; ++j) { const float d = y[n][j] - mean; q += d * d; }
      q = fq_sum(q);
      const float rstd = rsqrtf(q * (1.0f / 64.0f) + 64e-5f);
#pragma unroll
      for (int n = 0; n < 4; ++n) {
        const float vc[4] = {lo2f(V0[n].x), hi2f(V0[n].x), lo2f(V0[n].y), hi2f(V0[n].y)};
        const float vpp[4] = {hasp ? lo2f(VP[n].x) : 0.f, hasp ? hi2f(VP[n].x) : 0.f, hasp ? lo2f(VP[n].y) : 0.f, hasp ? hi2f(VP[n].y) : 0.f};
        const float vnn[4] = {hasn ? lo2f(VN[n].x) : 0.f, hasn ? hi2f(VN[n].x) : 0.f, hasn ? lo2f(VN[n].y) : 0.f, hasn ? hi2f(VN[n].y) : 0.f};
        float o[4];
#pragma unroll
        for (int j = 0; j < 4; ++j) {
          const float vs = vc[j] + M0[n][j] * (vpp[j] - vc[j]) + M1[n][j] * (vnn[j] - vc[j]);
          o[j] = ((y[n][j] - mean) * rstd * GG[n][j] + BB[n][j] + bsum * vs) * acc[m][n][j];
        }
        *(uint2*)(yf + (size_t)row * CA + c0 + n * 16) = make_uint2(pack2(o[0], o[1]), pack2(o[2], o[3]));
      }
    }
  }
}

DI void phase_merge(const bf16_t* __restrict__ xn, const bf16_t* __restrict__ Wl, const bf16_t* __restrict__ ya, const bf16_t* __restrict__ yn, const bf16_t* __restrict__ yd,
                    bf16_t* __restrict__ mo, unsigned char* smem) {
  const int tid_ = otid(), lane = tid_ & 63, w = tid_ >> 6, wr = w >> 1, wc = w & 1, fr = lane & 15, fq = lane >> 4;
  constexpr int nN = D / 128, nM = HT / 256;
  for (int id = blockIdx.x; id < nM * nN; id += gridDim.x) {
    int pm, pn; tile_coords(id, nN, pm, pn);
    unsigned tot[4][4][2];
#pragma unroll 1
    for (int i = 0; i < 3; ++i) {
      unsigned gp[4][4][2];
      {
        f32x4 ag[4][4]; zero_acc(ag);
        const bf16_t* Yn = (i == 0) ? ya : (i == 1 ? yn : yd);
        const int Kn = (i == 0) ? 512 : 256;
        const bf16_t* Pn = Wl + (i == 0 ? W_PA : (i == 1 ? W_PB : W_PC));
        gemm_block<4, 4, 4, 2>(xn + (size_t)pm * 256 * D, D, Wl + W_IN + (size_t)(ZC + i * 1024 + pn * 128) * D, D, D, ag, smem, !(i == 0 && id == (int)blockIdx.x),
                               Yn + (size_t)pm * 256 * Kn, Kn, Pn + (size_t)pn * 128 * Kn, Kn);
#pragma unroll
        for (int m = 0; m < 4; ++m)
#pragma unroll
          for (int n = 0; n < 4; ++n) {
            gp[m][n][0] = pack2(sigmoidf_(ag[m][n][0]), sigmoidf_(ag[m][n][1]));
            gp[m][n][1] = pack2(sigmoidf_(ag[m][n][2]), sigmoidf_(ag[m][n][3]));
          }
      }
      f32x4 ay[4][4]; zero_acc(ay);
      const bf16_t* Y = (i == 0) ? ya : (i == 1 ? yn : yd);
      const int Ki = (i == 0) ? 512 : 256;
      const bf16_t* P = Wl + (i == 0 ? W_PA : (i == 1 ? W_PB : W_PC));
      {
        const int idn = id + gridDim.x; int pm2 = pm, pn2 = pn, i2 = i + 1; bool hn = true;
        if (i == 2) { i2 = 0; hn = idn < nM * nN; if (hn) tile_coords(idn, nN, pm2, pn2); }
        gemm_block<4, 4, 4, 2>(Y + (size_t)pm * 256 * Ki, Ki, P + (size_t)pn * 128 * Ki, Ki, Ki, ay, smem, true,
                               hn ? xn + (size_t)pm2 * 256 * D : nullptr, D, Wl + W_IN + (size_t)(ZC + i2 * 1024 + pn2 * 128) * D, D);
      }
#pragma unroll
      for (int m = 0; m < 4; ++m)
#pragma unroll
        for (int n = 0; n < 4; ++n) {
          float t0 = ay[m][n][0] * lo2f(gp[m][n][0]), t1 = ay[m][n][1] * hi2f(gp[m][n][0]);
          float t2 = ay[m][n][2] * lo2f(gp[m][n][1]), t3 = ay[m][n][3] * hi2f(gp[m][n][1]);
          if (i > 0) { t0 += lo2f(tot[m][n][0]); t1 += hi2f(tot[m][n][0]); t2 += lo2f(tot[m][n][1]); t3 += hi2f(tot[m][n][1]); }
          tot[m][n][0] = pack2(t0, t1); tot[m][n][1] = pack2(t2, t3);
        }
    }
#pragma unroll
    for (int m = 0; m < 4; ++m) {
      const size_t row = (size_t)pm * 256 + wr * 64 + m * 16 + fr;
#pragma unroll
      for (int n = 0; n < 4; ++n)
        *(uint2*)(mo + row * D + pn * 128 + wc * 64 + n * 16 + fq * 4) = make_uint2(tot[m][n][0], tot[m][n][1]);
    }
  }
}

DI void item_sg(const Params& p, int l, int L, int item, const bf16_t* __restrict__ z, bf16_t* __restrict__ sg) {
  const int tid_ = otid() & 255, lane = tid_ & 63, w = tid_ >> 6;
  const float* mu0 = p.in[8] + (size_t)l * 2 * 1792 + 1664 + 2 * lane;
  const float* mu1 = mu0 + 1792;
  const float m0a = mu0[0], m0b = mu0[1], m1a = mu1[0], m1b = mu1[1];
  for (int i = w; i < 256; i += 4) {
    const int row = item * 256 + i;
    const int t = row % L;
    const bf16_t* zr = z + (size_t)row * ZC + 1664 + 2 * lane;
    const unsigned c = *(const unsigned*)zr;
    const unsigned pv = (t > 0) ? *(const unsigned*)(zr - ZC) : 0u;
    const unsigned nv = (t < L - 1) ? *(const unsigned*)(zr + ZC) : 0u;
    const float ca = lo2f(c), cb = hi2f(c);
    const float ga = ca + m0a * (lo2f(pv) - ca) + m1a * (lo2f(nv) - ca);
    const float gb = cb + m0b * (hi2f(pv) - cb) + m1b * (hi2f(nv) - cb);
    *(unsigned*)(sg + (size_t)row * 128 + 2 * lane) = pack2(sigmoidf_(ga), sigmoidf_(gb));
  }
}

DI void item_scan(const Params& p, int l, int L, int b, int h, int dir, const bf16_t* __restrict__ z, bf16_t* __restrict__ yout, float* __restrict__ bon, unsigned char* smem) {
  const int tid = otid() & 255, lane = tid & 63, w = tid >> 6, fr = lane & 15, fq = lane >> 4;
  unsigned* ZR = (unsigned*)smem;
  float* VR = (float*)(smem + 11520);
  float* VD = VR + 1024; float* VK = VD + 1024; float* VV = VK + 1024; float* VA = VV + 1024; float* VB = VA + 1024;
  float* YO = VB + 1024;
  float* BO = YO + 1024;
  unsigned char* WT = (unsigned char*)(BO + 16);
  unsigned char* AL = WT + 16 * RS;
  float* MU = (float*)(AL + 16 * RS);
  float* KKC = MU + 640;
  const size_t tok0 = (size_t)b * L;
  const float* mu0 = p.in[8] + (size_t)l * 2 * 1792;
  const float* mu1 = mu0 + 1792;
  const int cA = lane;
  __syncthreads();
  for (int i = tid; i < 640; i += 256) {
    const int s5 = i >> 7, d = (i >> 6) & 1, c = i & 63;
    const int col = (s5 < 3) ? (s5 * 512 + h * 64 + c) : (1536 + (s5 - 3) * 64 + c);
    MU[i] = (d ? mu1 : mu0)[col];
  }
  if (tid < 64) KKC[tid] = p.in[15][(size_t)l * CA + h * 64 + tid];
  const float rkc = p.in[14][((size_t)l * 2 + dir) * CA + h * 64 + cA];
  const int cB = w * 16 + fr;
  const float w0c = p.in[9][((size_t)l * 2 + dir) * CA + h * 64 + cB];
  const float a0c = p.in[11][((size_t)l * 2 + dir) * CA + h * 64 + cB];
  const float kac = p.in[13][((size_t)l * 2 + dir) * CA + h * 64 + cB];
  bf16x8 bw[2], ba[2];
  {
    const float* w2 = p.in[10] + ((size_t)l * 2 + dir) * 64 * CA + h * 64 + cB;
    const float* a2 = p.in[12] + ((size_t)l * 2 + dir) * 64 * CA + h * 64 + cB;
#pragma unroll
    for (int ks = 0; ks < 2; ++ks)
#pragma unroll
      for (int j = 0; j < 8; ++j) {
        bw[ks][j] = (short)f2bf(w2[(size_t)(ks * 32 + fq * 8 + j) * CA]);
        ba[ks][j] = (short)f2bf(a2[(size_t)(ks * 32 + fq * 8 + j) * CA]);
      }
  }
  const int kq = lane & 7, v0 = w * 16 + (lane >> 3) * 2;
  f32x2 S0[4], S1[4];
#pragma unroll
  for (int i = 0; i < 4; ++i) { S0[i] = (f32x2){0.f, 0.f}; S1[i] = (f32x2){0.f, 0.f}; }

  unsigned pf[12], poff[12];
  unsigned vbits = 0u, r0bits = 0u, r17bits = 0u, pf_ok = 0u;
#pragma unroll
  for (int i = 0; i < 12; ++i) {
    const int q = tid + i * 256;
    const int row = q / 160, pr = q - row * 160;
    const int col = (pr < 96) ? ((pr >> 5) * 512 + h * 64 + (pr & 31) * 2) : (1536 + (pr - 96) * 2);
    poff[i] = (q < 2880) ? (unsigned)(row * ZC + col) * 2u : 0u;
    if (q < 2880) vbits |= 1u << i;
    if (row == 0) r0bits |= 1u << i;
    if (row == 17) r17bits |= 1u << i;
  }
  auto prefetch = [&](int tc) {
    const char* zc = (const char*)(z + (tok0 + tc) * ZC) - (size_t)ZC * 2;
    pf_ok = vbits & ~((tc == 0) ? r0bits : 0u) & ~((tc == L - 16) ? r17bits : 0u);
#pragma unroll
    for (int i = 0; i < 12; ++i)
      pf[i] = *(const unsigned*)(zc + (((pf_ok >> i) & 1u) ? poff[i] : (unsigned)(ZC * 2)));
  };
  auto output = [&](int tco) {
    const int tt = tid >> 4, pj = tid & 15;
    const f32x2 ya = *(const f32x2*)(YO + tt * 64 + 2 * pj), yb2 = *(const f32x2*)(YO + tt * 64 + 32 + 2 * pj);
    bf16_t* yp = yout + (tok0 + tco + tt) * CA + h * 64 + 2 * pj;
    *(unsigned*)yp = pack2(ya[0], ya[1]);
    *(unsigned*)(yp + 32) = pack2(yb2[0], yb2[1]);
    if (tid < 16) bon[(tok0 + tco + tid) * 8 + h] = BO[tid];
  };
  const int nch = L / 16;
  prefetch(dir ? L - 16 : 0);
  int tc_prev = 0;
  for (int ci = 0; ci < nch; ++ci) {
    const int tc = dir ? (L - 16 - 16 * ci) : 16 * ci;
#pragma unroll
    for (int i = 0; i < 12; ++i) { const int q = tid + i * 256; if (q < 2880) ZR[q] = ((pf_ok >> i) & 1u) ? pf[i] : 0u; }
    __syncthreads();
    if (ci > 0) output(tc_prev);
    tc_prev = tc;
    if (ci + 1 < nch) prefetch(dir ? (tc - 16) : (tc + 16));
    {
      const int tt = tid >> 4, j = tid & 15, c = 4 * j;
      u32x2 zu[5][3];
      f32x4 mm[5][2];
#pragma unroll
      for (int s5 = 0; s5 < 5; ++s5) {
#pragma unroll
        for (int d3 = 0; d3 < 3; ++d3) zu[s5][d3] = *(const u32x2*)(ZR + (tt + d3) * 160 + s5 * 32 + 2 * j);
        mm[s5][0] = *(const f32x4*)(MU + (s5 * 2) * 64 + c);
        mm[s5][1] = *(const f32x4*)(MU + (s5 * 2 + 1) * 64 + c);
      }
      float zs[5][4];
#pragma unroll
      for (int s5 = 0; s5 < 5; ++s5)
#pragma unroll
        for (int e = 0; e < 4; ++e) {
          const unsigned up = zu[s5][0][e >> 1], uc = zu[s5][1][e >> 1], un = zu[s5][2][e >> 1];
          const float pv = (e & 1) ? hi2f(up) : lo2f(up), cv = (e & 1) ? hi2f(uc) : lo2f(uc), nv = (e & 1) ? hi2f(un) : lo2f(un);
          zs[s5][e] = cv + mm[s5][0][e] * (pv - cv) + mm[s5][1][e] * (nv - cv);
        }
      *(f32x4*)(VR + tt * 64 + c) = (f32x4){zs[0][0], zs[0][1], zs[0][2], zs[0][3]};
      *(f32x4*)(VK + tt * 64 + c) = (f32x4){zs[1][0], zs[1][1], zs[1][2], zs[1][3]};
      *(f32x4*)(VV + tt * 64 + c) = (f32x4){zs[2][0], zs[2][1], zs[2][2], zs[2][3]};
      const f32x4 kc = *(const f32x4*)(KKC + c);
      float kq4[4], th[4];
      float ksum = 0.f;
#pragma unroll
      for (int e = 0; e < 4; ++e) {
        kq4[e] = zs[1][e] * kc[e];
        ksum += kq4[e] * kq4[e];
        th[e] = 1.0f - 2.0f * rcp_(__expf(2.0f * zs[3][e]) + 1.0f);
      }
      *(u32x2*)(WT + tt * RS + c * 2) = (u32x2){pack2(th[0], th[1]), pack2(th[2], th[3])};
      *(u32x2*)(AL + tt * RS + c * 2) = (u32x2){pack2(zs[4][0], zs[4][1]), pack2(zs[4][2], zs[4][3])};
      ksum = row_sum16(ksum);
      const float inv = rcp_(fmaxf(sqrtf(ksum), 1e-12f));
      *(f32x4*)(VA + tt * 64 + c) = (f32x4){kq4[0] * inv, kq4[1] * inv, kq4[2] * inv, kq4[3] * inv};
    }
    __syncthreads();
    {
      f32x4 aw = {0.f, 0.f, 0.f, 0.f}, aa = {0.f, 0.f, 0.f, 0.f};
#pragma unroll
      for (int ks = 0; ks < 2; ++ks) {
        const bf16x8 fw = *(const bf16x8*)(WT + fr * RS + ks * 64 + fq * 16);
        const bf16x8 fa = *(const bf16x8*)(AL + fr * RS + ks * 64 + fq * 16);
        aw = MFMA16(fw, bw[ks], aw);
        aa = MFMA16(fa, ba[ks], aa);
      }
#pragma unroll
      for (int j = 0; j < 4; ++j) {
        const int tt = fq * 4 + j;
        const float x = w0c + aw[j];
        const float e = 0.60653065971263342f * sigmoidf_(x);
        const float dcy = __expf(-e);
        const float a = sigmoidf_(a0c + aa[j]);
        const float k = VK[tt * 64 + cB], kk = VA[tt * 64 + cB];
        VD[tt * 64 + cB] = dcy;
        VK[tt * 64 + cB] = k * (1.0f + (a - 1.0f) * kac);
        VA[tt * 64 + cB] = -kk;
        VB[tt * 64 + cB] = kk * a;
      }
    }
    __syncthreads();
    float pc[4];
#pragma unroll
    for (int i = 0; i < 4; ++i) { const int tt = w * 4 + i; pc[i] = VR[tt * 64 + cA] * VK[tt * 64 + cA] * rkc; }
#pragma unroll
    for (int i = 0; i < 4; ++i) {
      const int tt = w * 4 + i;
      const float s = wave_sum(pc[i]);
      if (lane == 0) BO[tt] = s;
    }
    {
      struct VA_ { f32x4 A0, A1; f32x2 V; };
      auto loada = [&](VA_& q, int off, int voff) {
        q.A0 = *(const f32x4*)(VA + off); q.A1 = *(const f32x4*)(VA + off + 4);
        q.V = *(const f32x2*)(VV + voff);
      };
      auto stepf = [&](const VA_& c, VA_& nx, int off, int voff, int offn, int voffn, bool has_next) {
        const f32x4 D0 = *(const f32x4*)(VD + off), D1 = *(const f32x4*)(VD + off + 4);
        const f32x4 B0 = *(const f32x4*)(VB + off), B1 = *(const f32x4*)(VB + off + 4);
        const f32x4 K0 = *(const f32x4*)(VK + off), K1 = *(const f32x4*)(VK + off + 4);
        const f32x4 R0 = *(const f32x4*)(VR + off), R1 = *(const f32x4*)(VR + off + 4);
        if (has_next) loada(nx, offn, voffn);
        const f32x2 a[4] = {{c.A0[0], c.A0[1]}, {c.A0[2], c.A0[3]}, {c.A1[0], c.A1[1]}, {c.A1[2], c.A1[3]}};
        const f32x2 d[4] = {{D0[0], D0[1]}, {D0[2], D0[3]}, {D1[0], D1[1]}, {D1[2], D1[3]}};
        const f32x2 bb[4] = {{B0[0], B0[1]}, {B0[2], B0[3]}, {B1[0], B1[1]}, {B1[2], B1[3]}};
        const f32x2 kk[4] = {{K0[0], K0[1]}, {K0[2], K0[3]}, {K1[0], K1[1]}, {K1[2], K1[3]}};
        const f32x2 rr[4] = {{R0[0], R0[1]}, {R0[2], R0[3]}, {R1[0], R1[1]}, {R1[2], R1[3]}};
        const f32x2 p0 = (S0[0] * a[0] + S0[1] * a[1]) + (S0[2] * a[2] + S0[3] * a[3]);
        const f32x2 p1 = (S1[0] * a[0] + S1[1] * a[1]) + (S1[2] * a[2] + S1[3] * a[3]);
        const float sa0 = oct_sum(p0[0] + p0[1]);
        const float sa1 = oct_sum(p1[0] + p1[1]);
        f32x2 y0a = {0.f, 0.f}, y0b = {0.f, 0.f}, y1a = {0.f, 0.f}, y1b = {0.f, 0.f};
#pragma unroll
        for (int i = 0; i < 4; ++i) {
          const f32x2 n0 = S0[i] * d[i] + (sa0 * bb[i] + c.V[0] * kk[i]);
          const f32x2 n1 = S1[i] * d[i] + (sa1 * bb[i] + c.V[1] * kk[i]);
          S0[i] = n0; S1[i] = n1;
          if (i & 1) { y0b += n0 * rr[i]; y1b += n1 * rr[i]; } else { y0a += n0 * rr[i]; y1a += n1 * rr[i]; }
        }
        const f32x2 y0 = y0a + y0b, y1 = y1a + y1b;
        float ys0 = y0[0] + y0[1], ys1 = y1[0] + y1[1];
        asm volatile("" : "+v"(ys0));
        asm volatile("" : "+v"(ys1));
        oct_sum_pair(ys0, ys1);
        *(f32x2*)(YO + voff) = (f32x2){ys0, ys1};
      };
      const int dstep = dir ? -64 : 64;
      int off = (dir ? 15 * 64 : 0) + kq * 8, voff = (dir ? 15 * 64 : 0) + v0;
      VA_ X, Y;
      loada(X, off, voff);
#pragma unroll 1
      for (int it2 = 0; it2 < 8; ++it2) {
        stepf(X, Y, off, voff, off + dstep, voff + dstep, true);
        stepf(Y, X, off + dstep, voff + dstep, off + 2 * dstep, voff + 2 * dstep, it2 < 7);
        off += 2 * dstep; voff += 2 * dstep;
      }
    }
  }
  __syncthreads();
  output(tc_prev);
  __syncthreads();
}

template <int MODE>
DI void item_attn(const Params& p, int l, int L, int b, int h, int qi, const bf16_t* __restrict__ z, bf16_t* __restrict__ yo, unsigned char* smem, unsigned char* smc) {
  const int tid = otid() & 255, lane = tid & 63, w = tid >> 6, fr = lane & 15, fq = lane >> 4;
  unsigned char* KV0 = (MODE == 1) ? smc : smem;
  constexpr int NLD = (MODE == 1) ? 1 : 2;
  const int t5 = (MODE == 1) ? (tid + (int)(smem - smc) / 256) : tid;
  const int vkey = (MODE == 1) ? (t5 & 63) : lane, vdc0 = (MODE == 1) ? (t5 >> 6) : 2 * w;
  float* RPB = (float*)(smem + 256 * RS);
  const size_t tok0 = (size_t)b * L;
  const int rows = L / 64;
  const int qcol = (MODE == 0 ? 1792 : 2560) + h * 64, kcol = qcol + 256, vcol = qcol + 512;
  const int ntile = (MODE == 0) ? 8 : rows;
  int rs = 0;
  if (MODE == 0) { rs = qi - 4; rs = rs < 0 ? 0 : (rs > rows - 8 ? rows - 8 : rs); }
  const int qc = w * 16 + fr;
  const size_t qtok = tok0 + (size_t)qi * 64 + qc;
  bf16x8 qf[2];
#pragma unroll
  for (int ks = 0; ks < 2; ++ks) qf[ks] = *(const bf16x8*)(z + qtok * ZC + qcol + ks * 32 + fq * 8);
  float lam = 0.f, lam_init = 0.f;
  if (MODE == 0) {
    __syncthreads();
    const float* rp = p.in[19] + ((size_t)l * 4 + h) * 465;
    for (int i = tid; i < 465; i += 256) RPB[i] = rp[i];
  } else {
    const float* lp = p.in[20] + (size_t)l * 128;
    float v1 = 0.f, v2 = 0.f;
    if (lane < 32) { v1 = lp[lane] * lp[32 + lane]; v2 = lp[64 + lane] * lp[96 + lane]; }
    v1 = wave_sum(v1); v2 = wave_sum(v2);
    lam_init = 0.8f - 0.6f * __expf(-0.3f * (float)l);
    lam = __expf(v1) - __expf(v2) + lam_init;
  }
  u32x4 rk[NLD], rv[NLD];
  auto load_tile = [&](int it) {
    const size_t kt0 = tok0 + (size_t)((MODE == 0) ? (rs + it) : it) * 64;
#pragma unroll
    for (int i = 0; i < NLD; ++i) {
      const int q = t5 + i * 256;
      rk[i] = *(const u32x4*)(z + (kt0 + (q >> 3)) * ZC + kcol + (q & 7) * 8);
      rv[i] = *(const u32x4*)(z + (kt0 + vkey) * ZC + vcol + (vdc0 + i) * 8);
    }
  };
  auto store_tile = [&](int buf) {
    unsigned char* KSw = KV0 + buf * (128 * RS);
    unsigned char* VTw = KSw + 64 * RS;
#pragma unroll
    for (int i = 0; i < NLD; ++i) {
      const int q = t5 + i * 256;
      *(u32x4*)(KSw + (q >> 3) * RS + (q & 7) * 16) = rk[i];
#pragma unroll
      for (int e = 0; e < 8; ++e) {
        const unsigned vwd = rv[i][e >> 1];
        const bf16_t val = (bf16_t)((e & 1) ? (vwd >> 16) : (vwd & 0xffffu));
        *(bf16_t*)(VTw + ((vdc0 + i) * 8 + e) * RS + vkey * 2) = val;
      }
    }
  };
  load_tile(0);
  store_tile(0);
  if (ntile > 1) load_tile(1);
  constexpr int NS = (MODE == 0) ? 1 : 2;
  f32x4 o[NS][4];
  float mrun[NS], lrun[NS];
#pragma unroll
  for (int s = 0; s < NS; ++s) { mrun[s] = -1e30f; lrun[s] = 0.f;
#pragma unroll
    for (int dt = 0; dt < 4; ++dt) o[s][dt] = (f32x4){0.f, 0.f, 0.f, 0.f}; }
  const float slope2 = (MODE == 1) ? exp2f(-2.0f * (float)(h + 1)) * LOG2E : 0.f;
  const float sc2 = (MODE == 0) ? 0.125f * LOG2E : 0.17677669529663687f * LOG2E;
  const int qpos = qi * 64 + qc;
  const float dbase = (float)(fq * 4 - qpos);
  int cs = qc - 8; cs = cs < 0 ? 0 : (cs > 48 ? 48 : cs);
  for (int it = 0; it < ntile; ++it) {
    __syncthreads();
    if (it + 1 < ntile) store_tile((it + 1) & 1);
    if (it + 2 < ntile) load_tile(it + 2);
    const unsigned char* KS = KV0 + (it & 1) * (128 * RS);
    const unsigned char* VT = KS + 64 * RS;
    f32x4 s[NS][4];
#pragma unroll
    for (int kt = 0; kt < 4; ++kt) {
      const bf16x8 k0 = *(const bf16x8*)(KS + (kt * 16 + fr) * RS + fq * 16);
      const bf16x8 k1 = *(const bf16x8*)(KS + (kt * 16 + fr) * RS + 64 + fq * 16);
      const f32x4 zf = {0.f, 0.f, 0.f, 0.f};
      if (MODE == 0) { s[0][kt] = MFMA16(k0, qf[0], zf); s[0][kt] = MFMA16(k1, qf[1], s[0][kt]); }
      else { s[0][kt] = MFMA16(k0, qf[0], zf); s[NS - 1][kt] = MFMA16(k1, qf[1], zf); }
    }
    float alpha[NS];
    float mx[NS];
#pragma unroll
    for (int sh = 0; sh < NS; ++sh) mx[sh] = -1e30f;
    if (MODE == 0) {
#pragma unroll
      for (int kt = 0; kt < 4; ++kt)
#pragma unroll
        for (int j = 0; j < 4; ++j) {
          const int kj = kt * 16 + fq * 4 + j;
          const bool valid = (kj >= cs) && (kj < cs + 16);
          int dc = kj - qc + 15; dc = dc < 0 ? 0 : (dc > 30 ? 30 : dc);
          const int dr = rs + it - qi + 7;
          const float t2 = valid ? (s[0][kt][j] * sc2 + RPB[dr * 31 + dc] * LOG2E) : -1e30f;
          s[0][kt][j] = t2;
          mx[0] = fmaxf(mx[0], t2);
        }
    } else {
      const float d0 = dbase + (float)(it * 64);
#pragma unroll
      for (int kt = 0; kt < 4; ++kt)
#pragma unroll
        for (int j = 0; j < 4; ++j) {
          const float ad = slope2 * fabsf(d0 + (float)(kt * 16 + j));
#pragma unroll
          for (int sh = 0; sh < NS; ++sh) {
            const float t2 = s[sh][kt][j] * sc2 - ad;
            s[sh][kt][j] = t2;
            mx[sh] = fmaxf(mx[sh], t2);
          }
        }
    }
#pragma unroll
    for (int sh = 0; sh < NS; ++sh) {
      float m1 = mx[sh];
      m1 = fq_max(m1);
      const float mn = fmaxf(mrun[sh], m1);
      alpha[sh] = __builtin_amdgcn_exp2f(mrun[sh] - mn);
      mrun[sh] = mn;
      float ps = 0.f;
#pragma unroll
      for (int kt = 0; kt < 4; ++kt)
#pragma unroll
        for (int j = 0; j < 4; ++j) { const float pe = __builtin_amdgcn_exp2f(s[sh][kt][j] - mn); s[sh][kt][j] = pe; ps += pe; }
      lrun[sh] = lrun[sh] * alpha[sh] + ps;
#pragma unroll
      for (int dt = 0; dt < 4; ++dt) o[sh][dt] = o[sh][dt] * alpha[sh];
    }
#pragma unroll
    for (int i2 = 0; i2 < 2; ++i2) {
      bf16x8 pfr[NS];
#pragma unroll
      for (int sh = 0; sh < NS; ++sh) {
        const unsigned u0 = pack2(s[sh][2 * i2][0], s[sh][2 * i2][1]), u1 = pack2(s[sh][2 * i2][2], s[sh][2 * i2][3]);
        const unsigned u2 = pack2(s[sh][2 * i2 + 1][0], s[sh][2 * i2 + 1][1]), u3 = pack2(s[sh][2 * i2 + 1][2], s[sh][2 * i2 + 1][3]);
        const u32x4 u = {u0, u1, u2, u3};
        pfr[sh] = __builtin_bit_cast(bf16x8, u);
      }
#pragma unroll
      for (int dt = 0; dt < 4; ++dt) {
        const u32x2 va = *(const u32x2*)(VT + (dt * 16 + fr) * RS + (32 * i2 + fq * 4) * 2);
        const u32x2 vb = *(const u32x2*)(VT + (dt * 16 + fr) * RS + (32 * i2 + 16 + fq * 4) * 2);
        const u32x4 vu = {va[0], va[1], vb[0], vb[1]};
        const bf16x8 vf = __builtin_bit_cast(bf16x8, vu);
#pragma unroll
        for (int sh = 0; sh < NS; ++sh) o[sh][dt] = MFMA16(vf, pfr[sh], o[sh][dt]);
      }
    }
  }
  float linv[NS];
#pragma unroll
  for (int sh = 0; sh < NS; ++sh) { float lt = lrun[sh]; lt = fq_sum(lt); linv[sh] = rcp_(lt); }
  if (MODE == 0) {
#pragma unroll
    for (int dt = 0; dt < 4; ++dt) {
      const f32x4 r = o[0][dt] * linv[0];
      *(uint2*)(yo + qtok * 256 + h * 64 + dt * 16 + fq * 4) = make_uint2(pack2(r[0], r[1]), pack2(r[2], r[3]));
    }
  } else {
    f32x4 r[4];
    float ss = 0.f;
#pragma unroll
    for (int dt = 0; dt < 4; ++dt) {
      r[dt] = o[0][dt] * linv[0] - lam * (o[NS - 1][dt] * linv[NS - 1]);
      ss += r[dt][0] * r[dt][0] + r[dt][1] * r[dt][1] + r[dt][2] * r[dt][2] + r[dt][3] * r[dt][3];
    }
    ss = fq_sum(ss);
    const float rn = rsqrtf(ss * (1.0f / 64.0f) + 1e-5f) * (1.0f - lam_init);
    const float* sg = p.in[21] + (size_t)l * 64;
#pragma unroll
    for (int dt = 0; dt < 4; ++dt) {
      const f32x4 g = *(const f32x4*)(sg + dt * 16 + fq * 4);
      const f32x4 q = r[dt] * rn * g;
      *(uint2*)(yo + qtok * 256 + h * 64 + dt * 16 + fq * 4) = make_uint2(pack2(q[0], q[1]), pack2(q[2], q[3]));
    }
  }
}

DI void phase_mixers(const Params& p, int l, int half, unsigned* counter, unsigned char* smem) {
  const int L = half ? 2048 : 4096, nseq = HT / L, rows = L / 64;
  const bf16_t* z = (const bf16_t*)(p.ws + WS_Z);
  bf16_t* yf = (bf16_t*)(p.ws + WS_YF);
  bf16_t* yb = (bf16_t*)(p.ws + WS_YB);
  bf16_t* yn = (bf16_t*)(p.ws + WS_YN);
  bf16_t* yd = (bf16_t*)(p.ws + WS_YD);
  bf16_t* sg = (bf16_t*)(p.ws + WS_SG);
  float* bon = (float*)(p.ws + WS_BON);
  const int n_scan = nseq * 16, n_diff = nseq * 4 * rows, n_na = nseq * rows * 4, n_sg = HT / 256;
  const int total = n_scan + n_diff + n_na + n_sg;
  const int hf = __builtin_amdgcn_readfirstlane(otid() >> 8);
  unsigned char* sm = smem + hf * 65536;
  __shared__ int s_item;
  for (;;) {
    __syncthreads();
    if (threadIdx.x == 0) s_item = (int)atomicAdd(counter, 1u);
    __syncthreads();
    int it = 2 * s_item + hf;
    if (it >= total) break;
    if (it < n_scan) {
      const int dir = it & 1, h = (it >> 1) & 7, b = it >> 4;
      item_scan(p, l, L, b, h, dir, z, dir ? yb : yf, bon + (size_t)dir * HT * 8, sm);
      continue;
    }
    it -= n_scan;
    if (it < n_diff) {
      const int qb = it % rows, h = (it / rows) & 3, b = it / (rows * 4);
      item_attn<1>(p, l, L, b, h, qb, z, yd, sm, smem);
      continue;
    }
    it -= n_diff;
    if (it < n_na) {
      const int r = it % rows, h = (it / rows) & 3, b = it / (rows * 4);
      item_attn<0>(p, l, L, b, h, r, z, yn, sm, smem);
      continue;
    }
    it -= n_na;
    item_sg(p, l, L, it, z, sg);
  }
}

#define XB_TMO      128
#define XB_XCNT(j)  (256  + 64 * (j))
#define XB_XSUB(j)  (1280 + 64 * (j))
#define XB_XGEN(j)  (2304 + 64 * (j))
#define XB_TOP      3328
#define XB_TOPGEN   3392
#define XB_SPIN_CAP (1u << 18)
#define LAS __attribute__((address_space(3)))
DI unsigned xb_ld(unsigned* p)              { return __hip_atomic_load(p, __ATOMIC_RELAXED, __HIP_MEMORY_SCOPE_AGENT); }
DI unsigned xb_add(unsigned* p, unsigned v) { return __hip_atomic_fetch_add(p, v, __ATOMIC_RELAXED, __HIP_MEMORY_SCOPE_AGENT); }
DI unsigned xb_xcc_id() { return (unsigned)__builtin_amdgcn_s_getreg((3 << 11) | 20) & 0xFu; }
#define XB_SPIN(cond, bar) do { unsigned _sp = 0; while (cond) { __builtin_amdgcn_s_sleep(1); \
    if ((++_sp & 255u) == 0u) { if (xb_ld(&(bar)[XB_TMO])) break; if (_sp > XB_SPIN_CAP) { atomicAdd(&(bar)[XB_TMO], 1u); break; } } } } while (0)
struct XcdBarrier { unsigned* bar; unsigned x; volatile LAS unsigned* st; };
DI XcdBarrier xcd_barrier_post(unsigned* bar, volatile LAS unsigned* st) {
  XcdBarrier b; b.bar = bar; b.x = xb_xcc_id(); b.st = st;
  if (threadIdx.x == 0) (void)xb_add(&bar[XB_XCNT(b.x)], 1u);
  return b;
}
DI void xcd_barrier_complete(unsigned* bar, unsigned x, unsigned& nloc, unsigned& nx) {
  const unsigned G = gridDim.x * gridDim.y * gridDim.z;
  unsigned sum, cnt, mine, sp = 0u;
  for (;;) {
    sum = 0u; cnt = 0u; mine = 0u;
#pragma unroll
    for (unsigned j = 0; j < 16; ++j) { const unsigned c = xb_ld(&bar[XB_XCNT(j)]); sum += c; cnt += (c > 0u) ? 1u : 0u; mine = (j == x) ? c : mine; }
    if (sum == G) break;
    __builtin_amdgcn_s_sleep(1);
    if ((++sp & 255u) == 0u) { if (xb_ld(&bar[XB_TMO])) break; if (sp > XB_SPIN_CAP) { atomicAdd(&bar[XB_TMO], 1u); break; } }
  }
  nloc = mine > 0u ? mine : 1u; nx = cnt > 0u ? cnt : 1u;
}
DI void xcd_barrier(const XcdBarrier& b) {
  asm volatile("s_waitcnt vmcnt(0)" ::: "memory");
  __syncthreads();
  if (threadIdx.x == 0) {
    unsigned* bar = b.bar;
    __builtin_amdgcn_s_waitcnt(0);
    unsigned nloc = b.st[0], nx = b.st[1];
    if (nloc == 0u) { xcd_barrier_complete(bar, b.x, nloc, nx); b.st[0] = nloc; b.st[1] = nx; }
    const unsigned old = xb_add(&bar[XB_XSUB(b.x)], 1u);
    const unsigned gen = old / nloc;
    if (old + 1u == (gen + 1u) * nloc) {
      __builtin_amdgcn_fence(__ATOMIC_RELEASE, "agent");
      asm volatile("s_waitcnt vmcnt(0)" ::: "memory");
      const unsigned og = xb_add(&bar[XB_TOP], 1u);
      const unsigned tg = og / nx;
      if (og + 1u == (tg + 1u) * nx) xb_add(&bar[XB_TOPGEN], 1u);
      else XB_SPIN(xb_ld(&bar[XB_TOPGEN]) == tg, bar);
      __builtin_amdgcn_fence(__ATOMIC_ACQUIRE, "agent");
      xb_add(&bar[XB_XGEN(b.x)], 1u);
      asm volatile("s_waitcnt vmcnt(0)" ::: "memory");
    } else {
      XB_SPIN(xb_ld(&bar[XB_XGEN(b.x)]) == gen, bar);
      __builtin_amdgcn_fence(__ATOMIC_ACQUIRE, "agent");
      asm volatile("s_waitcnt vmcnt(0)" ::: "memory");
    }
  }
  __syncthreads();
}

__global__ void __launch_bounds__(512, 2) fwd_megakernel(Params p) {
  cg::grid_group grid = cg::this_grid();
  __shared__ __attribute__((aligned(16))) unsigned char smem[131072];
  bf16_t* W = (bf16_t*)(p.ws + WS_W);
  bf16_t* xn = (bf16_t*)(p.ws + WS_XN);
  bf16_t* hid = (bf16_t*)(p.ws + WS_HID);
  bf16_t* z = (bf16_t*)(p.ws + WS_Z);
  bf16_t* mo = (bf16_t*)(p.ws + WS_M);
  unsigned* ctl = (unsigned*)(p.ws + WS_CTL);
  __shared__ uint4 xb_words;
  if (threadIdx.x == 0) xb_words = make_uint4(0u, 0u, 0u, 0u);
  __syncthreads();
  const XcdBarrier xb = xcd_barrier_post((unsigned*)(p.ws + WS_BAR), (volatile LAS unsigned*)&xb_words);

  phase_convert(p, smem);
  grid.sync();
  for (int half = 0; half < 2; ++half) {
    const float* xin = p.in[half];
    float* x = p.out + (size_t)half * HT * D;
    const int L = half ? 2048 : 4096;
    for (int l = 0; l < NLAYER; ++l) {
      const bf16_t* Wl = W + (size_t)l * W_LAYER;
      const float* xsrc = (l == 0) ? xin : x;
      phase_norm(xsrc, p.in[2] + (size_t)l * D, xn, nullptr);
      xcd_barrier(xb);
      phase_ffn_up(xn, Wl + W_GU, hid, smem);
      xcd_barrier(xb);
      phase_gemm_resid(hid, DFF, Wl + W_WD, xsrc, x, 0.5f, smem);
      xcd_barrier(xb);
      phase_norm(x, p.in[6] + (size_t)l * D, xn, nullptr);
      xcd_barrier(xb);
      phase_proj(xn, Wl + W_IN, z, smem);
      xcd_barrier(xb);
      phase_mixers(p, l, half, ctl + (half * NLAYER + l) * 16, smem);
      xcd_barrier(xb);
      phase_ya(p, l, L, (const bf16_t*)(p.ws + WS_SG), Wl + W_G2, z, (bf16_t*)(p.ws + WS_YF), (const bf16_t*)(p.ws + WS_YB), (const float*)(p.ws + WS_BON), smem);
      xcd_barrier(xb);
      phase_merge(xn, Wl, (const bf16_t*)(p.ws + WS_YF), (const bf16_t*)(p.ws + WS_YN), (const bf16_t*)(p.ws + WS_YD), mo, smem);
      xcd_barrier(xb);
      phase_gemm_resid(mo, D, Wl + W_OUT, x, x, 1.0f, smem);
      xcd_barrier(xb);
      phase_norm(x, p.in[26] + (size_t)l * D, xn, nullptr);
      xcd_barrier(xb);
      phase_ffn_up(xn, Wl + W_GU2, hid, smem);
      xcd_barrier(xb);
      phase_gemm_resid(hid, DFF, Wl + W_WD2, x, x, 0.5f, smem);
      xcd_barrier(xb);
    }
    phase_norm(x, p.in[30], nullptr, x);
    xcd_barrier(xb);
  }
}

extern "C" void kernel_launch(void* const* d_in, const int* in_sizes, int n_in, void* d_out, int out_size, void* d_ws, size_t ws_size, hipStream_t stream) {
  static int grid_blocks = 0;
  if (!grid_blocks) {
    int dev = 0, cus = 0, per_cu = 0;
    (void)hipGetDevice(&dev);
    (void)hipDeviceGetAttribute(&cus, hipDeviceAttributeMultiprocessorCount, dev);
    (void)hipOccupancyMaxActiveBlocksPerMultiprocessor(&per_cu, fwd_megakernel, 512, 0);
    if (per_cu < 1) per_cu = 1;
    if (per_cu > 1) per_cu = 1;
    grid_blocks = cus * per_cu;
    if (ws_size < WS_END) fprintf(stderr, "kernel_launch: workspace too small: need %zu have %zu\n", (size_t)WS_END, ws_size);
  }
  (void)hipMemsetAsync((char*)d_ws + WS_CTL, 0, WS_CTL_BYTES, stream);
  Params p{};
  for (int i = 0; i < 31; ++i) p.in[i] = (const float*)d_in[i];
  p.out = (float*)d_out;
  p.ws = (unsigned char*)d_ws;
  void* args[] = {&p};
  hipError_t e = hipLaunchCooperativeKernel((void*)fwd_megakernel, dim3(grid_blocks), dim3(512), args, 0, stream);
  if (e != hipSuccess) fprintf(stderr, "cooperative launch failed: %s (grid %d)\n", hipGetErrorString(e), grid_blocks);
}
```

```cpp
#include <hip/hip_runtime.h>
#include <hip/hip_cooperative_groups.h>
#include <cstdio>
#include <cstdint>
namespace cg = cooperative_groups;

typedef unsigned short bf16_t;
typedef short bf16x8 __attribute__((ext_vector_type(8)));
typedef short s16x4 __attribute__((ext_vector_type(4)));
typedef float f32x4 __attribute__((ext_vector_type(4)));
typedef float f32x2 __attribute__((ext_vector_type(2)));
typedef unsigned u32x4 __attribute__((ext_vector_type(4)));
typedef unsigned u32x2 __attribute__((ext_vector_type(2)));
#define DI __device__ __forceinline__
#define MFMA16(a, b, c) __builtin_amdgcn_mfma_f32_16x16x32_bf16((a), (b), (c), 0, 0, 0)

constexpr int D = 1024, DFF = 2816, HT = 65536  , NLAYER = 2;
constexpr int ZC = 3328;
constexpr int INC = 6400;
constexpr int CA = 512;
constexpr float LOG2E = 1.4426950408889634f;

constexpr size_t WS_CTL = 0;
constexpr size_t WS_BAR = 4096;
constexpr size_t WS_CTL_BYTES = 32768;
constexpr size_t WS_W = WS_CTL_BYTES;
constexpr size_t W_GU = 0;
constexpr size_t W_WD = W_GU + (size_t)2 * DFF * D;
constexpr size_t W_GU2 = W_WD + (size_t)D * DFF;
constexpr size_t W_WD2 = W_GU2 + (size_t)2 * DFF * D;
constexpr size_t W_IN = W_WD2 + (size_t)D * DFF;
constexpr size_t W_PA = W_IN + (size_t)INC * D;
constexpr size_t W_PB = W_PA + (size_t)D * 512;
constexpr size_t W_PC = W_PB + (size_t)D * 256;
constexpr size_t W_OUT = W_PC + (size_t)D * 256;
constexpr size_t W_G2 = W_OUT + (size_t)D * D;
constexpr size_t W_LAYER = W_G2 + (size_t)512 * 128;
constexpr size_t WS_XN = WS_W + 2 * W_LAYER * 2;
constexpr size_t WS_R = WS_XN + (size_t)HT * D * 2;
constexpr size_t WS_HID = WS_R;
constexpr size_t WS_Z = WS_R;
constexpr size_t WS_M = WS_R;
constexpr size_t WS_YF = WS_Z + (size_t)HT * ZC * 2;
constexpr size_t WS_YB = WS_YF + (size_t)HT * 512 * 2;
constexpr size_t WS_YN = WS_YB + (size_t)HT * 512 * 2;
constexpr size_t WS_YD = WS_YN + (size_t)HT * 256 * 2;
constexpr size_t WS_SG = WS_YD + (size_t)HT * 256 * 2;
constexpr size_t WS_BON = WS_SG + (size_t)HT * 128 * 2;
constexpr size_t WS_END = WS_BON + (size_t)2 * HT * 8 * 4;

struct Params {
  const float* in[31];
  float* out;
  unsigned char* ws;
};

typedef __bf16 bf16x2_t __attribute__((ext_vector_type(2)));
DI unsigned pack2(float lo, float hi) { const f32x2 v = {lo, hi}; const bf16x2_t b = __builtin_convertvector(v, bf16x2_t); return __builtin_bit_cast(unsigned, b); }
DI bf16_t f2bf(float x) { return (bf16_t)(pack2(x, x) & 0xffffu); }
DI float bf2f(bf16_t h) { return __uint_as_float(((unsigned)h) << 16); }
DI float lo2f(unsigned u) { return __uint_as_float(u << 16); }
DI float hi2f(unsigned u) { return __uint_as_float(u & 0xffff0000u); }
DI float xor16_sum(float v) { const auto r = __builtin_amdgcn_permlane16_swap(__float_as_uint(v), __float_as_uint(v), false, false); return __uint_as_float(r[0]) + __uint_as_float(r[1]); }
DI float xor32_sum(float v) { const auto r = __builtin_amdgcn_permlane32_swap(__float_as_uint(v), __float_as_uint(v), false, false); return __uint_as_float(r[0]) + __uint_as_float(r[1]); }
DI float xor16_max(float v) { const auto r = __builtin_amdgcn_permlane16_swap(__float_as_uint(v), __float_as_uint(v), false, false); return fmaxf(__uint_as_float(r[0]), __uint_as_float(r[1])); }
DI float xor32_max(float v) { const auto r = __builtin_amdgcn_permlane32_swap(__float_as_uint(v), __float_as_uint(v), false, false); return fmaxf(__uint_as_float(r[0]), __uint_as_float(r[1])); }
DI float fq_sum(float v) { return xor32_sum(xor16_sum(v)); }
DI float fq_max(float v) { return xor32_max(xor16_max(v)); }
DI float quad_sum(float v) {
  int t = __builtin_amdgcn_update_dpp(0, __float_as_int(v), 0xB1, 0xF, 0xF, true);
  v += __int_as_float(t);
  t = __builtin_amdgcn_update_dpp(0, __float_as_int(v), 0x4E, 0xF, 0xF, true);
  v += __int_as_float(t);
  return v;
}
DI float oct_sum(float v) {
  v = quad_sum(v);
  const int t = __builtin_amdgcn_update_dpp(0, __float_as_int(v), 0x141, 0xF, 0xF, true);
  return v + __int_as_float(t);
}
DI float row_sum16(float v) {
  v = oct_sum(v);
  const int t = __builtin_amdgcn_update_dpp(0, __float_as_int(v), 0x140, 0xF, 0xF, true);
  return v + __int_as_float(t);
}
DI float wave_sum(float v) { return fq_sum(row_sum16(v)); }
DI void oct_sum_pair(float& a, float& b) {
#define OSP_STAGE(ctrl) { const int ta = __builtin_amdgcn_update_dpp(0, __float_as_int(a), ctrl, 0xF, 0xF, true); const int tb = __builtin_amdgcn_update_dpp(0, __float_as_int(b), ctrl, 0xF, 0xF, true); \
    a += __int_as_float(ta); b += __int_as_float(tb); asm volatile("" : "+v"(a)); asm volatile("" : "+v"(b)); }
  OSP_STAGE(0xB1) OSP_STAGE(0x4E) OSP_STAGE(0x141)
#undef OSP_STAGE
}
DI int otid() { int t = threadIdx.x; asm volatile("" : "+v"(t)); return t; }
DI float rcp_(float x) { return __builtin_amdgcn_rcpf(x); }
DI float sigmoidf_(float x) { return rcp_(1.0f + __expf(-x)); }

DI void convert_job(const float* __restrict__ src, int K, int N, bf16_t* __restrict__ dst, int mode, float* tile  ) {
  const int tid = otid();
  const int ntk = K / 64, ntn = N / 64, nt = ntk * ntn;
  for (int t = blockIdx.x; t < nt; t += gridDim.x) {
    const int tk = t / ntn, tn = t % ntn;
    const int k0 = tk * 64, n0 = tn * 64;
    __syncthreads();
#pragma unroll
    for (int i = 0; i < 8; ++i) {
      const int kk = (tid >> 6) + i * 8, nn = tid & 63;
      tile[kk * 65 + nn] = src[(size_t)(k0 + kk) * N + n0 + nn];
    }
    __syncthreads();
    const int nn = tid >> 3, kc = (tid & 7) * 8;
    const int n = n0 + nn;
    int row = n;
    if (mode == 1) row = (n >> 5) * 64 + (n & 31);
    else if (mode == 2) row = (n >> 5) * 64 + 32 + (n & 31);
    u32x4 pk;
#pragma unroll
    for (int i = 0; i < 4; ++i) pk[i] = pack2(tile[(kc + 2 * i) * 65 + nn], tile[(kc + 2 * i + 1) * 65 + nn]);
    *(u32x4*)(dst + (size_t)row * K + k0 + kc) = pk;
  }
}

DI void phase_convert(const Params& p, unsigned char* smem) {
  float* tile = (float*)smem;
  bf16_t* W = (bf16_t*)(p.ws + WS_W);
  for (int l = 0; l < NLAYER; ++l) {
    bf16_t* Wl = W + (size_t)l * W_LAYER;
    convert_job(p.in[3] + (size_t)l * D * DFF, D, DFF, Wl + W_GU, 1, tile);
    convert_job(p.in[4] + (size_t)l * D * DFF, D, DFF, Wl + W_GU, 2, tile);
    convert_job(p.in[5] + (size_t)l * DFF * D, DFF, D, Wl + W_WD, 0, tile);
    convert_job(p.in[27] + (size_t)l * D * DFF, D, DFF, Wl + W_GU2, 1, tile);
    convert_job(p.in[28] + (size_t)l * D * DFF, D, DFF, Wl + W_GU2, 2, tile);
    convert_job(p.in[29] + (size_t)l * DFF * D, DFF, D, Wl + W_WD2, 0, tile);
    convert_job(p.in[7] + (size_t)l * D * INC, D, INC, Wl + W_IN, 0, tile);
    convert_job(p.in[22] + (size_t)l * 512 * D, 512, D, Wl + W_PA, 0, tile);
    convert_job(p.in[23] + (size_t)l * 256 * D, 256, D, Wl + W_PB, 0, tile);
    convert_job(p.in[24] + (size_t)l * 256 * D, 256, D, Wl + W_PC, 0, tile);
    convert_job(p.in[25] + (size_t)l * D * D, D, D, Wl + W_OUT, 0, tile);
    convert_job(p.in[16] + (size_t)l * 128 * 512, 128, 512, Wl + W_G2, 0, tile);
  }
}

DI void phase_norm(const float* __restrict__ src, const float* __restrict__ gam, bf16_t* __restrict__ xn, float* __restrict__ fout) {
  const int tid_ = otid(), lane = tid_ & 63, w = tid_ >> 6;
  f32x4 g[4];
#pragma unroll
  for (int i = 0; i < 4; ++i) g[i] = *(const f32x4*)(gam + i * 256 + lane * 4);
  const int stride = gridDim.x * 8;
  auto ld = [&](f32x4 (&v)[4], int row) {
    if (row < HT) {
#pragma unroll
      for (int i = 0; i < 4; ++i) v[i] = *(const f32x4*)(src + (size_t)row * D + i * 256 + lane * 4);
    }
  };
  auto proc = [&](const f32x4 (&v)[4], int row) {
    float ss = 0.f;
#pragma unroll
    for (int i = 0; i < 4; ++i) ss += (v[i][0] * v[i][0] + v[i][1] * v[i][1]) + (v[i][2] * v[i][2] + v[i][3] * v[i][3]);
    ss = wave_sum(ss);
    const float rs = rsqrtf(ss * (1.0f / 1024.0f) + 1e-6f);
#pragma unroll
    for (int i = 0; i < 4; ++i) {
      const f32x4 y = v[i] * rs * g[i];
      if (fout) *(f32x4*)(fout + (size_t)row * D + i * 256 + lane * 4) = y;
      else *(uint2*)(xn + (size_t)row * D + i * 256 + lane * 4) = make_uint2(pack2(y[0], y[1]), pack2(y[2], y[3]));
    }
  };
  int t = blockIdx.x * 8 + w;
  f32x4 a[4], b[4];
  ld(a, t); ld(b, t + stride);
  for (; t < HT; t += 2 * stride) {
    f32x4 na[4], nb[4];
    ld(na, t + 2 * stride); ld(nb, t + 3 * stride);
    proc(a, t);
    if (t + stride < HT) proc(b, t + stride);
#pragma unroll
    for (int i = 0; i < 4; ++i) { a[i] = na[i]; b[i] = nb[i]; }
  }
}

constexpr int RS = 144;
typedef __attribute__((address_space(3))) unsigned lds_u32;
DI void glds16(const void* g, unsigned char* l) { __builtin_amdgcn_global_load_lds((const unsigned*)g, (lds_u32*)l, 16, 0, 0); }
template <int N> DI void wait_vm() { asm volatile("s_waitcnt vmcnt(%0)" :: "n"(N) : "memory"); }
template <int MT, int NT, int WR, int WC>
DI void gemm_block(const bf16_t* __restrict__ A, int lda, const bf16_t* __restrict__ B, int ldb, int K, f32x4 (&acc)[MT][NT], unsigned char* smem,
                   bool primed = false, const bf16_t* __restrict__ nA = nullptr, int nlda = 0, const bf16_t* __restrict__ nB = nullptr, int nldb = 0) {
  static_assert(WR * WC == 8, "8 waves");
  constexpr int AR = 16 * MT * WR, BR = 16 * NT * WC;
  constexpr int AB = AR * 128, BB = BR * 128, STG = AB + BB;
  constexpr int NA = AR * 8 / 512, NB = BR * 8 / 512;
  const int tid = otid(), lane = tid & 63, w = tid >> 6, wr = w / WC, wc = w % WC, fr = lane & 15, fq = lane >> 4;
  const int srow = tid >> 3, kch = (tid & 7) ^ ((tid >> 4) & 7);
  const unsigned voA = (unsigned)(srow * lda + kch * 8) * 2u, voB = (unsigned)(srow * ldb + kch * 8) * 2u;
  const char* Ab = (const char*)A;
  const char* Bb = (const char*)B;
  const int nk = K >> 6;
  if (!primed) {
#pragma unroll
    for (int i = 0; i < NA; ++i) glds16(Ab + (size_t)i * 128 * lda + voA, smem + (i * 512 + tid) * 16);
#pragma unroll
    for (int i = 0; i < NB; ++i) glds16(Bb + (size_t)i * 128 * ldb + voB, smem + AB + (i * 512 + tid) * 16);
  }
  const int sw = (fr >> 1) & 7;
  const unsigned lds_base = (unsigned)(size_t)(__attribute__((address_space(3))) unsigned char*)smem;
  const unsigned a_row = (wr * 16 * MT + fr) * 128, b_row = AB + (wc * 16 * NT + fr) * 128;
  for (int kt = 0; kt < nk; ++kt) {
    wait_vm<0>();
    __builtin_amdgcn_s_barrier();
    if (kt + 1 < nk) {
      unsigned char* sn = smem + ((kt + 1) & 1) * STG;
      const int ko = (kt + 1) * 64;
#pragma unroll
      for (int i = 0; i < NA; ++i) glds16(Ab + ((size_t)i * 128 * lda + ko * 2) + voA, sn + (i * 512 + tid) * 16);
#pragma unroll
      for (int i = 0; i < NB; ++i) glds16(Bb + ((size_t)i * 128 * ldb + ko * 2) + voB, sn + AB + (i * 512 + tid) * 16);
    } else if (nA) {
      const unsigned nvoA = (unsigned)(srow * nlda + kch * 8) * 2u, nvoB = (unsigned)(srow * nldb + kch * 8) * 2u;
#pragma unroll
      for (int i = 0; i < NA; ++i) glds16((const char*)nA + (size_t)i * 128 * nlda + nvoA, smem + (i * 512 + tid) * 16);
#pragma unroll
      for (int i = 0; i < NB; ++i) glds16((const char*)nB + (size_t)i * 128 * nldb + nvoB, smem + AB + (i * 512 + tid) * 16);
    }
    const unsigned stb = lds_base + (kt & 1) * STG;
#pragma unroll
    for (int ks = 0; ks < 2; ++ks) {
      const unsigned co = ((ks * 4 + fq) ^ sw) * 16;
      const unsigned sa = stb + a_row + co, sb = stb + b_row + co;
      bf16x8 af[4], bfr[NT];
#pragma unroll
      for (int n = 0; n < NT; ++n) asm volatile("ds_read_b128 %0, %1 offset:%2" : "=v"(bfr[n]) : "v"(sb), "n"(n * 2048) : "memory");
#pragma unroll
      for (int mg = 0; mg < MT / 4; ++mg) {
#pragma unroll
        for (int m = 0; m < 4; ++m) asm volatile("ds_read_b128 %0, %1 offset:%2" : "=v"(af[m]) : "v"(sa), "n"((mg * 4 + m) * 2048) : "memory");
        if (mg == 0) {
#pragma unroll
          for (int n = 0; n < NT; ++n) asm volatile("s_waitcnt lgkmcnt(%1)" : "+v"(bfr[n]) : "n"(4 + NT - 1 - n) : "memory");
        }
#pragma unroll
        for (int m = 0; m < 4; ++m) {
          asm volatile("s_waitcnt lgkmcnt(%1)" : "+v"(af[m]) : "n"(3 - m) : "memory");
#pragma unroll
          for (int n = 0; n < NT; ++n) acc[mg * 4 + m][n] = MFMA16(bfr[n], af[m], acc[mg * 4 + m][n]);
        }
      }
    }
  }
  if (!nA) __syncthreads();
}

template <int MT, int NT>
DI void zero_acc(f32x4 (&acc)[MT][NT]) {
#pragma unroll
  for (int m = 0; m < MT; ++m)
#pragma unroll
    for (int n = 0; n < NT; ++n) acc[m][n] = (f32x4){0.f, 0.f, 0.f, 0.f};
}

DI void tile_coords(int id, int nN, int& pm, int& pn) {
  const int band = id / (16 * nN), r = id % (16 * nN);
  pm = band * 16 + (r & 15); pn = r >> 4;
}

DI void phase_ffn_up(const bf16_t* __restrict__ xn, const bf16_t* __restrict__ gu, bf16_t* __restrict__ hid, unsigned char* smem) {
  const int tid_ = otid(), lane = tid_ & 63, w = tid_ >> 6, wr = w >> 2, wc = w & 3, fr = lane & 15, fq = lane >> 4;
  constexpr int nN = 2 * DFF / 256, nM = HT / 256;
  for (int id = blockIdx.x; id < nM * nN; id += gridDim.x) {
    int pm, pn; tile_coords(id, nN, pm, pn);
    f32x4 acc[8][4]; zero_acc(acc);
    {
      const int idn = id + gridDim.x; int pm2 = 0, pn2 = 0; const bool hn = idn < nM * nN; if (hn) tile_coords(idn, nN, pm2, pn2);
      gemm_block<8, 4, 2, 4>(xn + (size_t)pm * 256 * D, D, gu + (size_t)pn * 256 * D, D, D, acc, smem, id != (int)blockIdx.x,
                             hn ? xn + (size_t)pm2 * 256 * D : nullptr, D, gu + (size_t)pn2 * 256 * D, D);
    }
    const int hc0 = (pn * 4 + wc) * 32 + fq * 4;
#pragma unroll
    for (int m = 0; m < 8; ++m) {
      const size_t row = (size_t)pm * 256 + wr * 128 + m * 16 + fr;
#pragma unroll
      for (int n = 0; n < 2; ++n) {
        float h[4];
#pragma unroll
        for (int j = 0; j < 4; ++j) { const float g = acc[m][n][j], u = acc[m][n + 2][j]; h[j] = g * rcp_(1.0f + __expf(-g)) * u; }
        *(uint2*)(hid + row * DFF + hc0 + n * 16) = make_uint2(pack2(h[0], h[1]), pack2(h[2], h[3]));
      }
    }
  }
}

DI void phase_gemm_resid(const bf16_t* __restrict__ A, int K, const bf16_t* __restrict__ Bt, const float* __restrict__ xin, float* __restrict__ xout, float alpha, unsigned char* smem) {
  const int tid_ = otid(), lane = tid_ & 63, w = tid_ >> 6, wr = w >> 2, wc = w & 3, fr = lane & 15, fq = lane >> 4;
  constexpr int nN = D / 256, nM = HT / 256;
  for (int id = blockIdx.x; id < nM * nN; id += gridDim.x) {
    int pm, pn; tile_coords(id, nN, pm, pn);
    f32x4 acc[8][4]; zero_acc(acc);
    {
      const int idn = id + gridDim.x; int pm2 = 0, pn2 = 0; const bool hn = idn < nM * nN; if (hn) tile_coords(idn, nN, pm2, pn2);
      gemm_block<8, 4, 2, 4>(A + (size_t)pm * 256 * K, K, Bt + (size_t)pn * 256 * K, K, K, acc, smem, id != (int)blockIdx.x,
                             hn ? A + (size_t)pm2 * 256 * K : nullptr, K, Bt + (size_t)pn2 * 256 * K, K);
    }
#pragma unroll
    for (int m = 0; m < 8; ++m) {
      const size_t row = (size_t)pm * 256 + wr * 128 + m * 16 + fr;
#pragma unroll
      for (int n = 0; n < 4; ++n) {
        const size_t o = row * D + pn * 256 + wc * 64 + n * 16 + fq * 4;
        const f32x4 x = *(const f32x4*)(xin + o);
        *(f32x4*)(xout + o) = x + alpha * acc[m][n];
      }
    }
  }
}

DI void phase_proj(const bf16_t* __restrict__ xn, const bf16_t* __restrict__ wint, bf16_t* __restrict__ z, unsigned char* smem) {
  const int tid_ = otid(), lane = tid_ & 63, w = tid_ >> 6, wr = w >> 2, wc = w & 3, fr = lane & 15, fq = lane >> 4;
  constexpr int nN = ZC / 256, nM = HT / 256;
  for (int id = blockIdx.x; id < nM * nN; id += gridDim.x) {
    int pm, pn; tile_coords(id, nN, pm, pn);
    f32x4 acc[8][4]; zero_acc(acc);
    {
      const int idn = id + gridDim.x; int pm2 = 0, pn2 = 0; const bool hn = idn < nM * nN; if (hn) tile_coords(idn, nN, pm2, pn2);
      gemm_block<8, 4, 2, 4>(xn + (size_t)pm * 256 * D, D, wint + (size_t)pn * 256 * D, D, D, acc, smem, id != (int)blockIdx.x,
                             hn ? xn + (size_t)pm2 * 256 * D : nullptr, D, wint + (size_t)pn2 * 256 * D, D);
    }
#pragma unroll
    for (int m = 0; m < 8; ++m) {
      const size_t row = (size_t)pm * 256 + wr * 128 + m * 16 + fr;
#pragma unroll
      for (int n = 0; n < 4; ++n) {
        const f32x4 a = acc[m][n];
        *(uint2*)(z + row * ZC + pn * 256 + wc * 64 + n * 16 + fq * 4) = make_uint2(pack2(a[0], a[1]), pack2(a[2], a[3]));
      }
    }
  }
}

DI void phase_ya(const Params& p, int l, int L, const bf16_t* __restrict__ sg, const bf16_t* __restrict__ g2t, const bf16_t* __restrict__ z,
                 bf16_t* __restrict__ yf, const bf16_t* __restrict__ yb, const float* __restrict__ bon, unsigned char* smem) {
  const int tid_ = otid(), lane = tid_ & 63, w = tid_ >> 6, wr = w >> 1, wc = w & 1, fr = lane & 15, fq = lane >> 4;
  constexpr int nN = 4, nM = HT / 256;
  const float* mu0 = p.in[8] + (size_t)l * 2 * 1792;
  const float* mu1 = mu0 + 1792;
  const float* lng = p.in[17] + (size_t)l * CA;
  const float* lnb = p.in[18] + (size_t)l * CA;
  for (int id = blockIdx.x; id < nM * nN; id += gridDim.x) {
    int pm, pn; tile_coords(id, nN, pm, pn);
    f32x4 acc[4][4]; zero_acc(acc);
    {
      const int idn = id + gridDim.x; int pm2 = 0, pn2 = 0; const bool hn = idn < nM * nN; if (hn) tile_coords(idn, nN, pm2, pn2);
      gemm_block<4, 4, 4, 2>(sg + (size_t)pm * 256 * 128, 128, g2t + (size_t)pn * 128 * 128, 128, 128, acc, smem, id != (int)blockIdx.x,
                             hn ? sg + (size_t)pm2 * 256 * 128 : nullptr, 128, g2t + (size_t)pn2 * 128 * 128, 128);
    }
    const int h = pn * 2 + wc;
    const int c0 = h * 64 + fq * 4;
    f32x4 M0[4], M1[4], GG[4], BB[4];
#pragma unroll
    for (int n = 0; n < 4; ++n) {
      M0[n] = *(const f32x4*)(mu0 + 1024 + c0 + n * 16); M1[n] = *(const f32x4*)(mu1 + 1024 + c0 + n * 16);
      GG[n] = *(const f32x4*)(lng + c0 + n * 16); BB[n] = *(const f32x4*)(lnb + c0 + n * 16);
    }
#pragma unroll
    for (int m = 0; m < 4; ++m) {
      const int row = pm * 256 + wr * 64 + m * 16 + fr;
      const int t = row % L;
      const bool hasp = t > 0, hasn = t < L - 1;
      const bf16_t* zr = z + (size_t)row * ZC + 1024 + c0;
      const bf16_t* zp = hasp ? zr - ZC : zr;
      const bf16_t* zn = hasn ? zr + ZC : zr;
      uint2 A[4], B[4], V0[4], VP[4], VN[4];
#pragma unroll
      for (int n = 0; n < 4; ++n) {
        A[n] = *(const uint2*)(yf + (size_t)row * CA + c0 + n * 16);
        B[n] = *(const uint2*)(yb + (size_t)row * CA + c0 + n * 16);
        V0[n] = *(const uint2*)(zr + n * 16);
        VP[n] = *(const uint2*)(zp + n * 16);
        VN[n] = *(const uint2*)(zn + n * 16);
      }
      const float bsum = bon[(size_t)row * 8 + h] + bon[(size_t)HT * 8 + (size_t)row * 8 + h];
      float y[4][4];
      float s = 0.f;
#pragma unroll
      for (int n = 0; n < 4; ++n) {
        y[n][0] = lo2f(A[n].x) + lo2f(B[n].x); y[n][1] = hi2f(A[n].x) + hi2f(B[n].x); y[n][2] = lo2f(A[n].y) + lo2f(B[n].y); y[n][3] = hi2f(A[n].y) + hi2f(B[n].y);
        s += (y[n][0] + y[n][1]) + (y[n][2] + y[n][3]);
      }
      s = fq_sum(s);
      const float mean = s * (1.0f / 64.0f);
      float q = 0.f;
#pragma unroll
      for (int n = 0; n < 4; ++n)
#pragma unroll
        for (int j = 0; j < 4; ++j) { const float d = y[n][j] - mean; q += d * d; }
      q = fq_sum(q);
      const float rstd = rsqrtf(q * (1.0f / 64.0f) + 64e-5f);
#pragma unroll
      for (int n = 0; n < 4; ++n) {
        const float vc[4] = {lo2f(V0[n].x), hi2f(V0[n].x), lo2f(V0[n].y), hi2f(V0[n].y)};
        const float vpp[4] = {hasp ? lo2f(VP[n].x) : 0.f, hasp ? hi2f(VP[n].x) : 0.f, hasp ? lo2f(VP[n].y) : 0.f, hasp ? hi2f(VP[n].y) : 0.f};
        const float vnn[4] = {hasn ? lo2f(VN[n].x) : 0.f, hasn ? hi2f(VN[n].x) : 0.f, hasn ? lo2f(VN[n].y) : 0.f, hasn ? hi2f(VN[n].y) : 0.f};
        float o[4];
#pragma unroll
        for (int j = 0; j < 4; ++j) {
          const float vs = vc[j] + M0[n][j] * (vpp[j] - vc[j]) + M1[n][j] * (vnn[j] - vc[j]);
          o[j] = ((y[n][j] - mean) * rstd * GG[n][j] + BB[n][j] + bsum * vs) * acc[m][n][j];
        }
        *(uint2*)(yf + (size_t)row * CA + c0 + n * 16) = make_uint2(pack2(o[0], o[1]), pack2(o[2], o[3]));
      }
    }
  }
}

DI void phase_merge(const bf16_t* __restrict__ xn, const bf16_t* __restrict__ Wl, const bf16_t* __restrict__ ya, const bf16_t* __restrict__ yn, const bf16_t* __restrict__ yd,
                    bf16_t* __restrict__ mo, unsigned char* smem) {
  const int tid_ = otid(), lane = tid_ & 63, w = tid_ >> 6, wr = w >> 1, wc = w & 1, fr = lane & 15, fq = lane >> 4;
  constexpr int nN = D / 128, nM = HT / 256;
  for (int id = blockIdx.x; id < nM * nN; id += gridDim.x) {
    int pm, pn; tile_coords(id, nN, pm, pn);
    unsigned tot[4][4][2];
#pragma unroll 1
    for (int i = 0; i < 3; ++i) {
      unsigned gp[4][4][2];
      {
        f32x4 ag[4][4]; zero_acc(ag);
        const bf16_t* Yn = (i == 0) ? ya : (i == 1 ? yn : yd);
        const int Kn = (i == 0) ? 512 : 256;
        const bf16_t* Pn = Wl + (i == 0 ? W_PA : (i == 1 ? W_PB : W_PC));
        gemm_block<4, 4, 4, 2>(xn + (size_t)pm * 256 * D, D, Wl + W_IN + (size_t)(ZC + i * 1024 + pn * 128) * D, D, D, ag, smem, !(i == 0 && id == (int)blockIdx.x),
                               Yn + (size_t)pm * 256 * Kn, Kn, Pn + (size_t)pn * 128 * Kn, Kn);
#pragma unroll
        for (int m = 0; m < 4; ++m)
#pragma unroll
          for (int n = 0; n < 4; ++n) {
            gp[m][n][0] = pack2(sigmoidf_(ag[m][n][0]), sigmoidf_(ag[m][n][1]));
            gp[m][n][1] = pack2(sigmoidf_(ag[m][n][2]), sigmoidf_(ag[m][n][3]));
          }
      }
      f32x4 ay[4][4]; zero_acc(ay);
      const bf16_t* Y = (i == 0) ? ya : (i == 1 ? yn : yd);
      const int Ki = (i == 0) ? 512 : 256;
      const bf16_t* P = Wl + (i == 0 ? W_PA : (i == 1 ? W_PB : W_PC));
      {
        const int idn = id + gridDim.x; int pm2 = pm, pn2 = pn, i2 = i + 1; bool hn = true;
        if (i == 2) { i2 = 0; hn = idn < nM * nN; if (hn) tile_coords(idn, nN, pm2, pn2); }
        gemm_block<4, 4, 4, 2>(Y + (size_t)pm * 256 * Ki, Ki, P + (size_t)pn * 128 * Ki, Ki, Ki, ay, smem, true,
                               hn ? xn + (size_t)pm2 * 256 * D : nullptr, D, Wl + W_IN + (size_t)(ZC + i2 * 1024 + pn2 * 128) * D, D);
      }
#pragma unroll
      for (int m = 0; m < 4; ++m)
#pragma unroll
        for (int n = 0; n < 4; ++n) {
          float t0 = ay[m][n][0] * lo2f(gp[m][n][0]), t1 = ay[m][n][1] * hi2f(gp[m][n][0]);
          float t2 = ay[m][n][2] * lo2f(gp[m][n][1]), t3 = ay[m][n][3] * hi2f(gp[m][n][1]);
          if (i > 0) { t0 += lo2f(tot[m][n][0]); t1 += hi2f(tot[m][n][0]); t2 += lo2f(tot[m][n][1]); t3 += hi2f(tot[m][n][1]); }
          tot[m][n][0] = pack2(t0, t1); tot[m][n][1] = pack2(t2, t3);
        }
    }
#pragma unroll
    for (int m = 0; m < 4; ++m) {
      const size_t row = (size_t)pm * 256 + wr * 64 + m * 16 + fr;
#pragma unroll
      for (int n = 0; n < 4; ++n)
        *(uint2*)(mo + row * D + pn * 128 + wc * 64 + n * 16 + fq * 4) = make_uint2(tot[m][n][0], tot[m][n][1]);
    }
  }
}

DI void item_sg(const Params& p, int l, int L, int item, const bf16_t* __restrict__ z, bf16_t* __restrict__ sg) {
  const int tid_ = otid() & 255, lane = tid_ & 63, w = tid_ >> 6;
  const float* mu0 = p.in[8] + (size_t)l * 2 * 1792 + 1664 + 2 * lane;
  const float* mu1 = mu0 + 1792;
  const float m0a = mu0[0], m0b = mu0[1], m1a = mu1[0], m1b = mu1[1];
  for (int i = w; i < 256; i += 4) {
    const int row = item * 256 + i;
    const int t = row % L;
    const bf16_t* zr = z + (size_t)row * ZC + 1664 + 2 * lane;
    const unsigned c = *(const unsigned*)zr;
    const unsigned pv = (t > 0) ? *(const unsigned*)(zr - ZC) : 0u;
    const unsigned nv = (t < L - 1) ? *(const unsigned*)(zr + ZC) : 0u;
    const float ca = lo2f(c), cb = hi2f(c);
    const float ga = ca + m0a * (lo2f(pv) - ca) + m1a * (lo2f(nv) - ca);
    const float gb = cb + m0b * (hi2f(pv) - cb) + m1b * (hi2f(nv) - cb);
    *(unsigned*)(sg + (size_t)row * 128 + 2 * lane) = pack2(sigmoidf_(ga), sigmoidf_(gb));
  }
}

DI void item_scan(const Params& p, int l, int L, int b, int h, int dir, const bf16_t* __restrict__ z, bf16_t* __restrict__ yout, float* __restrict__ bon, unsigned char* smem) {
  const int tid = otid() & 255, lane = tid & 63, w = tid >> 6, fr = lane & 15, fq = lane >> 4;
  unsigned* ZR = (unsigned*)smem;
  float* VR = (float*)(smem + 11520);
  float* VD = VR + 1024; float* VK = VD + 1024; float* VV = VK + 1024; float* VA = VV + 1024; float* VB = VA + 1024;
  float* YO = VB + 1024;
  float* BO = YO + 1024;
  unsigned char* WT = (unsigned char*)(BO + 16);
  unsigned char* AL = WT + 16 * RS;
  float* MU = (float*)(AL + 16 * RS);
  float* KKC = MU + 640;
  const size_t tok0 = (size_t)b * L;
  const float* mu0 = p.in[8] + (size_t)l * 2 * 1792;
  const float* mu1 = mu0 + 1792;
  const int cA = lane;
  __syncthreads();
  for (int i = tid; i < 640; i += 256) {
    const int s5 = i >> 7, d = (i >> 6) & 1, c = i & 63;
    const int col = (s5 < 3) ? (s5 * 512 + h * 64 + c) : (1536 + (s5 - 3) * 64 + c);
    MU[i] = (d ? mu1 : mu0)[col];
  }
  if (tid < 64) KKC[tid] = p.in[15][(size_t)l * CA + h * 64 + tid];
  const float rkc = p.in[14][((size_t)l * 2 + dir) * CA + h * 64 + cA];
  const int cB = w * 16 + fr;
  const float w0c = p.in[9][((size_t)l * 2 + dir) * CA + h * 64 + cB];
  const float a0c = p.in[11][((size_t)l * 2 + dir) * CA + h * 64 + cB];
  const float kac = p.in[13][((size_t)l * 2 + dir) * CA + h * 64 + cB];
  bf16x8 bw[2], ba[2];
  {
    const float* w2 = p.in[10] + ((size_t)l * 2 + dir) * 64 * CA + h * 64 + cB;
    const float* a2 = p.in[12] + ((size_t)l * 2 + dir) * 64 * CA + h * 64 + cB;
#pragma unroll
    for (int ks = 0; ks < 2; ++ks)
#pragma unroll
      for (int j = 0; j < 8; ++j) {
        bw[ks][j] = (short)f2bf(w2[(size_t)(ks * 32 + fq * 8 + j) * CA]);
        ba[ks][j] = (short)f2bf(a2[(size_t)(ks * 32 + fq * 8 + j) * CA]);
      }
  }
  const int kq = lane & 7, v0 = w * 16 + (lane >> 3) * 2;
  f32x2 S0[4], S1[4];
#pragma unroll
  for (int i = 0; i < 4; ++i) { S0[i] = (f32x2){0.f, 0.f}; S1[i] = (f32x2){0.f, 0.f}; }

  unsigned pf[12], poff[12];
  unsigned vbits = 0u, r0bits = 0u, r17bits = 0u, pf_ok = 0u;
#pragma unroll
  for (int i = 0; i < 12; ++i) {
    const int q = tid + i * 256;
    const int row = q / 160, pr = q - row * 160;
    const int col = (pr < 96) ? ((pr >> 5) * 512 + h * 64 + (pr & 31) * 2) : (1536 + (pr - 96) * 2);
    poff[i] = (q < 2880) ? (unsigned)(row * ZC + col) * 2u : 0u;
    if (q < 2880) vbits |= 1u << i;
    if (row == 0) r0bits |= 1u << i;
    if (row == 17) r17bits |= 1u << i;
  }
  auto prefetch = [&](int tc) {
    const char* zc = (const char*)(z + (tok0 + tc) * ZC) - (size_t)ZC * 2;
    pf_ok = vbits & ~((tc == 0) ? r0bits : 0u) & ~((tc == L - 16) ? r17bits : 0u);
#pragma unroll
    for (int i = 0; i < 12; ++i)
      pf[i] = *(const unsigned*)(zc + (((pf_ok >> i) & 1u) ? poff[i] : (unsigned)(ZC * 2)));
  };
  auto output = [&](int tco) {
    const int tt = tid >> 4, pj = tid & 15;
    const f32x2 ya = *(const f32x2*)(YO + tt * 64 + 2 * pj), yb2 = *(const f32x2*)(YO + tt * 64 + 32 + 2 * pj);
    bf16_t* yp = yout + (tok0 + tco + tt) * CA + h * 64 + 2 * pj;
    *(unsigned*)yp = pack2(ya[0], ya[1]);
    *(unsigned*)(yp + 32) = pack2(yb2[0], yb2[1]);
    if (tid < 16) bon[(tok0 + tco + tid) * 8 + h] = BO[tid];
  };
  const int nch = L / 16;
  prefetch(dir ? L - 16 : 0);
  int tc_prev = 0;
  for (int ci = 0; ci < nch; ++ci) {
    const int tc = dir ? (L - 16 - 16 * ci) : 16 * ci;
#pragma unroll
    for (int i = 0; i < 12; ++i) { const int q = tid + i * 256; if (q < 2880) ZR[q] = ((pf_ok >> i) & 1u) ? pf[i] : 0u; }
    __syncthreads();
    if (ci > 0) output(tc_prev);
    tc_prev = tc;
    if (ci + 1 < nch) prefetch(dir ? (tc - 16) : (tc + 16));
    {
      const int tt = tid >> 4, j = tid & 15, c = 4 * j;
      u32x2 zu[5][3];
      f32x4 mm[5][2];
#pragma unroll
      for (int s5 = 0; s5 < 5; ++s5) {
#pragma unroll
        for (int d3 = 0; d3 < 3; ++d3) zu[s5][d3] = *(const u32x2*)(ZR + (tt + d3) * 160 + s5 * 32 + 2 * j);
        mm[s5][0] = *(const f32x4*)(MU + (s5 * 2) * 64 + c);
        mm[s5][1] = *(const f32x4*)(MU + (s5 * 2 + 1) * 64 + c);
      }
      float zs[5][4];
#pragma unroll
      for (int s5 = 0; s5 < 5; ++s5)
#pragma unroll
        for (int e = 0; e < 4; ++e) {
          const unsigned up = zu[s5][0][e >> 1], uc = zu[s5][1][e >> 1], un = zu[s5][2][e >> 1];
          const float pv = (e & 1) ? hi2f(up) : lo2f(up), cv = (e & 1) ? hi2f(uc) : lo2f(uc), nv = (e & 1) ? hi2f(un) : lo2f(un);
          zs[s5][e] = cv + mm[s5][0][e] * (pv - cv) + mm[s5][1][e] * (nv - cv);
        }
      *(f32x4*)(VR + tt * 64 + c) = (f32x4){zs[0][0], zs[0][1], zs[0][2], zs[0][3]};
      *(f32x4*)(VK + tt * 64 + c) = (f32x4){zs[1][0], zs[1][1], zs[1][2], zs[1][3]};
      *(f32x4*)(VV + tt * 64 + c) = (f32x4){zs[2][0], zs[2][1], zs[2][2], zs[2][3]};
      const f32x4 kc = *(const f32x4*)(KKC + c);
      float kq4[4], th[4];
      float ksum = 0.f;
#pragma unroll
      for (int e = 0; e < 4; ++e) {
        kq4[e] = zs[1][e] * kc[e];
        ksum += kq4[e] * kq4[e];
        th[e] = 1.0f - 2.0f * rcp_(__expf(2.0f * zs[3][e]) + 1.0f);
      }
      *(u32x2*)(WT + tt * RS + c * 2) = (u32x2){pack2(th[0], th[1]), pack2(th[2], th[3])};
      *(u32x2*)(AL + tt * RS + c * 2) = (u32x2){pack2(zs[4][0], zs[4][1]), pack2(zs[4][2], zs[4][3])};
      ksum = row_sum16(ksum);
      const float inv = rcp_(fmaxf(sqrtf(ksum), 1e-12f));
      *(f32x4*)(VA + tt * 64 + c) = (f32x4){kq4[0] * inv, kq4[1] * inv, kq4[2] * inv, kq4[3] * inv};
    }
    __syncthreads();
    {
      f32x4 aw = {0.f, 0.f, 0.f, 0.f}, aa = {0.f, 0.f, 0.f, 0.f};
#pragma unroll
      for (int ks = 0; ks < 2; ++ks) {
        const bf16x8 fw = *(const bf16x8*)(WT + fr * RS + ks * 64 + fq * 16);
        const bf16x8 fa = *(const bf16x8*)(AL + fr * RS + ks * 64 + fq * 16);
        aw = MFMA16(fw, bw[ks], aw);
        aa = MFMA16(fa, ba[ks], aa);
      }
#pragma unroll
      for (int j = 0; j < 4; ++j) {
        const int tt = fq * 4 + j;
        const float x = w0c + aw[j];
        const float e = 0.60653065971263342f * sigmoidf_(x);
        const float dcy = __expf(-e);
        const float a = sigmoidf_(a0c + aa[j]);
        const float k = VK[tt * 64 + cB], kk = VA[tt * 64 + cB];
        VD[tt * 64 + cB] = dcy;
        VK[tt * 64 + cB] = k * (1.0f + (a - 1.0f) * kac);
        VA[tt * 64 + cB] = -kk;
        VB[tt * 64 + cB] = kk * a;
      }
    }
    __syncthreads();
    float pc[4];
#pragma unroll
    for (int i = 0; i < 4; ++i) { const int tt = w * 4 + i; pc[i] = VR[tt * 64 + cA] * VK[tt * 64 + cA] * rkc; }
#pragma unroll
    for (int i = 0; i < 4; ++i) {
      const int tt = w * 4 + i;
      const float s = wave_sum(pc[i]);
      if (lane == 0) BO[tt] = s;
    }
    {
      struct VA_ { f32x4 A0, A1; f32x2 V; };
      auto loada = [&](VA_& q, int off, int voff) {
        q.A0 = *(const f32x4*)(VA + off); q.A1 = *(const f32x4*)(VA + off + 4);
        q.V = *(const f32x2*)(VV + voff);
      };
      auto stepf = [&](const VA_& c, VA_& nx, int off, int voff, int offn, int voffn, bool has_next) {
        const f32x4 D0 = *(const f32x4*)(VD + off), D1 = *(const f32x4*)(VD + off + 4);
        const f32x4 B0 = *(const f32x4*)(VB + off), B1 = *(const f32x4*)(VB + off + 4);
        const f32x4 K0 = *(const f32x4*)(VK + off), K1 = *(const f32x4*)(VK + off + 4);
        const f32x4 R0 = *(const f32x4*)(VR + off), R1 = *(const f32x4*)(VR + off + 4);
        if (has_next) loada(nx, offn, voffn);
        const f32x2 a[4] = {{c.A0[0], c.A0[1]}, {c.A0[2], c.A0[3]}, {c.A1[0], c.A1[1]}, {c.A1[2], c.A1[3]}};
        const f32x2 d[4] = {{D0[0], D0[1]}, {D0[2], D0[3]}, {D1[0], D1[1]}, {D1[2], D1[3]}};
        const f32x2 bb[4] = {{B0[0], B0[1]}, {B0[2], B0[3]}, {B1[0], B1[1]}, {B1[2], B1[3]}};
        const f32x2 kk[4] = {{K0[0], K0[1]}, {K0[2], K0[3]}, {K1[0], K1[1]}, {K1[2], K1[3]}};
        const f32x2 rr[4] = {{R0[0], R0[1]}, {R0[2], R0[3]}, {R1[0], R1[1]}, {R1[2], R1[3]}};
        const f32x2 p0 = (S0[0] * a[0] + S0[1] * a[1]) + (S0[2] * a[2] + S0[3] * a[3]);
        const f32x2 p1 = (S1[0] * a[0] + S1[1] * a[1]) + (S1[2] * a[2] + S1[3] * a[3]);
        const float sa0 = oct_sum(p0[0] + p0[1]);
        const float sa1 = oct_sum(p1[0] + p1[1]);
        f32x2 y0a = {0.f, 0.f}, y0b = {0.f, 0.f}, y1a = {0.f, 0.f}, y1b = {0.f, 0.f};
#pragma unroll
        for (int i = 0; i < 4; ++i) {
          const f32x2 n0 = S0[i] * d[i] + (sa0 * bb[i] + c.V[0] * kk[i]);
          const f32x2 n1 = S1[i] * d[i] + (sa1 * bb[i] + c.V[1] * kk[i]);
          S0[i] = n0; S1[i] = n1;
          if (i & 1) { y0b += n0 * rr[i]; y1b += n1 * rr[i]; } else { y0a += n0 * rr[i]; y1a += n1 * rr[i]; }
        }
        const f32x2 y0 = y0a + y0b, y1 = y1a + y1b;
        float ys0 = y0[0] + y0[1], ys1 = y1[0] + y1[1];
        asm volatile("" : "+v"(ys0));
        asm volatile("" : "+v"(ys1));
        oct_sum_pair(ys0, ys1);
        *(f32x2*)(YO + voff) = (f32x2){ys0, ys1};
      };
      const int dstep = dir ? -64 : 64;
      int off = (dir ? 15 * 64 : 0) + kq * 8, voff = (dir ? 15 * 64 : 0) + v0;
      VA_ X, Y;
      loada(X, off, voff);
#pragma unroll 1
      for (int it2 = 0; it2 < 8; ++it2) {
        stepf(X, Y, off, voff, off + dstep, voff + dstep, true);
        stepf(Y, X, off + dstep, voff + dstep, off + 2 * dstep, voff + 2 * dstep, it2 < 7);
        off += 2 * dstep; voff += 2 * dstep;
      }
    }
  }
  __syncthreads();
  output(tc_prev);
  __syncthreads();
}

template <int MODE>
DI void item_attn(const Params& p, int l, int L, int b, int h, int qi, const bf16_t* __restrict__ z, bf16_t* __restrict__ yo, unsigned char* smem, unsigned char* smc) {
  const int tid = otid() & 255, lane = tid & 63, w = tid >> 6, fr = lane & 15, fq = lane >> 4;
  unsigned char* KV0 = (MODE == 1) ? smc : smem;
  constexpr int NLD = (MODE == 1) ? 1 : 2;
  const int t5 = (MODE == 1) ? (tid + (int)(smem - smc) / 256) : tid;
  const int vkey = (MODE == 1) ? (t5 & 63) : lane, vdc0 = (MODE == 1) ? (t5 >> 6) : 2 * w;
  float* RPB = (float*)(smem + 256 * RS);
  const size_t tok0 = (size_t)b * L;
  const int rows = L / 64;
  const int qcol = (MODE == 0 ? 1792 : 2560) + h * 64, kcol = qcol + 256, vcol = qcol + 512;
  const int ntile = (MODE == 0) ? 8 : rows;
  int rs = 0;
  if (MODE == 0) { rs = qi - 4; rs = rs < 0 ? 0 : (rs > rows - 8 ? rows - 8 : rs); }
  const int qc = w * 16 + fr;
  const size_t qtok = tok0 + (size_t)qi * 64 + qc;
  bf16x8 qf[2];
#pragma unroll
  for (int ks = 0; ks < 2; ++ks) qf[ks] = *(const bf16x8*)(z + qtok * ZC + qcol + ks * 32 + fq * 8);
  float lam = 0.f, lam_init = 0.f;
  if (MODE == 0) {
    __syncthreads();
    const float* rp = p.in[19] + ((size_t)l * 4 + h) * 465;
    for (int i = tid; i < 465; i += 256) RPB[i] = rp[i];
  } else {
    const float* lp = p.in[20] + (size_t)l * 128;
    float v1 = 0.f, v2 = 0.f;
    if (lane < 32) { v1 = lp[lane] * lp[32 + lane]; v2 = lp[64 + lane] * lp[96 + lane]; }
    v1 = wave_sum(v1); v2 = wave_sum(v2);
    lam_init = 0.8f - 0.6f * __expf(-0.3f * (float)l);
    lam = __expf(v1) - __expf(v2) + lam_init;
  }
  u32x4 rk[NLD], rv[NLD];
  auto load_tile = [&](int it) {
    const size_t kt0 = tok0 + (size_t)((MODE == 0) ? (rs + it) : it) * 64;
#pragma unroll
    for (int i = 0; i < NLD; ++i) {
      const int q = t5 + i * 256;
      rk[i] = *(const u32x4*)(z + (kt0 + (q >> 3)) * ZC + kcol + (q & 7) * 8);
      rv[i] = *(const u32x4*)(z + (kt0 + vkey) * ZC + vcol + (vdc0 + i) * 8);
    }
  };
  auto store_tile = [&](int buf) {
    unsigned char* KSw = KV0 + buf * (128 * RS);
    unsigned char* VTw = KSw + 64 * RS;
#pragma unroll
    for (int i = 0; i < NLD; ++i) {
      const int q = t5 + i * 256;
      *(u32x4*)(KSw + (q >> 3) * RS + (q & 7) * 16) = rk[i];
#pragma unroll
      for (int e = 0; e < 8; ++e) {
        const unsigned vwd = rv[i][e >> 1];
        const bf16_t val = (bf16_t)((e & 1) ? (vwd >> 16) : (vwd & 0xffffu));
        *(bf16_t*)(VTw + ((vdc0 + i) * 8 + e) * RS + vkey * 2) = val;
      }
    }
  };
  load_tile(0);
  store_tile(0);
  if (ntile > 1) load_tile(1);
  constexpr int NS = (MODE == 0) ? 1 : 2;
  f32x4 o[NS][4];
  float mrun[NS], lrun[NS];
#pragma unroll
  for (int s = 0; s < NS; ++s) { mrun[s] = -1e30f; lrun[s] = 0.f;
#pragma unroll
    for (int dt = 0; dt < 4; ++dt) o[s][dt] = (f32x4){0.f, 0.f, 0.f, 0.f}; }
  const float slope2 = (MODE == 1) ? exp2f(-2.0f * (float)(h + 1)) * LOG2E : 0.f;
  const float sc2 = (MODE == 0) ? 0.125f * LOG2E : 0.17677669529663687f * LOG2E;
  const int qpos = qi * 64 + qc;
  const float dbase = (float)(fq * 4 - qpos);
  int cs = qc - 8; cs = cs < 0 ? 0 : (cs > 48 ? 48 : cs);
  for (int it = 0; it < ntile; ++it) {
    __syncthreads();
    if (it + 1 < ntile) store_tile((it + 1) & 1);
    if (it + 2 < ntile) load_tile(it + 2);
    const unsigned char* KS = KV0 + (it & 1) * (128 * RS);
    const unsigned char* VT = KS + 64 * RS;
    f32x4 s[NS][4];
#pragma unroll
    for (int kt = 0; kt < 4; ++kt) {
      const bf16x8 k0 = *(const bf16x8*)(KS + (kt * 16 + fr) * RS + fq * 16);
      const bf16x8 k1 = *(const bf16x8*)(KS + (kt * 16 + fr) * RS + 64 + fq * 16);
      const f32x4 zf = {0.f, 0.f, 0.f, 0.f};
      if (MODE == 0) { s[0][kt] = MFMA16(k0, qf[0], zf); s[0][kt] = MFMA16(k1, qf[1], s[0][kt]); }
      else { s[0][kt] = MFMA16(k0, qf[0], zf); s[NS - 1][kt] = MFMA16(k1, qf[1], zf); }
    }
    float alpha[NS];
    float mx[NS];
#pragma unroll
    for (int sh = 0; sh < NS; ++sh) mx[sh] = -1e30f;
    if (MODE == 0) {
#pragma unroll
      for (int kt = 0; kt < 4; ++kt)
#pragma unroll
        for (int j = 0; j < 4; ++j) {
          const int kj = kt * 16 + fq * 4 + j;
          const bool valid = (kj >= cs) && (kj < cs + 16);
          int dc = kj - qc + 15; dc = dc < 0 ? 0 : (dc > 30 ? 30 : dc);
          const int dr = rs + it - qi + 7;
          const float t2 = valid ? (s[0][kt][j] * sc2 + RPB[dr * 31 + dc] * LOG2E) : -1e30f;
          s[0][kt][j] = t2;
          mx[0] = fmaxf(mx[0], t2);
        }
    } else {
      const float d0 = dbase + (float)(it * 64);
      if (it != qi) {
        const float ss = (it < qi) ? slope2 : -slope2;
        const float base = ss * d0;
#pragma unroll
        for (int kt = 0; kt < 4; ++kt)
#pragma unroll
          for (int j = 0; j < 4; ++j) {
            const float negad = fmaf(ss, (float)(kt * 16 + j), base);
#pragma unroll
            for (int sh = 0; sh < NS; ++sh) {
              const float t2 = fmaf(s[sh][kt][j], sc2, negad);
              s[sh][kt][j] = t2;
              mx[sh] = fmaxf(mx[sh], t2);
            }
          }
      } else {
#pragma unroll
        for (int kt = 0; kt < 4; ++kt)
#pragma unroll
          for (int j = 0; j < 4; ++j) {
            const float ad = slope2 * fabsf(d0 + (float)(kt * 16 + j));
#pragma unroll
            for (int sh = 0; sh < NS; ++sh) {
              const float t2 = s[sh][kt][j] * sc2 - ad;
              s[sh][kt][j] = t2;
              mx[sh] = fmaxf(mx[sh], t2);
            }
          }
      }
    }
#pragma unroll
    for (int sh = 0; sh < NS; ++sh) {
      float m1 = mx[sh];
      m1 = fq_max(m1);
      const float mn = fmaxf(mrun[sh], m1);
      alpha[sh] = __builtin_amdgcn_exp2f(mrun[sh] - mn);
      mrun[sh] = mn;
      float ps = 0.f;
#pragma unroll
      for (int kt = 0; kt < 4; ++kt)
#pragma unroll
        for (int j = 0; j < 4; ++j) { const float pe = __builtin_amdgcn_exp2f(s[sh][kt][j] - mn); s[sh][kt][j] = pe; ps += pe; }
      lrun[sh] = lrun[sh] * alpha[sh] + ps;
#pragma unroll
      for (int dt = 0; dt < 4; ++dt) o[sh][dt] = o[sh][dt] * alpha[sh];
    }
#pragma unroll
    for (int i2 = 0; i2 < 2; ++i2) {
      bf16x8 pfr[NS];
#pragma unroll
      for (int sh = 0; sh < NS; ++sh) {
        const unsigned u0 = pack2(s[sh][2 * i2][0], s[sh][2 * i2][1]), u1 = pack2(s[sh][2 * i2][2], s[sh][2 * i2][3]);
        const unsigned u2 = pack2(s[sh][2 * i2 + 1][0], s[sh][2 * i2 + 1][1]), u3 = pack2(s[sh][2 * i2 + 1][2], s[sh][2 * i2 + 1][3]);
        const u32x4 u = {u0, u1, u2, u3};
        pfr[sh] = __builtin_bit_cast(bf16x8, u);
      }
#pragma unroll
      for (int dt = 0; dt < 4; ++dt) {
        const u32x2 va = *(const u32x2*)(VT + (dt * 16 + fr) * RS + (32 * i2 + fq * 4) * 2);
        const u32x2 vb = *(const u32x2*)(VT + (dt * 16 + fr) * RS + (32 * i2 + 16 + fq * 4) * 2);
        const u32x4 vu = {va[0], va[1], vb[0], vb[1]};
        const bf16x8 vf = __builtin_bit_cast(bf16x8, vu);
#pragma unroll
        for (int sh = 0; sh < NS; ++sh) o[sh][dt] = MFMA16(vf, pfr[sh], o[sh][dt]);
      }
    }
  }
  float linv[NS];
#pragma unroll
  for (int sh = 0; sh < NS; ++sh) { float lt = lrun[sh]; lt = fq_sum(lt); linv[sh] = rcp_(lt); }
  if (MODE == 0) {
#pragma unroll
    for (int dt = 0; dt < 4; ++dt) {
      const f32x4 r = o[0][dt] * linv[0];
      *(uint2*)(yo + qtok * 256 + h * 64 + dt * 16 + fq * 4) = make_uint2(pack2(r[0], r[1]), pack2(r[2], r[3]));
    }
  } else {
    f32x4 r[4];
    float ss = 0.f;
#pragma unroll
    for (int dt = 0; dt < 4; ++dt) {
      r[dt] = o[0][dt] * linv[0] - lam * (o[NS - 1][dt] * linv[NS - 1]);
      ss += r[dt][0] * r[dt][0] + r[dt][1] * r[dt][1] + r[dt][2] * r[dt][2] + r[dt][3] * r[dt][3];
    }
    ss = fq_sum(ss);
    const float rn = rsqrtf(ss * (1.0f / 64.0f) + 1e-5f) * (1.0f - lam_init);
    const float* sg = p.in[21] + (size_t)l * 64;
#pragma unroll
    for (int dt = 0; dt < 4; ++dt) {
      const f32x4 g = *(const f32x4*)(sg + dt * 16 + fq * 4);
      const f32x4 q = r[dt] * rn * g;
      *(uint2*)(yo + qtok * 256 + h * 64 + dt * 16 + fq * 4) = make_uint2(pack2(q[0], q[1]), pack2(q[2], q[3]));
    }
  }
}

DI void phase_mixers(const Params& p, int l, int half, unsigned* counter, unsigned char* smem) {
  const int L = half ? 2048 : 4096, nseq = HT / L, rows = L / 64;
  const bf16_t* z = (const bf16_t*)(p.ws + WS_Z);
  bf16_t* yf = (bf16_t*)(p.ws + WS_YF);
  bf16_t* yb = (bf16_t*)(p.ws + WS_YB);
  bf16_t* yn = (bf16_t*)(p.ws + WS_YN);
  bf16_t* yd = (bf16_t*)(p.ws + WS_YD);
  bf16_t* sg = (bf16_t*)(p.ws + WS_SG);
  float* bon = (float*)(p.ws + WS_BON);
  const int n_scan = nseq * 16, n_diff = nseq * 4 * rows, n_na = nseq * rows * 4, n_sg = HT / 256;
  const int total = n_scan + n_diff + n_na + n_sg;
  const int hf = __builtin_amdgcn_readfirstlane(otid() >> 8);
  unsigned char* sm = smem + hf * 65536;
  __shared__ int s_item;
  for (;;) {
    __syncthreads();
    if (threadIdx.x == 0) s_item = (int)atomicAdd(counter, 1u);
    __syncthreads();
    int it = 2 * s_item + hf;
    if (it >= total) break;
    if (it < n_scan) {
      const int dir = it & 1, h = (it >> 1) & 7, b = it >> 4;
      item_scan(p, l, L, b, h, dir, z, dir ? yb : yf, bon + (size_t)dir * HT * 8, sm);
      continue;
    }
    it -= n_scan;
    if (it < n_diff) {
      const int qb = it % rows, h = (it / rows) & 3, b = it / (rows * 4);
      item_attn<1>(p, l, L, b, h, qb, z, yd, sm, smem);
      continue;
    }
    it -= n_diff;
    if (it < n_na) {
      const int r = it % rows, h = (it / rows) & 3, b = it / (rows * 4);
      item_attn<0>(p, l, L, b, h, r, z, yn, sm, smem);
      continue;
    }
    it -= n_na;
    item_sg(p, l, L, it, z, sg);
  }
}

#define XB_TMO      128
#define XB_XCNT(j)  (256  + 64 * (j))
#define XB_XSUB(j)  (1280 + 64 * (j))
#define XB_XGEN(j)  (2304 + 64 * (j))
#define XB_TOP      3328
#define XB_TOPGEN   3392
#define XB_SPIN_CAP (1u << 18)
#define LAS __attribute__((address_space(3)))
DI unsigned xb_ld(unsigned* p)              { return __hip_atomic_load(p, __ATOMIC_RELAXED, __HIP_MEMORY_SCOPE_AGENT); }
DI unsigned xb_add(unsigned* p, unsigned v) { return __hip_atomic_fetch_add(p, v, __ATOMIC_RELAXED, __HIP_MEMORY_SCOPE_AGENT); }
DI unsigned xb_xcc_id() { return (unsigned)__builtin_amdgcn_s_getreg((3 << 11) | 20) & 0xFu; }
#define XB_SPIN(cond, bar) do { unsigned _sp = 0; while (cond) { __builtin_amdgcn_s_sleep(1); \
    if ((++_sp & 255u) == 0u) { if (xb_ld(&(bar)[XB_TMO])) break; if (_sp > XB_SPIN_CAP) { atomicAdd(&(bar)[XB_TMO], 1u); break; } } } } while (0)
struct XcdBarrier { unsigned* bar; unsigned x; volatile LAS unsigned* st; };
DI XcdBarrier xcd_barrier_post(unsigned* bar, volatile LAS unsigned* st) {
  XcdBarrier b; b.bar = bar; b.x = xb_xcc_id(); b.st = st;
  if (threadIdx.x == 0) (void)xb_add(&bar[XB_XCNT(b.x)], 1u);
  return b;
}
DI void xcd_barrier_complete(unsigned* bar, unsigned x, unsigned& nloc, unsigned& nx) {
  const unsigned G = gridDim.x * gridDim.y * gridDim.z;
  unsigned sum, cnt, mine, sp = 0u;
  for (;;) {
    sum = 0u; cnt = 0u; mine = 0u;
#pragma unroll
    for (unsigned j = 0; j < 16; ++j) { const unsigned c = xb_ld(&bar[XB_XCNT(j)]); sum += c; cnt += (c > 0u) ? 1u : 0u; mine = (j == x) ? c : mine; }
    if (sum == G) break;
    __builtin_amdgcn_s_sleep(1);
    if ((++sp & 255u) == 0u) { if (xb_ld(&bar[XB_TMO])) break; if (sp > XB_SPIN_CAP) { atomicAdd(&bar[XB_TMO], 1u); break; } }
  }
  nloc = mine > 0u ? mine : 1u; nx = cnt > 0u ? cnt : 1u;
}
DI void xcd_barrier(const XcdBarrier& b) {
  asm volatile("s_waitcnt vmcnt(0)" ::: "memory");
  __syncthreads();
  if (threadIdx.x == 0) {
    unsigned* bar = b.bar;
    __builtin_amdgcn_s_waitcnt(0);
    unsigned nloc = b.st[0], nx = b.st[1];
    if (nloc == 0u) { xcd_barrier_complete(bar, b.x, nloc, nx); b.st[0] = nloc; b.st[1] = nx; }
    const unsigned old = xb_add(&bar[XB_XSUB(b.x)], 1u);
    const unsigned gen = old / nloc;
    if (old + 1u == (gen + 1u) * nloc) {
      __builtin_amdgcn_fence(__ATOMIC_RELEASE, "agent");
      asm volatile("s_waitcnt vmcnt(0)" ::: "memory");
      const unsigned og = xb_add(&bar[XB_TOP], 1u);
      const unsigned tg = og / nx;
      if (og + 1u == (tg + 1u) * nx) xb_add(&bar[XB_TOPGEN], 1u);
      else XB_SPIN(xb_ld(&bar[XB_TOPGEN]) == tg, bar);
      __builtin_amdgcn_fence(__ATOMIC_ACQUIRE, "agent");
      xb_add(&bar[XB_XGEN(b.x)], 1u);
      asm volatile("s_waitcnt vmcnt(0)" ::: "memory");
    } else {
      XB_SPIN(xb_ld(&bar[XB_XGEN(b.x)]) == gen, bar);
      __builtin_amdgcn_fence(__ATOMIC_ACQUIRE, "agent");
      asm volatile("s_waitcnt vmcnt(0)" ::: "memory");
    }
  }
  __syncthreads();
}

__global__ void __launch_bounds__(512, 2) fwd_megakernel(Params p) {
  cg::grid_group grid = cg::this_grid();
  __shared__ __attribute__((aligned(16))) unsigned char smem[131072];
  bf16_t* W = (bf16_t*)(p.ws + WS_W);
  bf16_t* xn = (bf16_t*)(p.ws + WS_XN);
  bf16_t* hid = (bf16_t*)(p.ws + WS_HID);
  bf16_t* z = (bf16_t*)(p.ws + WS_Z);
  bf16_t* mo = (bf16_t*)(p.ws + WS_M);
  unsigned* ctl = (unsigned*)(p.ws + WS_CTL);
  __shared__ uint4 xb_words;
  if (threadIdx.x == 0) xb_words = make_uint4(0u, 0u, 0u, 0u);
  __syncthreads();
  const XcdBarrier xb = xcd_barrier_post((unsigned*)(p.ws + WS_BAR), (volatile LAS unsigned*)&xb_words);

  phase_convert(p, smem);
  grid.sync();
  for (int half = 0; half < 2; ++half) {
    const float* xin = p.in[half];
    float* x = p.out + (size_t)half * HT * D;
    const int L = half ? 2048 : 4096;
    for (int l = 0; l < NLAYER; ++l) {
      const bf16_t* Wl = W + (size_t)l * W_LAYER;
      const float* xsrc = (l == 0) ? xin : x;
      phase_norm(xsrc, p.in[2] + (size_t)l * D, xn, nullptr);
      xcd_barrier(xb);
      phase_ffn_up(xn, Wl + W_GU, hid, smem);
      xcd_barrier(xb);
      phase_gemm_resid(hid, DFF, Wl + W_WD, xsrc, x, 0.5f, smem);
      xcd_barrier(xb);
      phase_norm(x, p.in[6] + (size_t)l * D, xn, nullptr);
      xcd_barrier(xb);
      phase_proj(xn, Wl + W_IN, z, smem);
      xcd_barrier(xb);
      phase_mixers(p, l, half, ctl + (half * NLAYER + l) * 16, smem);
      xcd_barrier(xb);
      phase_ya(p, l, L, (const bf16_t*)(p.ws + WS_SG), Wl + W_G2, z, (bf16_t*)(p.ws + WS_YF), (const bf16_t*)(p.ws + WS_YB), (const float*)(p.ws + WS_BON), smem);
      xcd_barrier(xb);
      phase_merge(xn, Wl, (const bf16_t*)(p.ws + WS_YF), (const bf16_t*)(p.ws + WS_YN), (const bf16_t*)(p.ws + WS_YD), mo, smem);
      xcd_barrier(xb);
      phase_gemm_resid(mo, D, Wl + W_OUT, x, x, 1.0f, smem);
      xcd_barrier(xb);
      phase_norm(x, p.in[26] + (size_t)l * D, xn, nullptr);
      xcd_barrier(xb);
      phase_ffn_up(xn, Wl + W_GU2, hid, smem);
      xcd_barrier(xb);
      phase_gemm_resid(hid, DFF, Wl + W_WD2, x, x, 0.5f, smem);
      xcd_barrier(xb);
    }
    phase_norm(x, p.in[30], nullptr, x);
    xcd_barrier(xb);
  }
}

extern "C" void kernel_launch(void* const* d_in, const int* in_sizes, int n_in, void* d_out, int out_size, void* d_ws, size_t ws_size, hipStream_t stream) {
  static int grid_blocks = 0;
  if (!grid_blocks) {
    int dev = 0, cus = 0, per_cu = 0;
    (void)hipGetDevice(&dev);
    (void)hipDeviceGetAttribute(&cus, hipDeviceAttributeMultiprocessorCount, dev);
    (void)hipOccupancyMaxActiveBlocksPerMultiprocessor(&per_cu, fwd_megakernel, 512, 0);
    if (per_cu < 1) per_cu = 1;
    if (per_cu > 1) per_cu = 1;
    grid_blocks = cus * per_cu;
    if (ws_size < WS_END) fprintf(stderr, "kernel_launch: workspace too small: need %zu have %zu\n", (size_t)WS_END, ws_size);
  }
  (void)hipMemsetAsync((char*)d_ws + WS_CTL, 0, WS_CTL_BYTES, stream);
  Params p{};
  for (int i = 0; i < 31; ++i) p.in[i] = (const float*)d_in[i];
  p.out = (float*)d_out;
  p.ws = (unsigned char*)d_ws;
  void* args[] = {&p};
  hipError_t e = hipLaunchCooperativeKernel((void*)fwd_megakernel, dim3(grid_blocks), dim3(512), args, 0, stream);
  if (e != hipSuccess) fprintf(stderr, "cooperative launch failed: %s (grid %d)\n", hipGetErrorString(e), grid_blocks);
}
```

```cpp
#include <hip/hip_runtime.h>
#include <hip/hip_cooperative_groups.h>
#include <cstdio>
#include <cstdint>
namespace cg = cooperative_groups;

typedef unsigned short bf16_t;
typedef short bf16x8 __attribute__((ext_vector_type(8)));
typedef short s16x4 __attribute__((ext_vector_type(4)));
typedef float f32x4 __attribute__((ext_vector_type(4)));
typedef float f32x2 __attribute__((ext_vector_type(2)));
typedef unsigned u32x4 __attribute__((ext_vector_type(4)));
typedef unsigned u32x2 __attribute__((ext_vector_type(2)));
#define DI __device__ __forceinline__
#define MFMA16(a, b, c) __builtin_amdgcn_mfma_f32_16x16x32_bf16((a), (b), (c), 0, 0, 0)

constexpr int D = 1024, DFF = 2816, HT = 65536  , NLAYER = 2;
constexpr int ZC = 3328;
constexpr int INC = 6400;
constexpr int CA = 512;
constexpr float LOG2E = 1.4426950408889634f;

constexpr size_t WS_CTL = 0;
constexpr size_t WS_BAR = 4096;
constexpr size_t WS_CTL_BYTES = 32768;
constexpr size_t WS_W = WS_CTL_BYTES;
constexpr size_t W_GU = 0;
constexpr size_t W_WD = W_GU + (size_t)2 * DFF * D;
constexpr size_t W_GU2 = W_WD + (size_t)D * DFF;
constexpr size_t W_WD2 = W_GU2 + (size_t)2 * DFF * D;
constexpr size_t W_IN = W_WD2 + (size_t)D * DFF;
constexpr size_t W_PA = W_IN + (size_t)INC * D;
constexpr size_t W_PB = W_PA + (size_t)D * 512;
constexpr size_t W_PC = W_PB + (size_t)D * 256;
constexpr size_t W_OUT = W_PC + (size_t)D * 256;
constexpr size_t W_G2 = W_OUT + (size_t)D * D;
constexpr size_t W_LAYER = W_G2 + (size_t)512 * 128;
constexpr size_t WS_XN = WS_W + 2 * W_LAYER * 2;
constexpr size_t WS_R = WS_XN + (size_t)HT * D * 2;
constexpr size_t WS_HID = WS_R;
constexpr size_t WS_Z = WS_R;
constexpr size_t WS_M = WS_R;
constexpr size_t WS_YF = WS_Z + (size_t)HT * ZC * 2;
constexpr size_t WS_YB = WS_YF + (size_t)HT * 512 * 2;
constexpr size_t WS_YN = WS_YB + (size_t)HT * 512 * 2;
constexpr size_t WS_YD = WS_YN + (size_t)HT * 256 * 2;
constexpr size_t WS_SG = WS_YD + (size_t)HT * 256 * 2;
constexpr size_t WS_BON = WS_SG + (size_t)HT * 128 * 2;
constexpr size_t WS_END = WS_BON + (size_t)2 * HT * 8 * 4;

struct Params {
  const float* in[31];
  float* out;
  unsigned char* ws;
};

typedef __bf16 bf16x2_t __attribute__((ext_vector_type(2)));
DI unsigned pack2(float lo, float hi) { const f32x2 v = {lo, hi}; const bf16x2_t b = __builtin_convertvector(v, bf16x2_t); return __builtin_bit_cast(unsigned, b); }
DI bf16_t f2bf(float x) { return (bf16_t)(pack2(x, x) & 0xffffu); }
DI float bf2f(bf16_t h) { return __uint_as_float(((unsigned)h) << 16); }
DI float lo2f(unsigned u) { return __uint_as_float(u << 16); }
DI float hi2f(unsigned u) { return __uint_as_float(u & 0xffff0000u); }
DI float xor16_sum(float v) { const auto r = __builtin_amdgcn_permlane16_swap(__float_as_uint(v), __float_as_uint(v), false, false); return __uint_as_float(r[0]) + __uint_as_float(r[1]); }
DI float xor32_sum(float v) { const auto r = __builtin_amdgcn_permlane32_swap(__float_as_uint(v), __float_as_uint(v), false, false); return __uint_as_float(r[0]) + __uint_as_float(r[1]); }
DI float xor16_max(float v) { const auto r = __builtin_amdgcn_permlane16_swap(__float_as_uint(v), __float_as_uint(v), false, false); return fmaxf(__uint_as_float(r[0]), __uint_as_float(r[1])); }
DI float xor32_max(float v) { const auto r = __builtin_amdgcn_permlane32_swap(__float_as_uint(v), __float_as_uint(v), false, false); return fmaxf(__uint_as_float(r[0]), __uint_as_float(r[1])); }
DI float fq_sum(float v) { return xor32_sum(xor16_sum(v)); }
DI float fq_max(float v) { return xor32_max(xor16_max(v)); }
DI float quad_sum(float v) {
  int t = __builtin_amdgcn_update_dpp(0, __float_as_int(v), 0xB1, 0xF, 0xF, true);
  v += __int_as_float(t);
  t = __builtin_amdgcn_update_dpp(0, __float_as_int(v), 0x4E, 0xF, 0xF, true);
  v += __int_as_float(t);
  return v;
}
DI float oct_sum(float v) {
  v = quad_sum(v);
  const int t = __builtin_amdgcn_update_dpp(0, __float_as_int(v), 0x141, 0xF, 0xF, true);
  return v + __int_as_float(t);
}
DI float row_sum16(float v) {
  v = oct_sum(v);
  const int t = __builtin_amdgcn_update_dpp(0, __float_as_int(v), 0x140, 0xF, 0xF, true);
  return v + __int_as_float(t);
}
DI float wave_sum(float v) { return fq_sum(row_sum16(v)); }
DI void oct_sum_pair(float& a, float& b) {
#define OSP_STAGE(ctrl) { const int ta = __builtin_amdgcn_update_dpp(0, __float_as_int(a), ctrl, 0xF, 0xF, true); const int tb = __builtin_amdgcn_update_dpp(0, __float_as_int(b), ctrl, 0xF, 0xF, true); \
    a += __int_as_float(ta); b += __int_as_float(tb); asm volatile("" : "+v"(a)); asm volatile("" : "+v"(b)); }
  OSP_STAGE(0xB1) OSP_STAGE(0x4E) OSP_STAGE(0x141)
#undef OSP_STAGE
}
DI int otid() { int t = threadIdx.x; asm volatile("" : "+v"(t)); return t; }
DI float rcp_(float x) { return __builtin_amdgcn_rcpf(x); }
DI float sigmoidf_(float x) { return rcp_(1.0f + __expf(-x)); }

DI void convert_job(const float* __restrict__ src, int K, int N, bf16_t* __restrict__ dst, int mode, float* tile  ) {
  const int tid = otid();
  const int ntk = K / 64, ntn = N / 64, nt = ntk * ntn;
  for (int t = blockIdx.x; t < nt; t += gridDim.x) {
    const int tk = t / ntn, tn = t % ntn;
    const int k0 = tk * 64, n0 = tn * 64;
    __syncthreads();
#pragma unroll
    for (int i = 0; i < 8; ++i) {
      const int kk = (tid >> 6) + i * 8, nn = tid & 63;
      tile[kk * 65 + nn] = src[(size_t)(k0 + kk) * N + n0 + nn];
    }
    __syncthreads();
    const int nn = tid >> 3, kc = (tid & 7) * 8;
    const int n = n0 + nn;
    int row = n;
    if (mode == 1) row = (n >> 5) * 64 + (n & 31);
    else if (mode == 2) row = (n >> 5) * 64 + 32 + (n & 31);
    u32x4 pk;
#pragma unroll
    for (int i = 0; i < 4; ++i) pk[i] = pack2(tile[(kc + 2 * i) * 65 + nn], tile[(kc + 2 * i + 1) * 65 + nn]);
    *(u32x4*)(dst + (size_t)row * K + k0 + kc) = pk;
  }
}

DI void phase_convert(const Params& p, unsigned char* smem) {
  float* tile = (float*)smem;
  bf16_t* W = (bf16_t*)(p.ws + WS_W);
  for (int l = 0; l < NLAYER; ++l) {
    bf16_t* Wl = W + (size_t)l * W_LAYER;
    convert_job(p.in[3] + (size_t)l * D * DFF, D, DFF, Wl + W_GU, 1, tile);
    convert_job(p.in[4] + (size_t)l * D * DFF, D, DFF, Wl + W_GU, 2, tile);
    convert_job(p.in[5] + (size_t)l * DFF * D, DFF, D, Wl + W_WD, 0, tile);
    convert_job(p.in[27] + (size_t)l * D * DFF, D, DFF, Wl + W_GU2, 1, tile);
    convert_job(p.in[28] + (size_t)l * D * DFF, D, DFF, Wl + W_GU2, 2, tile);
    convert_job(p.in[29] + (size_t)l * DFF * D, DFF, D, Wl + W_WD2, 0, tile);
    convert_job(p.in[7] + (size_t)l * D * INC, D, INC, Wl + W_IN, 0, tile);
    convert_job(p.in[22] + (size_t)l * 512 * D, 512, D, Wl + W_PA, 0, tile);
    convert_job(p.in[23] + (size_t)l * 256 * D, 256, D, Wl + W_PB, 0, tile);
    convert_job(p.in[24] + (size_t)l * 256 * D, 256, D, Wl + W_PC, 0, tile);
    convert_job(p.in[25] + (size_t)l * D * D, D, D, Wl + W_OUT, 0, tile);
    convert_job(p.in[16] + (size_t)l * 128 * 512, 128, 512, Wl + W_G2, 0, tile);
  }
}

DI void phase_norm(const float* __restrict__ src, const float* __restrict__ gam, bf16_t* __restrict__ xn, float* __restrict__ fout) {
  const int tid_ = otid(), lane = tid_ & 63, w = tid_ >> 6;
  f32x4 g[4];
#pragma unroll
  for (int i = 0; i < 4; ++i) g[i] = *(const f32x4*)(gam + i * 256 + lane * 4);
  const int stride = gridDim.x * 8;
  auto ld = [&](f32x4 (&v)[4], int row) {
    if (row < HT) {
#pragma unroll
      for (int i = 0; i < 4; ++i) v[i] = *(const f32x4*)(src + (size_t)row * D + i * 256 + lane * 4);
    }
  };
  auto proc = [&](const f32x4 (&v)[4], int row) {
    float ss = 0.f;
#pragma unroll
    for (int i = 0; i < 4; ++i) ss += (v[i][0] * v[i][0] + v[i][1] * v[i][1]) + (v[i][2] * v[i][2] + v[i][3] * v[i][3]);
    ss = wave_sum(ss);
    const float rs = rsqrtf(ss * (1.0f / 1024.0f) + 1e-6f);
#pragma unroll
    for (int i = 0; i < 4; ++i) {
      const f32x4 y = v[i] * rs * g[i];
      if (fout) *(f32x4*)(fout + (size_t)row * D + i * 256 + lane * 4) = y;
      else *(uint2*)(xn + (size_t)row * D + i * 256 + lane * 4) = make_uint2(pack2(y[0], y[1]), pack2(y[2], y[3]));
    }
  };
  int t = blockIdx.x * 8 + w;
  f32x4 a[4], b[4];
  ld(a, t); ld(b, t + stride);
  for (; t < HT; t += 2 * stride) {
    f32x4 na[4], nb[4];
    ld(na, t + 2 * stride); ld(nb, t + 3 * stride);
    proc(a, t);
    if (t + stride < HT) proc(b, t + stride);
#pragma unroll
    for (int i = 0; i < 4; ++i) { a[i] = na[i]; b[i] = nb[i]; }
  }
}

constexpr int RS = 144;
typedef __attribute__((address_space(3))) unsigned lds_u32;
DI void glds16(const void* g, unsigned char* l) { __builtin_amdgcn_global_load_lds((const unsigned*)g, (lds_u32*)l, 16, 0, 0); }
template <int N> DI void wait_vm() { asm volatile("s_waitcnt vmcnt(%0)" :: "n"(N) : "memory"); }
template <int MT, int NT, int WR, int WC>
DI void gemm_block(const bf16_t* __restrict__ A, int lda, const bf16_t* __restrict__ B, int ldb, int K, f32x4 (&acc)[MT][NT], unsigned char* smem,
                   bool primed = false, const bf16_t* __restrict__ nA = nullptr, int nlda = 0, const bf16_t* __restrict__ nB = nullptr, int nldb = 0) {
  static_assert(WR * WC == 8, "8 waves");
  constexpr int AR = 16 * MT * WR, BR = 16 * NT * WC;
  constexpr int AB = AR * 128, BB = BR * 128, STG = AB + BB;
  constexpr int NA = AR * 8 / 512, NB = BR * 8 / 512;
  const int tid = otid(), lane = tid & 63, w = tid >> 6, wr = w / WC, wc = w % WC, fr = lane & 15, fq = lane >> 4;
  const int srow = tid >> 3, kch = (tid & 7) ^ ((tid >> 4) & 7);
  const unsigned voA = (unsigned)(srow * lda + kch * 8) * 2u, voB = (unsigned)(srow * ldb + kch * 8) * 2u;
  const char* Ab = (const char*)A;
  const char* Bb = (const char*)B;
  const int nk = K >> 6;
  if (!primed) {
#pragma unroll
    for (int i = 0; i < NA; ++i) glds16(Ab + (size_t)i * 128 * lda + voA, smem + (i * 512 + tid) * 16);
#pragma unroll
    for (int i = 0; i < NB; ++i) glds16(Bb + (size_t)i * 128 * ldb + voB, smem + AB + (i * 512 + tid) * 16);
  }
  const int sw = (fr >> 1) & 7;
  const unsigned lds_base = (unsigned)(size_t)(__attribute__((address_space(3))) unsigned char*)smem;
  const unsigned a_row = (wr * 16 * MT + fr) * 128, b_row = AB + (wc * 16 * NT + fr) * 128;
  for (int kt = 0; kt < nk; ++kt) {
    wait_vm<0>();
    __builtin_amdgcn_s_barrier();
    if (kt + 1 < nk) {
      unsigned char* sn = smem + ((kt + 1) & 1) * STG;
      const int ko = (kt + 1) * 64;
#pragma unroll
      for (int i = 0; i < NA; ++i) glds16(Ab + ((size_t)i * 128 * lda + ko * 2) + voA, sn + (i * 512 + tid) * 16);
#pragma unroll
      for (int i = 0; i < NB; ++i) glds16(Bb + ((size_t)i * 128 * ldb + ko * 2) + voB, sn + AB + (i * 512 + tid) * 16);
    } else if (nA) {
      const unsigned nvoA = (unsigned)(srow * nlda + kch * 8) * 2u, nvoB = (unsigned)(srow * nldb + kch * 8) * 2u;
#pragma unroll
      for (int i = 0; i < NA; ++i) glds16((const char*)nA + (size_t)i * 128 * nlda + nvoA, smem + (i * 512 + tid) * 16);
#pragma unroll
      for (int i = 0; i < NB; ++i) glds16((const char*)nB + (size_t)i * 128 * nldb + nvoB, smem + AB + (i * 512 + tid) * 16);
    }
    const unsigned stb = lds_base + (kt & 1) * STG;
#pragma unroll
    for (int ks = 0; ks < 2; ++ks) {
      const unsigned co = ((ks * 4 + fq) ^ sw) * 16;
      const unsigned sa = stb + a_row + co, sb = stb + b_row + co;
      bf16x8 af[4], bfr[NT];
#pragma unroll
      for (int n = 0; n < NT; ++n) asm volatile("ds_read_b128 %0, %1 offset:%2" : "=v"(bfr[n]) : "v"(sb), "n"(n * 2048) : "memory");
#pragma unroll
      for (int mg = 0; mg < MT / 4; ++mg) {
#pragma unroll
        for (int m = 0; m < 4; ++m) asm volatile("ds_read_b128 %0, %1 offset:%2" : "=v"(af[m]) : "v"(sa), "n"((mg * 4 + m) * 2048) : "memory");
        if (mg == 0) {
#pragma unroll
          for (int n = 0; n < NT; ++n) asm volatile("s_waitcnt lgkmcnt(%1)" : "+v"(bfr[n]) : "n"(4 + NT - 1 - n) : "memory");
        }
#pragma unroll
        for (int m = 0; m < 4; ++m) {
          asm volatile("s_waitcnt lgkmcnt(%1)" : "+v"(af[m]) : "n"(3 - m) : "memory");
#pragma unroll
          for (int n = 0; n < NT; ++n) acc[mg * 4 + m][n] = MFMA16(bfr[n], af[m], acc[mg * 4 + m][n]);
        }
      }
    }
  }
  if (!nA) __syncthreads();
}

template <int MT, int NT>
DI void zero_acc(f32x4 (&acc)[MT][NT]) {
#pragma unroll
  for (int m = 0; m < MT; ++m)
#pragma unroll
    for (int n = 0; n < NT; ++n) acc[m][n] = (f32x4){0.f, 0.f, 0.f, 0.f};
}

DI void tile_coords(int id, int nN, int& pm, int& pn) {
  const int band = id / (16 * nN), r = id % (16 * nN);
  pm = band * 16 + (r & 15); pn = r >> 4;
}

DI void phase_ffn_up(const bf16_t* __restrict__ xn, const bf16_t* __restrict__ gu, bf16_t* __restrict__ hid, unsigned char* smem) {
  const int tid_ = otid(), lane = tid_ & 63, w = tid_ >> 6, wr = w >> 2, wc = w & 3, fr = lane & 15, fq = lane >> 4;
  constexpr int nN = 2 * DFF / 256, nM = HT / 256;
  for (int id = blockIdx.x; id < nM * nN; id += gridDim.x) {
    int pm, pn; tile_coords(id, nN, pm, pn);
    f32x4 acc[8][4]; zero_acc(acc);
    {
      const int idn = id + gridDim.x; int pm2 = 0, pn2 = 0; const bool hn = idn < nM * nN; if (hn) tile_coords(idn, nN, pm2, pn2);
      gemm_block<8, 4, 2, 4>(xn + (size_t)pm * 256 * D, D, gu + (size_t)pn * 256 * D, D, D, acc, smem, id != (int)blockIdx.x,
                             hn ? xn + (size_t)pm2 * 256 * D : nullptr, D, gu + (size_t)pn2 * 256 * D, D);
    }
    const int hc0 = (pn * 4 + wc) * 32 + fq * 4;
#pragma unroll
    for (int m = 0; m < 8; ++m) {
      const size_t row = (size_t)pm * 256 + wr * 128 + m * 16 + fr;
#pragma unroll
      for (int n = 0; n < 2; ++n) {
        float h[4];
#pragma unroll
        for (int j = 0; j < 4; ++j) { const float g = acc[m][n][j], u = acc[m][n + 2][j]; h[j] = g * rcp_(1.0f + __expf(-g)) * u; }
        *(uint2*)(hid + row * DFF + hc0 + n * 16) = make_uint2(pack2(h[0], h[1]), pack2(h[2], h[3]));
      }
    }
  }
}

DI void phase_gemm_resid(const bf16_t* __restrict__ A, int K, const bf16_t* __restrict__ Bt, const float* __restrict__ xin, float* __restrict__ xout, float alpha, unsigned char* smem) {
  const int tid_ = otid(), lane = tid_ & 63, w = tid_ >> 6, wr = w >> 2, wc = w & 3, fr = lane & 15, fq = lane >> 4;
  constexpr int nN = D / 256, nM = HT / 256;
  for (int id = blockIdx.x; id < nM * nN; id += gridDim.x) {
    int pm, pn; tile_coords(id, nN, pm, pn);
    f32x4 acc[8][4]; zero_acc(acc);
    {
      const int idn = id + gridDim.x; int pm2 = 0, pn2 = 0; const bool hn = idn < nM * nN; if (hn) tile_coords(idn, nN, pm2, pn2);
      gemm_block<8, 4, 2, 4>(A + (size_t)pm * 256 * K, K, Bt + (size_t)pn * 256 * K, K, K, acc, smem, id != (int)blockIdx.x,
                             hn ? A + (size_t)pm2 * 256 * K : nullptr, K, Bt + (size_t)pn2 * 256 * K, K);
    }
#pragma unroll
    for (int m = 0; m < 8; ++m) {
      const size_t row = (size_t)pm * 256 + wr * 128 + m * 16 + fr;
#pragma unroll
      for (int n = 0; n < 4; ++n) {
        const size_t o = row * D + pn * 256 + wc * 64 + n * 16 + fq * 4;
        const f32x4 x = *(const f32x4*)(xin + o);
        *(f32x4*)(xout + o) = x + alpha * acc[m][n];
      }
    }
  }
}

DI void phase_proj(const bf16_t* __restrict__ xn, const bf16_t* __restrict__ wint, bf16_t* __restrict__ z, unsigned char* smem) {
  const int tid_ = otid(), lane = tid_ & 63, w = tid_ >> 6, wr = w >> 2, wc = w & 3, fr = lane & 15, fq = lane >> 4;
  constexpr int nN = ZC / 256, nM = HT / 256;
  for (int id = blockIdx.x; id < nM * nN; id += gridDim.x) {
    int pm, pn; tile_coords(id, nN, pm, pn);
    f32x4 acc[8][4]; zero_acc(acc);
    {
      const int idn = id + gridDim.x; int pm2 = 0, pn2 = 0; const bool hn = idn < nM * nN; if (hn) tile_coords(idn, nN, pm2, pn2);
      gemm_block<8, 4, 2, 4>(xn + (size_t)pm * 256 * D, D, wint + (size_t)pn * 256 * D, D, D, acc, smem, id != (int)blockIdx.x,
                             hn ? xn + (size_t)pm2 * 256 * D : nullptr, D, wint + (size_t)pn2 * 256 * D, D);
    }
#pragma unroll
    for (int m = 0; m < 8; ++m) {
      const size_t row = (size_t)pm * 256 + wr * 128 + m * 16 + fr;
#pragma unroll
      for (int n = 0; n < 4; ++n) {
        const f32x4 a = acc[m][n];
        *(uint2*)(z + row * ZC + pn * 256 + wc * 64 + n * 16 + fq * 4) = make_uint2(pack2(a[0], a[1]), pack2(a[2], a[3]));
      }
    }
  }
}

DI void phase_ya(const Params& p, int l, int L, const bf16_t* __restrict__ sg, const bf16_t* __restrict__ g2t, const bf16_t* __restrict__ z,
                 bf16_t* __restrict__ yf, const bf16_t* __restrict__ yb, const float* __restrict__ bon, unsigned char* smem) {
  const int tid_ = otid(), lane = tid_ & 63, w = tid_ >> 6, wr = w >> 1, wc = w & 1, fr = lane & 15, fq = lane >> 4;
  constexpr int nN = 4, nM = HT / 256;
  const float* mu0 = p.in[8] + (size_t)l * 2 * 1792;
  const float* mu1 = mu0 + 1792;
  const float* lng = p.in[17] + (size_t)l * CA;
  const float* lnb = p.in[18] + (size_t)l * CA;
  for (int id = blockIdx.x; id < nM * nN; id += gridDim.x) {
    int pm, pn; tile_coords(id, nN, pm, pn);
    f32x4 acc[4][4]; zero_acc(acc);
    {
      const int idn = id + gridDim.x; int pm2 = 0, pn2 = 0; const bool hn = idn < nM * nN; if (hn) tile_coords(idn, nN, pm2, pn2);
      gemm_block<4, 4, 4, 2>(sg + (size_t)pm * 256 * 128, 128, g2t + (size_t)pn * 128 * 128, 128, 128, acc, smem, id != (int)blockIdx.x,
                             hn ? sg + (size_t)pm2 * 256 * 128 : nullptr, 128, g2t + (size_t)pn2 * 128 * 128, 128);
    }
    const int h = pn * 2 + wc;
    const int c0 = h * 64 + fq * 4;
    f32x4 M0[4], M1[4], GG[4], BB[4];
#pragma unroll
    for (int n = 0; n < 4; ++n) {
      M0[n] = *(const f32x4*)(mu0 + 1024 + c0 + n * 16); M1[n] = *(const f32x4*)(mu1 + 1024 + c0 + n * 16);
      GG[n] = *(const f32x4*)(lng + c0 + n * 16); BB[n] = *(const f32x4*)(lnb + c0 + n * 16);
    }
#pragma unroll
    for (int m = 0; m < 4; ++m) {
      const int row = pm * 256 + wr * 64 + m * 16 + fr;
      const int t = row % L;
      const bool hasp = t > 0, hasn = t < L - 1;
      const bf16_t* zr = z + (size_t)row * ZC + 1024 + c0;
      const bf16_t* zp = hasp ? zr - ZC : zr;
      const bf16_t* zn = hasn ? zr + ZC : zr;
      uint2 A[4], B[4], V0[4], VP[4], VN[4];
#pragma unroll
      for (int n = 0; n < 4; ++n) {
        A[n] = *(const uint2*)(yf + (size_t)row * CA + c0 + n * 16);
        B[n] = *(const uint2*)(yb + (size_t)row * CA + c0 + n * 16);
        V0[n] = *(const uint2*)(zr + n * 16);
        VP[n] = *(const uint2*)(zp + n * 16);
        VN[n] = *(const uint2*)(zn + n * 16);
      }
      const float bsum = bon[(size_t)row * 8 + h] + bon[(size_t)HT * 8 + (size_t)row * 8 + h];
      float y[4][4];
      float s = 0.f;
#pragma unroll
      for (int n = 0; n < 4; ++n) {
        y[n][0] = lo2f(A[n].x) + lo2f(B[n].x); y[n][1] = hi2f(A[n].x) + hi2f(B[n].x); y[n][2] = lo2f(A[n].y) + lo2f(B[n].y); y[n][3] = hi2f(A[n].y) + hi2f(B[n].y);
        s += (y[n][0] + y[n][1]) + (y[n][2] + y[n][3]);
      }
      s = fq_sum(s);
      const float mean = s * (1.0f / 64.0f);
      float q = 0.f;
#pragma unroll
      for (int n = 0; n < 4; ++n)
#pragma unroll
        for (int j = 0; j < 4; ++j) { const float d = y[n][j] - mean; q += d * d; }
      q = fq_sum(q);
      const float rstd = rsqrtf(q * (1.0f / 64.0f) + 64e-5f);
#pragma unroll
      for (int n = 0; n < 4; ++n) {
        const float vc[4] = {lo2f(V0[n].x), hi2f(V0[n].x), lo2f(V0[n].y), hi2f(V0[n].y)};
        const float vpp[4] = {hasp ? lo2f(VP[n].x) : 0.f, hasp ? hi2f(VP[n].x) : 0.f, hasp ? lo2f(VP[n].y) : 0.f, hasp ? hi2f(VP[n].y) : 0.f};
        const float vnn[4] = {hasn ? lo2f(VN[n].x) : 0.f, hasn ? hi2f(VN[n].x) : 0.f, hasn ? lo2f(VN[n].y) : 0.f, hasn ? hi2f(VN[n].y) : 0.f};
        float o[4];
#pragma unroll
        for (int j = 0; j < 4; ++j) {
          const float vs = vc[j] + M0[n][j] * (vpp[j] - vc[j]) + M1[n][j] * (vnn[j] - vc[j]);
          o[j] = ((y[n][j] - mean) * rstd * GG[n][j] + BB[n][j] + bsum * vs) * acc[m][n][j];
        }
        *(uint2*)(yf + (size_t)row * CA + c0 + n * 16) = make_uint2(pack2(o[0], o[1]), pack2(o[2], o[3]));
      }
    }
  }
}

DI void phase_merge(const bf16_t* __restrict__ xn, const bf16_t* __restrict__ Wl, const bf16_t* __restrict__ ya, const bf16_t* __restrict__ yn, const bf16_t* __restrict__ yd,
                    bf16_t* __restrict__ mo, unsigned char* smem) {
  const int tid_ = otid(), lane = tid_ & 63, w = tid_ >> 6, wr = w >> 1, wc = w & 1, fr = lane & 15, fq = lane >> 4;
  constexpr int nN = D / 128, nM = HT / 256;
  for (int id = blockIdx.x; id < nM * nN; id += gridDim.x) {
    int pm, pn; tile_coords(id, nN, pm, pn);
    unsigned tot[4][4][2];
#pragma unroll 1
    for (int i = 0; i < 3; ++i) {
      unsigned gp[4][4][2];
      {
        f32x4 ag[4][4]; zero_acc(ag);
        const bf16_t* Yn = (i == 0) ? ya : (i == 1 ? yn : yd);
        const int Kn = (i == 0) ? 512 : 256;
        const bf16_t* Pn = Wl + (i == 0 ? W_PA : (i == 1 ? W_PB : W_PC));
        gemm_block<4, 4, 4, 2>(xn + (size_t)pm * 256 * D, D, Wl + W_IN + (size_t)(ZC + i * 1024 + pn * 128) * D, D, D, ag, smem, !(i == 0 && id == (int)blockIdx.x),
                               Yn + (size_t)pm * 256 * Kn, Kn, Pn + (size_t)pn * 128 * Kn, Kn);
#pragma unroll
        for (int m = 0; m < 4; ++m)
#pragma unroll
          for (int n = 0; n < 4; ++n) {
            gp[m][n][0] = pack2(sigmoidf_(ag[m][n][0]), sigmoidf_(ag[m][n][1]));
            gp[m][n][1] = pack2(sigmoidf_(ag[m][n][2]), sigmoidf_(ag[m][n][3]));
          }
      }
      f32x4 ay[4][4]; zero_acc(ay);
      const bf16_t* Y = (i == 0) ? ya : (i == 1 ? yn : yd);
      const int Ki = (i == 0) ? 512 : 256;
      const bf16_t* P = Wl + (i == 0 ? W_PA : (i == 1 ? W_PB : W_PC));
      {
        const int idn = id + gridDim.x; int pm2 = pm, pn2 = pn, i2 = i + 1; bool hn = true;
        if (i == 2) { i2 = 0; hn = idn < nM * nN; if (hn) tile_coords(idn, nN, pm2, pn2); }
        gemm_block<4, 4, 4, 2>(Y + (size_t)pm * 256 * Ki, Ki, P + (size_t)pn * 128 * Ki, Ki, Ki, ay, smem, true,
                               hn ? xn + (size_t)pm2 * 256 * D : nullptr, D, Wl + W_IN + (size_t)(ZC + i2 * 1024 + pn2 * 128) * D, D);
      }
#pragma unroll
      for (int m = 0; m < 4; ++m)
#pragma unroll
        for (int n = 0; n < 4; ++n) {
          float t0 = ay[m][n][0] * lo2f(gp[m][n][0]), t1 = ay[m][n][1] * hi2f(gp[m][n][0]);
          float t2 = ay[m][n][2] * lo2f(gp[m][n][1]), t3 = ay[m][n][3] * hi2f(gp[m][n][1]);
          if (i > 0) { t0 += lo2f(tot[m][n][0]); t1 += hi2f(tot[m][n][0]); t2 += lo2f(tot[m][n][1]); t3 += hi2f(tot[m][n][1]); }
          tot[m][n][0] = pack2(t0, t1); tot[m][n][1] = pack2(t2, t3);
        }
    }
#pragma unroll
    for (int m = 0; m < 4; ++m) {
      const size_t row = (size_t)pm * 256 + wr * 64 + m * 16 + fr;
#pragma unroll
      for (int n = 0; n < 4; ++n)
        *(uint2*)(mo + row * D + pn * 128 + wc * 64 + n * 16 + fq * 4) = make_uint2(tot[m][n][0], tot[m][n][1]);
    }
  }
}

DI void item_sg(const Params& p, int l, int L, int item, const bf16_t* __restrict__ z, bf16_t* __restrict__ sg) {
  const int tid_ = otid() & 255, lane = tid_ & 63, w = tid_ >> 6;
  const float* mu0 = p.in[8] + (size_t)l * 2 * 1792 + 1664 + 2 * lane;
  const float* mu1 = mu0 + 1792;
  const float m0a = mu0[0], m0b = mu0[1], m1a = mu1[0], m1b = mu1[1];
  for (int i = w; i < 256; i += 4) {
    const int row = item * 256 + i;
    const int t = row % L;
    const bf16_t* zr = z + (size_t)row * ZC + 1664 + 2 * lane;
    const unsigned c = *(const unsigned*)zr;
    const unsigned pv = (t > 0) ? *(const unsigned*)(zr - ZC) : 0u;
    const unsigned nv = (t < L - 1) ? *(const unsigned*)(zr + ZC) : 0u;
    const float ca = lo2f(c), cb = hi2f(c);
    const float ga = ca + m0a * (lo2f(pv) - ca) + m1a * (lo2f(nv) - ca);
    const float gb = cb + m0b * (hi2f(pv) - cb) + m1b * (hi2f(nv) - cb);
    *(unsigned*)(sg + (size_t)row * 128 + 2 * lane) = pack2(sigmoidf_(ga), sigmoidf_(gb));
  }
}

DI void item_scan(const Params& p, int l, int L, int b, int h, int dir, const bf16_t* __restrict__ z, bf16_t* __restrict__ yout, float* __restrict__ bon, unsigned char* smem) {
  const int tid = otid() & 255, lane = tid & 63, w = tid >> 6, fr = lane & 15, fq = lane >> 4;
  unsigned* ZR = (unsigned*)smem;
  float* VR = (float*)(smem + 11520);
  float* VD = VR + 1024; float* VK = VD + 1024; float* VV = VK + 1024; float* VA = VV + 1024; float* VB = VA + 1024;
  float* YO = VB + 1024;
  float* BO = YO + 1024;
  unsigned char* WT = (unsigned char*)(BO + 16);
  unsigned char* AL = WT + 16 * RS;
  float* MU = (float*)(AL + 16 * RS);
  float* KKC = MU + 640;
  const size_t tok0 = (size_t)b * L;
  const float* mu0 = p.in[8] + (size_t)l * 2 * 1792;
  const float* mu1 = mu0 + 1792;
  const int cA = lane;
  __syncthreads();
  for (int i = tid; i < 640; i += 256) {
    const int s5 = i >> 7, d = (i >> 6) & 1, c = i & 63;
    const int col = (s5 < 3) ? (s5 * 512 + h * 64 + c) : (1536 + (s5 - 3) * 64 + c);
    MU[i] = (d ? mu1 : mu0)[col];
  }
  if (tid < 64) KKC[tid] = p.in[15][(size_t)l * CA + h * 64 + tid];
  const float rkc = p.in[14][((size_t)l * 2 + dir) * CA + h * 64 + cA];
  const int cB = w * 16 + fr;
  const float w0c = p.in[9][((size_t)l * 2 + dir) * CA + h * 64 + cB];
  const float a0c = p.in[11][((size_t)l * 2 + dir) * CA + h * 64 + cB];
  const float kac = p.in[13][((size_t)l * 2 + dir) * CA + h * 64 + cB];
  bf16x8 bw[2], ba[2];
  {
    const float* w2 = p.in[10] + ((size_t)l * 2 + dir) * 64 * CA + h * 64 + cB;
    const float* a2 = p.in[12] + ((size_t)l * 2 + dir) * 64 * CA + h * 64 + cB;
#pragma unroll
    for (int ks = 0; ks < 2; ++ks)
#pragma unroll
      for (int j = 0; j < 8; ++j) {
        bw[ks][j] = (short)f2bf(w2[(size_t)(ks * 32 + fq * 8 + j) * CA]);
        ba[ks][j] = (short)f2bf(a2[(size_t)(ks * 32 + fq * 8 + j) * CA]);
      }
  }
  const int kq = lane & 7, v0 = w * 16 + (lane >> 3) * 2;
  f32x2 S0[4], S1[4];
#pragma unroll
  for (int i = 0; i < 4; ++i) { S0[i] = (f32x2){0.f, 0.f}; S1[i] = (f32x2){0.f, 0.f}; }

  unsigned pf[12], poff[12];
  unsigned vbits = 0u, r0bits = 0u, r17bits = 0u, pf_ok = 0u;
#pragma unroll
  for (int i = 0; i < 12; ++i) {
    const int q = tid + i * 256;
    const int row = q / 160, pr = q - row * 160;
    const int col = (pr < 96) ? ((pr >> 5) * 512 + h * 64 + (pr & 31) * 2) : (1536 + (pr - 96) * 2);
    poff[i] = (q < 2880) ? (unsigned)(row * ZC + col) * 2u : 0u;
    if (q < 2880) vbits |= 1u << i;
    if (row == 0) r0bits |= 1u << i;
    if (row == 17) r17bits |= 1u << i;
  }
  auto prefetch = [&](int tc) {
    const char* zc = (const char*)(z + (tok0 + tc) * ZC) - (size_t)ZC * 2;
    pf_ok = vbits & ~((tc == 0) ? r0bits : 0u) & ~((tc == L - 16) ? r17bits : 0u);
#pragma unroll
    for (int i = 0; i < 12; ++i)
      pf[i] = *(const unsigned*)(zc + (((pf_ok >> i) & 1u) ? poff[i] : (unsigned)(ZC * 2)));
  };
  auto output = [&](int tco) {
    const int tt = tid >> 4, pj = tid & 15;
    const f32x2 ya = *(const f32x2*)(YO + tt * 64 + 2 * pj), yb2 = *(const f32x2*)(YO + tt * 64 + 32 + 2 * pj);
    bf16_t* yp = yout + (tok0 + tco + tt) * CA + h * 64 + 2 * pj;
    *(unsigned*)yp = pack2(ya[0], ya[1]);
    *(unsigned*)(yp + 32) = pack2(yb2[0], yb2[1]);
    if (tid < 16) bon[(tok0 + tco + tid) * 8 + h] = BO[tid];
  };
  const int nch = L / 16;
  prefetch(dir ? L - 16 : 0);
  int tc_prev = 0;
  for (int ci = 0; ci < nch; ++ci) {
    const int tc = dir ? (L - 16 - 16 * ci) : 16 * ci;
#pragma unroll
    for (int i = 0; i < 12; ++i) { const int q = tid + i * 256; if (q < 2880) ZR[q] = ((pf_ok >> i) & 1u) ? pf[i] : 0u; }
    __syncthreads();
    if (ci > 0) output(tc_prev);
    tc_prev = tc;
    if (ci + 1 < nch) prefetch(dir ? (tc - 16) : (tc + 16));
    {
      const int tt = tid >> 4, j = tid & 15, c = 4 * j;
      u32x2 zu[5][3];
      f32x4 mm[5][2];
#pragma unroll
      for (int s5 = 0; s5 < 5; ++s5) {
#pragma unroll
        for (int d3 = 0; d3 < 3; ++d3) zu[s5][d3] = *(const u32x2*)(ZR + (tt + d3) * 160 + s5 * 32 + 2 * j);
        mm[s5][0] = *(const f32x4*)(MU + (s5 * 2) * 64 + c);
        mm[s5][1] = *(const f32x4*)(MU + (s5 * 2 + 1) * 64 + c);
      }
      float zs[5][4];
#pragma unroll
      for (int s5 = 0; s5 < 5; ++s5)
#pragma unroll
        for (int e = 0; e < 4; ++e) {
          const unsigned up = zu[s5][0][e >> 1], uc = zu[s5][1][e >> 1], un = zu[s5][2][e >> 1];
          const float pv = (e & 1) ? hi2f(up) : lo2f(up), cv = (e & 1) ? hi2f(uc) : lo2f(uc), nv = (e & 1) ? hi2f(un) : lo2f(un);
          zs[s5][e] = cv + mm[s5][0][e] * (pv - cv) + mm[s5][1][e] * (nv - cv);
        }
      *(f32x4*)(VR + tt * 64 + c) = (f32x4){zs[0][0], zs[0][1], zs[0][2], zs[0][3]};
      *(f32x4*)(VK + tt * 64 + c) = (f32x4){zs[1][0], zs[1][1], zs[1][2], zs[1][3]};
      *(f32x4*)(VV + tt * 64 + c) = (f32x4){zs[2][0], zs[2][1], zs[2][2], zs[2][3]};
      const f32x4 kc = *(const f32x4*)(KKC + c);
      float kq4[4], th[4];
      float ksum = 0.f;
#pragma unroll
      for (int e = 0; e < 4; ++e) {
        kq4[e] = zs[1][e] * kc[e];
        ksum += kq4[e] * kq4[e];
        th[e] = 1.0f - 2.0f * rcp_(__expf(2.0f * zs[3][e]) + 1.0f);
      }
      *(u32x2*)(WT + tt * RS + c * 2) = (u32x2){pack2(th[0], th[1]), pack2(th[2], th[3])};
      *(u32x2*)(AL + tt * RS + c * 2) = (u32x2){pack2(zs[4][0], zs[4][1]), pack2(zs[4][2], zs[4][3])};
      ksum = row_sum16(ksum);
      const float inv = rcp_(fmaxf(sqrtf(ksum), 1e-12f));
      *(f32x4*)(VA + tt * 64 + c) = (f32x4){kq4[0] * inv, kq4[1] * inv, kq4[2] * inv, kq4[3] * inv};
    }
    __syncthreads();
    {
      f32x4 aw = {0.f, 0.f, 0.f, 0.f}, aa = {0.f, 0.f, 0.f, 0.f};
#pragma unroll
      for (int ks = 0; ks < 2; ++ks) {
        const bf16x8 fw = *(const bf16x8*)(WT + fr * RS + ks * 64 + fq * 16);
        const bf16x8 fa = *(const bf16x8*)(AL + fr * RS + ks * 64 + fq * 16);
        aw = MFMA16(fw, bw[ks], aw);
        aa = MFMA16(fa, ba[ks], aa);
      }
#pragma unroll
      for (int j = 0; j < 4; ++j) {
        const int tt = fq * 4 + j;
        const float x = w0c + aw[j];
        const float e = 0.60653065971263342f * sigmoidf_(x);
        const float dcy = __expf(-e);
        const float a = sigmoidf_(a0c + aa[j]);
        const float k = VK[tt * 64 + cB], kk = VA[tt * 64 + cB];
        VD[tt * 64 + cB] = dcy;
        VK[tt * 64 + cB] = k * (1.0f + (a - 1.0f) * kac);
        VA[tt * 64 + cB] = -kk;
        VB[tt * 64 + cB] = kk * a;
      }
    }
    __syncthreads();
    float pc[4];
#pragma unroll
    for (int i = 0; i < 4; ++i) { const int tt = w * 4 + i; pc[i] = VR[tt * 64 + cA] * VK[tt * 64 + cA] * rkc; }
#pragma unroll
    for (int i = 0; i < 4; ++i) {
      const int tt = w * 4 + i;
      const float s = wave_sum(pc[i]);
      if (lane == 0) BO[tt] = s;
    }
    {
      struct VA_ { f32x4 A0, A1; f32x2 V; };
      auto loada = [&](VA_& q, int off, int voff) {
        q.A0 = *(const f32x4*)(VA + off); q.A1 = *(const f32x4*)(VA + off + 4);
        q.V = *(const f32x2*)(VV + voff);
      };
      auto stepf = [&](const VA_& c, VA_& nx, int off, int voff, int offn, int voffn, bool has_next) {
        const f32x4 D0 = *(const f32x4*)(VD + off), D1 = *(const f32x4*)(VD + off + 4);
        const f32x4 B0 = *(const f32x4*)(VB + off), B1 = *(const f32x4*)(VB + off + 4);
        const f32x4 K0 = *(const f32x4*)(VK + off), K1 = *(const f32x4*)(VK + off + 4);
        const f32x4 R0 = *(const f32x4*)(VR + off), R1 = *(const f32x4*)(VR + off + 4);
        if (has_next) loada(nx, offn, voffn);
        const f32x2 a[4] = {{c.A0[0], c.A0[1]}, {c.A0[2], c.A0[3]}, {c.A1[0], c.A1[1]}, {c.A1[2], c.A1[3]}};
        const f32x2 d[4] = {{D0[0], D0[1]}, {D0[2], D0[3]}, {D1[0], D1[1]}, {D1[2], D1[3]}};
        const f32x2 bb[4] = {{B0[0], B0[1]}, {B0[2], B0[3]}, {B1[0], B1[1]}, {B1[2], B1[3]}};
        const f32x2 kk[4] = {{K0[0], K0[1]}, {K0[2], K0[3]}, {K1[0], K1[1]}, {K1[2], K1[3]}};
        const f32x2 rr[4] = {{R0[0], R0[1]}, {R0[2], R0[3]}, {R1[0], R1[1]}, {R1[2], R1[3]}};
        const f32x2 p0 = (S0[0] * a[0] + S0[1] * a[1]) + (S0[2] * a[2] + S0[3] * a[3]);
        const f32x2 p1 = (S1[0] * a[0] + S1[1] * a[1]) + (S1[2] * a[2] + S1[3] * a[3]);
        const float sa0 = oct_sum(p0[0] + p0[1]);
        const float sa1 = oct_sum(p1[0] + p1[1]);
        f32x2 y0a = {0.f, 0.f}, y0b = {0.f, 0.f}, y1a = {0.f, 0.f}, y1b = {0.f, 0.f};
#pragma unroll
        for (int i = 0; i < 4; ++i) {
          const f32x2 n0 = S0[i] * d[i] + (sa0 * bb[i] + c.V[0] * kk[i]);
          const f32x2 n1 = S1[i] * d[i] + (sa1 * bb[i] + c.V[1] * kk[i]);
          S0[i] = n0; S1[i] = n1;
          if (i & 1) { y0b += n0 * rr[i]; y1b += n1 * rr[i]; } else { y0a += n0 * rr[i]; y1a += n1 * rr[i]; }
        }
        const f32x2 y0 = y0a + y0b, y1 = y1a + y1b;
        float ys0 = y0[0] + y0[1], ys1 = y1[0] + y1[1];
        asm volatile("" : "+v"(ys0));
        asm volatile("" : "+v"(ys1));
        oct_sum_pair(ys0, ys1);
        *(f32x2*)(YO + voff) = (f32x2){ys0, ys1};
      };
      const int dstep = dir ? -64 : 64;
      int off = (dir ? 15 * 64 : 0) + kq * 8, voff = (dir ? 15 * 64 : 0) + v0;
      VA_ X, Y;
      loada(X, off, voff);
#pragma unroll 1
      for (int it2 = 0; it2 < 8; ++it2) {
        stepf(X, Y, off, voff, off + dstep, voff + dstep, true);
        stepf(Y, X, off + dstep, voff + dstep, off + 2 * dstep, voff + 2 * dstep, it2 < 7);
        off += 2 * dstep; voff += 2 * dstep;
      }
    }
  }
  __syncthreads();
  output(tc_prev);
  __syncthreads();
}

template <int MODE>
DI void item_attn(const Params& p, int l, int L, int b, int h, int qi, const bf16_t* __restrict__ z, bf16_t* __restrict__ yo, unsigned char* smem, unsigned char* smc) {
  const int tid = otid() & 255, lane = tid & 63, w = tid >> 6, fr = lane & 15, fq = lane >> 4;
  unsigned char* KV0 = (MODE == 1) ? smc : smem;
  constexpr int NLD = (MODE == 1) ? 1 : 2;
  const int t5 = (MODE == 1) ? (tid + (int)(smem - smc) / 256) : tid;
  const int vkey = (MODE == 1) ? (t5 & 63) : lane, vdc0 = (MODE == 1) ? (t5 >> 6) : 2 * w;
  float* RPB = (float*)(smem + 256 * RS);
  const size_t tok0 = (size_t)b * L;
  const int rows = L / 64;
  const int qcol = (MODE == 0 ? 1792 : 2560) + h * 64, kcol = qcol + 256, vcol = qcol + 512;
  const int ntile = (MODE == 0) ? 8 : rows;
  int rs = 0;
  if (MODE == 0) { rs = qi - 4; rs = rs < 0 ? 0 : (rs > rows - 8 ? rows - 8 : rs); }
  const int qc = w * 16 + fr;
  const size_t qtok = tok0 + (size_t)qi * 64 + qc;
  bf16x8 qf[2];
#pragma unroll
  for (int ks = 0; ks < 2; ++ks) qf[ks] = *(const bf16x8*)(z + qtok * ZC + qcol + ks * 32 + fq * 8);
  float lam = 0.f, lam_init = 0.f;
  if (MODE == 0) {
    __syncthreads();
    const float* rp = p.in[19] + ((size_t)l * 4 + h) * 465;
    for (int i = tid; i < 465; i += 256) RPB[i] = rp[i];
  } else {
    const float* lp = p.in[20] + (size_t)l * 128;
    float v1 = 0.f, v2 = 0.f;
    if (lane < 32) { v1 = lp[lane] * lp[32 + lane]; v2 = lp[64 + lane] * lp[96 + lane]; }
    v1 = wave_sum(v1); v2 = wave_sum(v2);
    lam_init = 0.8f - 0.6f * __expf(-0.3f * (float)l);
    lam = __expf(v1) - __expf(v2) + lam_init;
  }
  u32x4 rk[NLD], rv[NLD];
  auto load_tile = [&](int it) {
    const size_t kt0 = tok0 + (size_t)((MODE == 0) ? (rs + it) : it) * 64;
#pragma unroll
    for (int i = 0; i < NLD; ++i) {
      const int q = t5 + i * 256;
      rk[i] = *(const u32x4*)(z + (kt0 + (q >> 3)) * ZC + kcol + (q & 7) * 8);
      rv[i] = *(const u32x4*)(z + (kt0 + vkey) * ZC + vcol + (vdc0 + i) * 8);
    }
  };
  auto store_tile = [&](int buf) {
    unsigned char* KSw = KV0 + buf * (128 * RS);
    unsigned char* VTw = KSw + 64 * RS;
#pragma unroll
    for (int i = 0; i < NLD; ++i) {
      const int q = t5 + i * 256;
      *(u32x4*)(KSw + (q >> 3) * RS + (q & 7) * 16) = rk[i];
#pragma unroll
      for (int e = 0; e < 8; ++e) {
        const unsigned vwd = rv[i][e >> 1];
        const bf16_t val = (bf16_t)((e & 1) ? (vwd >> 16) : (vwd & 0xffffu));
        *(bf16_t*)(VTw + ((vdc0 + i) * 8 + e) * RS + vkey * 2) = val;
      }
    }
  };
  load_tile(0);
  store_tile(0);
  if (ntile > 1) load_tile(1);
  constexpr int NS = (MODE == 0) ? 1 : 2;
  f32x4 o[NS][4], lacc[NS];
  float mrun[NS];
#pragma unroll
  for (int s = 0; s < NS; ++s) { mrun[s] = -1e30f; lacc[s] = (f32x4){0.f, 0.f, 0.f, 0.f};
#pragma unroll
    for (int dt = 0; dt < 4; ++dt) o[s][dt] = (f32x4){0.f, 0.f, 0.f, 0.f}; }
  const u32x4 ones_u = {0x3F803F80u, 0x3F803F80u, 0x3F803F80u, 0x3F803F80u};
  const bf16x8 ones = __builtin_bit_cast(bf16x8, ones_u);
  const float slope2 = (MODE == 1) ? exp2f(-2.0f * (float)(h + 1)) * LOG2E : 0.f;
  const float sc2 = (MODE == 0) ? 0.125f * LOG2E : 0.17677669529663687f * LOG2E;
  const int qpos = qi * 64 + qc;
  const float dbase = (float)(fq * 4 - qpos);
  int cs = qc - 8; cs = cs < 0 ? 0 : (cs > 48 ? 48 : cs);
  for (int it = 0; it < ntile; ++it) {
    __syncthreads();
    if (it + 1 < ntile) store_tile((it + 1) & 1);
    if (it + 2 < ntile) load_tile(it + 2);
    const unsigned char* KS = KV0 + (it & 1) * (128 * RS);
    const unsigned char* VT = KS + 64 * RS;
    f32x4 s[NS][4];
#pragma unroll
    for (int kt = 0; kt < 4; ++kt) {
      const bf16x8 k0 = *(const bf16x8*)(KS + (kt * 16 + fr) * RS + fq * 16);
      const bf16x8 k1 = *(const bf16x8*)(KS + (kt * 16 + fr) * RS + 64 + fq * 16);
      const f32x4 zf = {0.f, 0.f, 0.f, 0.f};
      if (MODE == 0) { s[0][kt] = MFMA16(k0, qf[0], zf); s[0][kt] = MFMA16(k1, qf[1], s[0][kt]); }
      else { s[0][kt] = MFMA16(k0, qf[0], zf); s[NS - 1][kt] = MFMA16(k1, qf[1], zf); }
    }
    float alpha[NS];
    float mx[NS];
#pragma unroll
    for (int sh = 0; sh < NS; ++sh) mx[sh] = -1e30f;
    if (MODE == 0) {
#pragma unroll
      for (int kt = 0; kt < 4; ++kt)
#pragma unroll
        for (int j = 0; j < 4; ++j) {
          const int kj = kt * 16 + fq * 4 + j;
          const bool valid = (kj >= cs) && (kj < cs + 16);
          int dc = kj - qc + 15; dc = dc < 0 ? 0 : (dc > 30 ? 30 : dc);
          const int dr = rs + it - qi + 7;
          const float t2 = valid ? (s[0][kt][j] * sc2 + RPB[dr * 31 + dc] * LOG2E) : -1e30f;
          s[0][kt][j] = t2;
          mx[0] = fmaxf(mx[0], t2);
        }
    } else {
      const float d0 = dbase + (float)(it * 64);
      if (it != qi) {
        const float ss = (it < qi) ? slope2 : -slope2;
        const float base = ss * d0;
#pragma unroll
        for (int kt = 0; kt < 4; ++kt)
#pragma unroll
          for (int j = 0; j < 4; ++j) {
            const float negad = fmaf(ss, (float)(kt * 16 + j), base);
#pragma unroll
            for (int sh = 0; sh < NS; ++sh) {
              const float t2 = fmaf(s[sh][kt][j], sc2, negad);
              s[sh][kt][j] = t2;
              mx[sh] = fmaxf(mx[sh], t2);
            }
          }
      } else {
#pragma unroll
        for (int kt = 0; kt < 4; ++kt)
#pragma unroll
          for (int j = 0; j < 4; ++j) {
            const float ad = slope2 * fabsf(d0 + (float)(kt * 16 + j));
#pragma unroll
            for (int sh = 0; sh < NS; ++sh) {
              const float t2 = s[sh][kt][j] * sc2 - ad;
              s[sh][kt][j] = t2;
              mx[sh] = fmaxf(mx[sh], t2);
            }
          }
      }
    }
#pragma unroll
    for (int sh = 0; sh < NS; ++sh) {
      float m1 = mx[sh];
      m1 = fq_max(m1);
      const float mn = fmaxf(mrun[sh], m1);
      alpha[sh] = __builtin_amdgcn_exp2f(mrun[sh] - mn);
      mrun[sh] = mn;
#pragma unroll
      for (int kt = 0; kt < 4; ++kt)
#pragma unroll
        for (int j = 0; j < 4; ++j) s[sh][kt][j] = __builtin_amdgcn_exp2f(s[sh][kt][j] - mn);
      lacc[sh] = lacc[sh] * alpha[sh];
#pragma unroll
      for (int dt = 0; dt < 4; ++dt) o[sh][dt] = o[sh][dt] * alpha[sh];
    }
#pragma unroll
    for (int i2 = 0; i2 < 2; ++i2) {
      bf16x8 pfr[NS];
#pragma unroll
      for (int sh = 0; sh < NS; ++sh) {
        const unsigned u0 = pack2(s[sh][2 * i2][0], s[sh][2 * i2][1]), u1 = pack2(s[sh][2 * i2][2], s[sh][2 * i2][3]);
        const unsigned u2 = pack2(s[sh][2 * i2 + 1][0], s[sh][2 * i2 + 1][1]), u3 = pack2(s[sh][2 * i2 + 1][2], s[sh][2 * i2 + 1][3]);
        const u32x4 u = {u0, u1, u2, u3};
        pfr[sh] = __builtin_bit_cast(bf16x8, u);
      }
#pragma unroll
      for (int sh = 0; sh < NS; ++sh) lacc[sh] = MFMA16(ones, pfr[sh], lacc[sh]);
#pragma unroll
      for (int dt = 0; dt < 4; ++dt) {
        const u32x2 va = *(const u32x2*)(VT + (dt * 16 + fr) * RS + (32 * i2 + fq * 4) * 2);
        const u32x2 vb = *(const u32x2*)(VT + (dt * 16 + fr) * RS + (32 * i2 + 16 + fq * 4) * 2);
        const u32x4 vu = {va[0], va[1], vb[0], vb[1]};
        const bf16x8 vf = __builtin_bit_cast(bf16x8, vu);
#pragma unroll
        for (int sh = 0; sh < NS; ++sh) o[sh][dt] = MFMA16(vf, pfr[sh], o[sh][dt]);
      }
    }
  }
  float linv[NS];
#pragma unroll
  for (int sh = 0; sh < NS; ++sh) linv[sh] = rcp_(lacc[sh][0]);
  if (MODE == 0) {
#pragma unroll
    for (int dt = 0; dt < 4; ++dt) {
      const f32x4 r = o[0][dt] * linv[0];
      *(uint2*)(yo + qtok * 256 + h * 64 + dt * 16 + fq * 4) = make_uint2(pack2(r[0], r[1]), pack2(r[2], r[3]));
    }
  } else {
    f32x4 r[4];
    float ss = 0.f;
#pragma unroll
    for (int dt = 0; dt < 4; ++dt) {
      r[dt] = o[0][dt] * linv[0] - lam * (o[NS - 1][dt] * linv[NS - 1]);
      ss += r[dt][0] * r[dt][0] + r[dt][1] * r[dt][1] + r[dt][2] * r[dt][2] + r[dt][3] * r[dt][3];
    }
    ss = fq_sum(ss);
    const float rn = rsqrtf(ss * (1.0f / 64.0f) + 1e-5f) * (1.0f - lam_init);
    const float* sg = p.in[21] + (size_t)l * 64;
#pragma unroll
    for (int dt = 0; dt < 4; ++dt) {
      const f32x4 g = *(const f32x4*)(sg + dt * 16 + fq * 4);
      const f32x4 q = r[dt] * rn * g;
      *(uint2*)(yo + qtok * 256 + h * 64 + dt * 16 + fq * 4) = make_uint2(pack2(q[0], q[1]), pack2(q[2], q[3]));
    }
  }
}

DI void phase_mixers(const Params& p, int l, int half, unsigned* counter, unsigned char* smem) {
  const int L = half ? 2048 : 4096, nseq = HT / L, rows = L / 64;
  const bf16_t* z = (const bf16_t*)(p.ws + WS_Z);
  bf16_t* yf = (bf16_t*)(p.ws + WS_YF);
  bf16_t* yb = (bf16_t*)(p.ws + WS_YB);
  bf16_t* yn = (bf16_t*)(p.ws + WS_YN);
  bf16_t* yd = (bf16_t*)(p.ws + WS_YD);
  bf16_t* sg = (bf16_t*)(p.ws + WS_SG);
  float* bon = (float*)(p.ws + WS_BON);
  const int n_scan = nseq * 16, n_diff = nseq * 4 * rows, n_na = nseq * rows * 4, n_sg = HT / 256;
  const int total = n_scan + n_diff + n_na + n_sg;
  const int hf = __builtin_amdgcn_readfirstlane(otid() >> 8);
  unsigned char* sm = smem + hf * 65536;
  __shared__ int s_item;
  for (;;) {
    __syncthreads();
    if (threadIdx.x == 0) s_item = (int)atomicAdd(counter, 1u);
    __syncthreads();
    int it = 2 * s_item + hf;
    if (it >= total) break;
    if (it < n_scan) {
      const int dir = it & 1, h = (it >> 1) & 7, b = it >> 4;
      item_scan(p, l, L, b, h, dir, z, dir ? yb : yf, bon + (size_t)dir * HT * 8, sm);
      continue;
    }
    it -= n_scan;
    if (it < n_diff) {
      const int qb = it % rows, h = (it / rows) & 3, b = it / (rows * 4);
      item_attn<1>(p, l, L, b, h, qb, z, yd, sm, smem);
      continue;
    }
    it -= n_diff;
    if (it < n_na) {
      const int r = it % rows, h = (it / rows) & 3, b = it / (rows * 4);
      item_attn<0>(p, l, L, b, h, r, z, yn, sm, smem);
      continue;
    }
    it -= n_na;
    item_sg(p, l, L, it, z, sg);
  }
}

#define XB_TMO      128
#define XB_XCNT(j)  (256  + 64 * (j))
#define XB_XSUB(j)  (1280 + 64 * (j))
#define XB_XGEN(j)  (2304 + 64 * (j))
#define XB_TOP      3328
#define XB_TOPGEN   3392
#define XB_SPIN_CAP (1u << 18)
#define LAS __attribute__((address_space(3)))
DI unsigned xb_ld(unsigned* p)              { return __hip_atomic_load(p, __ATOMIC_RELAXED, __HIP_MEMORY_SCOPE_AGENT); }
DI unsigned xb_add(unsigned* p, unsigned v) { return __hip_atomic_fetch_add(p, v, __ATOMIC_RELAXED, __HIP_MEMORY_SCOPE_AGENT); }
DI unsigned xb_xcc_id() { return (unsigned)__builtin_amdgcn_s_getreg((3 << 11) | 20) & 0xFu; }
#define XB_SPIN(cond, bar) do { unsigned _sp = 0; while (cond) { __builtin_amdgcn_s_sleep(1); \
    if ((++_sp & 255u) == 0u) { if (xb_ld(&(bar)[XB_TMO])) break; if (_sp > XB_SPIN_CAP) { atomicAdd(&(bar)[XB_TMO], 1u); break; } } } } while (0)
struct XcdBarrier { unsigned* bar; unsigned x; volatile LAS unsigned* st; };
DI XcdBarrier xcd_barrier_post(unsigned* bar, volatile LAS unsigned* st) {
  XcdBarrier b; b.bar = bar; b.x = xb_xcc_id(); b.st = st;
  if (threadIdx.x == 0) (void)xb_add(&bar[XB_XCNT(b.x)], 1u);
  return b;
}
DI void xcd_barrier_complete(unsigned* bar, unsigned x, unsigned& nloc, unsigned& nx) {
  const unsigned G = gridDim.x * gridDim.y * gridDim.z;
  unsigned sum, cnt, mine, sp = 0u;
  for (;;) {
    sum = 0u; cnt = 0u; mine = 0u;
#pragma unroll
    for (unsigned j = 0; j < 16; ++j) { const unsigned c = xb_ld(&bar[XB_XCNT(j)]); sum += c; cnt += (c > 0u) ? 1u : 0u; mine = (j == x) ? c : mine; }
    if (sum == G) break;
    __builtin_amdgcn_s_sleep(1);
    if ((++sp & 255u) == 0u) { if (xb_ld(&bar[XB_TMO])) break; if (sp > XB_SPIN_CAP) { atomicAdd(&bar[XB_TMO], 1u); break; } }
  }
  nloc = mine > 0u ? mine : 1u; nx = cnt > 0u ? cnt : 1u;
}
DI void xcd_barrier(const XcdBarrier& b) {
  asm volatile("s_waitcnt vmcnt(0)" ::: "memory");
  __syncthreads();
  if (threadIdx.x == 0) {
    unsigned* bar = b.bar;
    __builtin_amdgcn_s_waitcnt(0);
    unsigned nloc = b.st[0], nx = b.st[1];
    if (nloc == 0u) { xcd_barrier_complete(bar, b.x, nloc, nx); b.st[0] = nloc; b.st[1] = nx; }
    const unsigned old = xb_add(&bar[XB_XSUB(b.x)], 1u);
    const unsigned gen = old / nloc;
    if (old + 1u == (gen + 1u) * nloc) {
      __builtin_amdgcn_fence(__ATOMIC_RELEASE, "agent");
      asm volatile("s_waitcnt vmcnt(0)" ::: "memory");
      const unsigned og = xb_add(&bar[XB_TOP], 1u);
      const unsigned tg = og / nx;
      if (og + 1u == (tg + 1u) * nx) xb_add(&bar[XB_TOPGEN], 1u);
      else XB_SPIN(xb_ld(&bar[XB_TOPGEN]) == tg, bar);
      __builtin_amdgcn_fence(__ATOMIC_ACQUIRE, "agent");
      xb_add(&bar[XB_XGEN(b.x)], 1u);
      asm volatile("s_waitcnt vmcnt(0)" ::: "memory");
    } else {
      XB_SPIN(xb_ld(&bar[XB_XGEN(b.x)]) == gen, bar);
      __builtin_amdgcn_fence(__ATOMIC_ACQUIRE, "agent");
      asm volatile("s_waitcnt vmcnt(0)" ::: "memory");
    }
  }
  __syncthreads();
}

__global__ void __launch_bounds__(512, 2) fwd_megakernel(Params p) {
  cg::grid_group grid = cg::this_grid();
  __shared__ __attribute__((aligned(16))) unsigned char smem[131072];
  bf16_t* W = (bf16_t*)(p.ws + WS_W);
  bf16_t* xn = (bf16_t*)(p.ws + WS_XN);
  bf16_t* hid = (bf16_t*)(p.ws + WS_HID);
  bf16_t* z = (bf16_t*)(p.ws + WS_Z);
  bf16_t* mo = (bf16_t*)(p.ws + WS_M);
  unsigned* ctl = (unsigned*)(p.ws + WS_CTL);
  __shared__ uint4 xb_words;
  if (threadIdx.x == 0) xb_words = make_uint4(0u, 0u, 0u, 0u);
  __syncthreads();
  const XcdBarrier xb = xcd_barrier_post((unsigned*)(p.ws + WS_BAR), (volatile LAS unsigned*)&xb_words);

  phase_convert(p, smem);
  grid.sync();
  for (int half = 0; half < 2; ++half) {
    const float* xin = p.in[half];
    float* x = p.out + (size_t)half * HT * D;
    const int L = half ? 2048 : 4096;
    for (int l = 0; l < NLAYER; ++l) {
      const bf16_t* Wl = W + (size_t)l * W_LAYER;
      const float* xsrc = (l == 0) ? xin : x;
      phase_norm(xsrc, p.in[2] + (size_t)l * D, xn, nullptr);
      xcd_barrier(xb);
      phase_ffn_up(xn, Wl + W_GU, hid, smem);
      xcd_barrier(xb);
      phase_gemm_resid(hid, DFF, Wl + W_WD, xsrc, x, 0.5f, smem);
      xcd_barrier(xb);
      phase_norm(x, p.in[6] + (size_t)l * D, xn, nullptr);
      xcd_barrier(xb);
      phase_proj(xn, Wl + W_IN, z, smem);
      xcd_barrier(xb);
      phase_mixers(p, l, half, ctl + (half * NLAYER + l) * 16, smem);
      xcd_barrier(xb);
      phase_ya(p, l, L, (const bf16_t*)(p.ws + WS_SG), Wl + W_G2, z, (bf16_t*)(p.ws + WS_YF), (const bf16_t*)(p.ws + WS_YB), (const float*)(p.ws + WS_BON), smem);
      xcd_barrier(xb);
      phase_merge(xn, Wl, (const bf16_t*)(p.ws + WS_YF), (const bf16_t*)(p.ws + WS_YN), (const bf16_t*)(p.ws + WS_YD), mo, smem);
      xcd_barrier(xb);
      phase_gemm_resid(mo, D, Wl + W_OUT, x, x, 1.0f, smem);
      xcd_barrier(xb);
      phase_norm(x, p.in[26] + (size_t)l * D, xn, nullptr);
      xcd_barrier(xb);
      phase_ffn_up(xn, Wl + W_GU2, hid, smem);
      xcd_barrier(xb);
      phase_gemm_resid(hid, DFF, Wl + W_WD2, x, x, 0.5f, smem);
      xcd_barrier(xb);
    }
    phase_norm(x, p.in[30], nullptr, x);
    xcd_barrier(xb);
  }
}

extern "C" void kernel_launch(void* const* d_in, const int* in_sizes, int n_in, void* d_out, int out_size, void* d_ws, size_t ws_size, hipStream_t stream) {
  static int grid_blocks = 0;
  if (!grid_blocks) {
    int dev = 0, cus = 0, per_cu = 0;
    (void)hipGetDevice(&dev);
    (void)hipDeviceGetAttribute(&cus, hipDeviceAttributeMultiprocessorCount, dev);
    (void)hipOccupancyMaxActiveBlocksPerMultiprocessor(&per_cu, fwd_megakernel, 512, 0);
    if (per_cu < 1) per_cu = 1;
    if (per_cu > 1) per_cu = 1;
    grid_blocks = cus * per_cu;
    if (ws_size < WS_END) fprintf(stderr, "kernel_launch: workspace too small: need %zu have %zu\n", (size_t)WS_END, ws_size);
  }
  (void)hipMemsetAsync((char*)d_ws + WS_CTL, 0, WS_CTL_BYTES, stream);
  Params p{};
  for (int i = 0; i < 31; ++i) p.in[i] = (const float*)d_in[i];
  p.out = (float*)d_out;
  p.ws = (unsigned char*)d_ws;
  void* args[] = {&p};
  hipError_t e = hipLaunchCooperativeKernel((void*)fwd_megakernel, dim3(grid_blocks), dim3(512), args, 0, stream);
  if (e != hipSuccess) fprintf(stderr, "cooperative launch failed: %s (grid %d)\n", hipGetErrorString(e), grid_blocks);
}
```

```cpp
#include <hip/hip_runtime.h>
#include <hip/hip_cooperative_groups.h>
#include <cstdio>
#include <cstdint>
namespace cg = cooperative_groups;

typedef unsigned short bf16_t;
typedef short bf16x8 __attribute__((ext_vector_type(8)));
typedef short s16x4 __attribute__((ext_vector_type(4)));
typedef float f32x4 __attribute__((ext_vector_type(4)));
typedef float f32x2 __attribute__((ext_vector_type(2)));
typedef unsigned u32x4 __attribute__((ext_vector_type(4)));
typedef unsigned u32x2 __attribute__((ext_vector_type(2)));
#define DI __device__ __forceinline__
#define MFMA16(a, b, c) __builtin_amdgcn_mfma_f32_16x16x32_bf16((a), (b), (c), 0, 0, 0)

constexpr int D = 1024, DFF = 2816, HT = 65536  , NLAYER = 2;
constexpr int ZC = 3328;
constexpr int INC = 6400;
constexpr int CA = 512;
constexpr float LOG2E = 1.4426950408889634f;

constexpr size_t WS_CTL = 0;
constexpr size_t WS_BAR = 4096;
constexpr size_t WS_CTL_BYTES = 32768;
constexpr size_t WS_W = WS_CTL_BYTES;
constexpr size_t W_GU = 0;
constexpr size_t W_WD = W_GU + (size_t)2 * DFF * D;
constexpr size_t W_GU2 = W_WD + (size_t)D * DFF;
constexpr size_t W_WD2 = W_GU2 + (size_t)2 * DFF * D;
constexpr size_t W_IN = W_WD2 + (size_t)D * DFF;
constexpr size_t W_PA = W_IN + (size_t)INC * D;
constexpr size_t W_PB = W_PA + (size_t)D * 512;
constexpr size_t W_PC = W_PB + (size_t)D * 256;
constexpr size_t W_OUT = W_PC + (size_t)D * 256;
constexpr size_t W_G2 = W_OUT + (size_t)D * D;
constexpr size_t W_LAYER = W_G2 + (size_t)512 * 128;
constexpr size_t WS_XN = WS_W + 2 * W_LAYER * 2;
constexpr size_t WS_R = WS_XN + (size_t)HT * D * 2;
constexpr size_t WS_HID = WS_R;
constexpr size_t WS_Z = WS_R;
constexpr size_t WS_M = WS_R;
constexpr size_t WS_YF = WS_Z + (size_t)HT * ZC * 2;
constexpr size_t WS_YB = WS_YF + (size_t)HT * 512 * 2;
constexpr size_t WS_YN = WS_YB + (size_t)HT * 512 * 2;
constexpr size_t WS_YD = WS_YN + (size_t)HT * 256 * 2;
constexpr size_t WS_SG = WS_YD + (size_t)HT * 256 * 2;
constexpr size_t WS_BON = WS_SG + (size_t)HT * 128 * 2;
constexpr size_t WS_END = WS_BON + (size_t)2 * HT * 8 * 4;

struct Params {
  const float* in[31];
  float* out;
  unsigned char* ws;
};

typedef __bf16 bf16x2_t __attribute__((ext_vector_type(2)));
DI unsigned pack2(float lo, float hi) { const f32x2 v = {lo, hi}; const bf16x2_t b = __builtin_convertvector(v, bf16x2_t); return __builtin_bit_cast(unsigned, b); }
DI bf16_t f2bf(float x) { return (bf16_t)(pack2(x, x) & 0xffffu); }
DI float bf2f(bf16_t h) { return __uint_as_float(((unsigned)h) << 16); }
DI float lo2f(unsigned u) { return __uint_as_float(u << 16); }
DI float hi2f(unsigned u) { return __uint_as_float(u & 0xffff0000u); }
DI float xor16_sum(float v) { const auto r = __builtin_amdgcn_permlane16_swap(__float_as_uint(v), __float_as_uint(v), false, false); return __uint_as_float(r[0]) + __uint_as_float(r[1]); }
DI float xor32_sum(float v) { const auto r = __builtin_amdgcn_permlane32_swap(__float_as_uint(v), __float_as_uint(v), false, false); return __uint_as_float(r[0]) + __uint_as_float(r[1]); }
DI float xor16_max(float v) { const auto r = __builtin_amdgcn_permlane16_swap(__float_as_uint(v), __float_as_uint(v), false, false); return fmaxf(__uint_as_float(r[0]), __uint_as_float(r[1])); }
DI float xor32_max(float v) { const auto r = __builtin_amdgcn_permlane32_swap(__float_as_uint(v), __float_as_uint(v), false, false); return fmaxf(__uint_as_float(r[0]), __uint_as_float(r[1])); }
DI float fq_sum(float v) { return xor32_sum(xor16_sum(v)); }
DI float fq_max(float v) { return xor32_max(xor16_max(v)); }
DI float quad_sum(float v) {
  int t = __builtin_amdgcn_update_dpp(0, __float_as_int(v), 0xB1, 0xF, 0xF, true);
  v += __int_as_float(t);
  t = __builtin_amdgcn_update_dpp(0, __float_as_int(v), 0x4E, 0xF, 0xF, true);
  v += __int_as_float(t);
  return v;
}
DI float oct_sum(float v) {
  v = quad_sum(v);
  const int t = __builtin_amdgcn_update_dpp(0, __float_as_int(v), 0x141, 0xF, 0xF, true);
  return v + __int_as_float(t);
}
DI float row_sum16(float v) {
  v = oct_sum(v);
  const int t = __builtin_amdgcn_update_dpp(0, __float_as_int(v), 0x140, 0xF, 0xF, true);
  return v + __int_as_float(t);
}
DI float wave_sum(float v) { return fq_sum(row_sum16(v)); }
DI void oct_sum_pair(float& a, float& b) {
#define OSP_STAGE(ctrl) { const int ta = __builtin_amdgcn_update_dpp(0, __float_as_int(a), ctrl, 0xF, 0xF, true); const int tb = __builtin_amdgcn_update_dpp(0, __float_as_int(b), ctrl, 0xF, 0xF, true); \
    a += __int_as_float(ta); b += __int_as_float(tb); asm volatile("" : "+v"(a)); asm volatile("" : "+v"(b)); }
  OSP_STAGE(0xB1) OSP_STAGE(0x4E) OSP_STAGE(0x141)
#undef OSP_STAGE
}
DI int otid() { int t = threadIdx.x; asm volatile("" : "+v"(t)); return t; }
DI float rcp_(float x) { return __builtin_amdgcn_rcpf(x); }
DI float sigmoidf_(float x) { return rcp_(1.0f + __expf(-x)); }

DI void convert_job(const float* __restrict__ src, int K, int N, bf16_t* __restrict__ dst, int mode, float* tile  ) {
  const int tid = otid();
  const int ntk = K / 64, ntn = N / 64, nt = ntk * ntn;
  for (int t = blockIdx.x; t < nt; t += gridDim.x) {
    const int tk = t / ntn, tn = t % ntn;
    const int k0 = tk * 64, n0 = tn * 64;
    __syncthreads();
#pragma unroll
    for (int i = 0; i < 8; ++i) {
      const int kk = (tid >> 6) + i * 8, nn = tid & 63;
      tile[kk * 65 + nn] = src[(size_t)(k0 + kk) * N + n0 + nn];
    }
    __syncthreads();
    const int nn = tid >> 3, kc = (tid & 7) * 8;
    const int n = n0 + nn;
    int row = n;
    if (mode == 1) row = (n >> 5) * 64 + (n & 31);
    else if (mode == 2) row = (n >> 5) * 64 + 32 + (n & 31);
    u32x4 pk;
#pragma unroll
    for (int i = 0; i < 4; ++i) pk[i] = pack2(tile[(kc + 2 * i) * 65 + nn], tile[(kc + 2 * i + 1) * 65 + nn]);
    *(u32x4*)(dst + (size_t)row * K + k0 + kc) = pk;
  }
}

DI void phase_convert(const Params& p, unsigned char* smem) {
  float* tile = (float*)smem;
  bf16_t* W = (bf16_t*)(p.ws + WS_W);
  for (int l = 0; l < NLAYER; ++l) {
    bf16_t* Wl = W + (size_t)l * W_LAYER;
    convert_job(p.in[3] + (size_t)l * D * DFF, D, DFF, Wl + W_GU, 1, tile);
    convert_job(p.in[4] + (size_t)l * D * DFF, D, DFF, Wl + W_GU, 2, tile);
    convert_job(p.in[5] + (size_t)l * DFF * D, DFF, D, Wl + W_WD, 0, tile);
    convert_job(p.in[27] + (size_t)l * D * DFF, D, DFF, Wl + W_GU2, 1, tile);
    convert_job(p.in[28] + (size_t)l * D * DFF, D, DFF, Wl + W_GU2, 2, tile);
    convert_job(p.in[29] + (size_t)l * DFF * D, DFF, D, Wl + W_WD2, 0, tile);
    convert_job(p.in[7] + (size_t)l * D * INC, D, INC, Wl + W_IN, 0, tile);
    convert_job(p.in[22] + (size_t)l * 512 * D, 512, D, Wl + W_PA, 0, tile);
    convert_job(p.in[23] + (size_t)l * 256 * D, 256, D, Wl + W_PB, 0, tile);
    convert_job(p.in[24] + (size_t)l * 256 * D, 256, D, Wl + W_PC, 0, tile);
    convert_job(p.in[25] + (size_t)l * D * D, D, D, Wl + W_OUT, 0, tile);
    convert_job(p.in[16] + (size_t)l * 128 * 512, 128, 512, Wl + W_G2, 0, tile);
  }
}

DI void phase_norm(const float* __restrict__ src, const float* __restrict__ gam, bf16_t* __restrict__ xn, float* __restrict__ fout) {
  const int tid_ = otid(), lane = tid_ & 63, w = tid_ >> 6;
  f32x4 g[4];
#pragma unroll
  for (int i = 0; i < 4; ++i) g[i] = *(const f32x4*)(gam + i * 256 + lane * 4);
  const int stride = gridDim.x * 8;
  auto ld = [&](f32x4 (&v)[4], int row) {
    if (row < HT) {
#pragma unroll
      for (int i = 0; i < 4; ++i) v[i] = *(const f32x4*)(src + (size_t)row * D + i * 256 + lane * 4);
    }
  };
  auto proc = [&](const f32x4 (&v)[4], int row) {
    float ss = 0.f;
#pragma unroll
    for (int i = 0; i < 4; ++i) ss += (v[i][0] * v[i][0] + v[i][1] * v[i][1]) + (v[i][2] * v[i][2] + v[i][3] * v[i][3]);
    ss = wave_sum(ss);
    const float rs = rsqrtf(ss * (1.0f / 1024.0f) + 1e-6f);
#pragma unroll
    for (int i = 0; i < 4; ++i) {
      const f32x4 y = v[i] * rs * g[i];
      if (fout) *(f32x4*)(fout + (size_t)row * D + i * 256 + lane * 4) = y;
      else *(uint2*)(xn + (size_t)row * D + i * 256 + lane * 4) = make_uint2(pack2(y[0], y[1]), pack2(y[2], y[3]));
    }
  };
  int t = blockIdx.x * 8 + w;
  f32x4 a[4], b[4];
  ld(a, t); ld(b, t + stride);
  for (; t < HT; t += 2 * stride) {
    f32x4 na[4], nb[4];
    ld(na, t + 2 * stride); ld(nb, t + 3 * stride);
    proc(a, t);
    if (t + stride < HT) proc(b, t + stride);
#pragma unroll
    for (int i = 0; i < 4; ++i) { a[i] = na[i]; b[i] = nb[i]; }
  }
}

constexpr int RS = 144;
typedef __attribute__((address_space(3))) unsigned lds_u32;
DI void glds16(const void* g, unsigned char* l) { __builtin_amdgcn_global_load_lds((const unsigned*)g, (lds_u32*)l, 16, 0, 0); }
template <int N> DI void wait_vm() { asm volatile("s_waitcnt vmcnt(%0)" :: "n"(N) : "memory"); }
template <int MT, int NT, int WR, int WC>
DI void gemm_block(const bf16_t* __restrict__ A, int lda, const bf16_t* __restrict__ B, int ldb, int K, f32x4 (&acc)[MT][NT], unsigned char* smem,
                   bool primed = false, const bf16_t* __restrict__ nA = nullptr, int nlda = 0, const bf16_t* __restrict__ nB = nullptr, int nldb = 0) {
  static_assert(WR * WC == 8, "8 waves");
  constexpr int AR = 16 * MT * WR, BR = 16 * NT * WC;
  constexpr int AB = AR * 128, BB = BR * 128, STG = AB + BB;
  constexpr int NA = AR * 8 / 512, NB = BR * 8 / 512;
  const int tid = otid(), lane = tid & 63, w = tid >> 6, wr = w / WC, wc = w % WC, fr = lane & 15, fq = lane >> 4;
  const int srow = tid >> 3, kch = (tid & 7) ^ ((tid >> 4) & 7);
  const unsigned voA = (unsigned)(srow * lda + kch * 8) * 2u, voB = (unsigned)(srow * ldb + kch * 8) * 2u;
  const char* Ab = (const char*)A;
  const char* Bb = (const char*)B;
  const int nk = K >> 6;
  if (!primed) {
#pragma unroll
    for (int i = 0; i < NA; ++i) glds16(Ab + (size_t)i * 128 * lda + voA, smem + (i * 512 + tid) * 16);
#pragma unroll
    for (int i = 0; i < NB; ++i) glds16(Bb + (size_t)i * 128 * ldb + voB, smem + AB + (i * 512 + tid) * 16);
  }
  const int sw = (fr >> 1) & 7;
  const unsigned lds_base = (unsigned)(size_t)(__attribute__((address_space(3))) unsigned char*)smem;
  const unsigned a_row = (wr * 16 * MT + fr) * 128, b_row = AB + (wc * 16 * NT + fr) * 128;
  for (int kt = 0; kt < nk; ++kt) {
    wait_vm<0>();
    __builtin_amdgcn_s_barrier();
    if (kt + 1 < nk) {
      unsigned char* sn = smem + ((kt + 1) & 1) * STG;
      const int ko = (kt + 1) * 64;
#pragma unroll
      for (int i = 0; i < NA; ++i) glds16(Ab + ((size_t)i * 128 * lda + ko * 2) + voA, sn + (i * 512 + tid) * 16);
#pragma unroll
      for (int i = 0; i < NB; ++i) glds16(Bb + ((size_t)i * 128 * ldb + ko * 2) + voB, sn + AB + (i * 512 + tid) * 16);
    } else if (nA) {
      const unsigned nvoA = (unsigned)(srow * nlda + kch * 8) * 2u, nvoB = (unsigned)(srow * nldb + kch * 8) * 2u;
#pragma unroll
      for (int i = 0; i < NA; ++i) glds16((const char*)nA + (size_t)i * 128 * nlda + nvoA, smem + (i * 512 + tid) * 16);
#pragma unroll
      for (int i = 0; i < NB; ++i) glds16((const char*)nB + (size_t)i * 128 * nldb + nvoB, smem + AB + (i * 512 + tid) * 16);
    }
    const unsigned stb = lds_base + (kt & 1) * STG;
#pragma unroll
    for (int ks = 0; ks < 2; ++ks) {
      const unsigned co = ((ks * 4 + fq) ^ sw) * 16;
      const unsigned sa = stb + a_row + co, sb = stb + b_row + co;
      bf16x8 af[4], bfr[NT];
#pragma unroll
      for (int n = 0; n < NT; ++n) asm volatile("ds_read_b128 %0, %1 offset:%2" : "=v"(bfr[n]) : "v"(sb), "n"(n * 2048) : "memory");
#pragma unroll
      for (int mg = 0; mg < MT / 4; ++mg) {
#pragma unroll
        for (int m = 0; m < 4; ++m) asm volatile("ds_read_b128 %0, %1 offset:%2" : "=v"(af[m]) : "v"(sa), "n"((mg * 4 + m) * 2048) : "memory");
        if (mg == 0) {
#pragma unroll
          for (int n = 0; n < NT; ++n) asm volatile("s_waitcnt lgkmcnt(%1)" : "+v"(bfr[n]) : "n"(4 + NT - 1 - n) : "memory");
        }
#pragma unroll
        for (int m = 0; m < 4; ++m) {
          asm volatile("s_waitcnt lgkmcnt(%1)" : "+v"(af[m]) : "n"(3 - m) : "memory");
#pragma unroll
          for (int n = 0; n < NT; ++n) acc[mg * 4 + m][n] = MFMA16(bfr[n], af[m], acc[mg * 4 + m][n]);
        }
      }
    }
  }
  if (!nA) __syncthreads();
}

template <int MT, int NT>
DI void zero_acc(f32x4 (&acc)[MT][NT]) {
#pragma unroll
  for (int m = 0; m < MT; ++m)
#pragma unroll
    for (int n = 0; n < NT; ++n) acc[m][n] = (f32x4){0.f, 0.f, 0.f, 0.f};
}

DI void tile_coords(int id, int nN, int& pm, int& pn) {
  const int band = id / (16 * nN), r = id % (16 * nN);
  pm = band * 16 + (r & 15); pn = r >> 4;
}

DI void phase_ffn_up(const bf16_t* __restrict__ xn, const bf16_t* __restrict__ gu, bf16_t* __restrict__ hid, unsigned char* smem) {
  const int tid_ = otid(), lane = tid_ & 63, w = tid_ >> 6, wr = w >> 2, wc = w & 3, fr = lane & 15, fq = lane >> 4;
  constexpr int nN = 2 * DFF / 256, nM = HT / 256;
  for (int id = blockIdx.x; id < nM * nN; id += gridDim.x) {
    int pm, pn; tile_coords(id, nN, pm, pn);
    f32x4 acc[8][4]; zero_acc(acc);
    {
      const int idn = id + gridDim.x; int pm2 = 0, pn2 = 0; const bool hn = idn < nM * nN; if (hn) tile_coords(idn, nN, pm2, pn2);
      gemm_block<8, 4, 2, 4>(xn + (size_t)pm * 256 * D, D, gu + (size_t)pn * 256 * D, D, D, acc, smem, id != (int)blockIdx.x,
                             hn ? xn + (size_t)pm2 * 256 * D : nullptr, D, gu + (size_t)pn2 * 256 * D, D);
    }
    const int hc0 = (pn * 4 + wc) * 32 + fq * 4;
#pragma unroll
    for (int m = 0; m < 8; ++m) {
      const size_t row = (size_t)pm * 256 + wr * 128 + m * 16 + fr;
#pragma unroll
      for (int n = 0; n < 2; ++n) {
        float h[4];
#pragma unroll
        for (int j = 0; j < 4; ++j) { const float g = acc[m][n][j], u = acc[m][n + 2][j]; h[j] = g * rcp_(1.0f + __expf(-g)) * u; }
        *(uint2*)(hid + row * DFF + hc0 + n * 16) = make_uint2(pack2(h[0], h[1]), pack2(h[2], h[3]));
      }
    }
  }
}

DI void phase_gemm_resid(const bf16_t* __restrict__ A, int K, const bf16_t* __restrict__ Bt, const float* __restrict__ xin, float* __restrict__ xout, float alpha, unsigned char* smem) {
  const int tid_ = otid(), lane = tid_ & 63, w = tid_ >> 6, wr = w >> 2, wc = w & 3, fr = lane & 15, fq = lane >> 4;
  constexpr int nN = D / 256, nM = HT / 256;
  for (int id = blockIdx.x; id < nM * nN; id += gridDim.x) {
    int pm, pn; tile_coords(id, nN, pm, pn);
    f32x4 acc[8][4]; zero_acc(acc);
    {
      const int idn = id + gridDim.x; int pm2 = 0, pn2 = 0; const bool hn = idn < nM * nN; if (hn) tile_coords(idn, nN, pm2, pn2);
      gemm_block<8, 4, 2, 4>(A + (size_t)pm * 256 * K, K, Bt + (size_t)pn * 256 * K, K, K, acc, smem, id != (int)blockIdx.x,
                             hn ? A + (size_t)pm2 * 256 * K : nullptr, K, Bt + (size_t)pn2 * 256 * K, K);
    }
#pragma unroll
    for (int m = 0; m < 8; ++m) {
      const size_t row = (size_t)pm * 256 + wr * 128 + m * 16 + fr;
#pragma unroll
      for (int n = 0; n < 4; ++n) {
        const size_t o = row * D + pn * 256 + wc * 64 + n * 16 + fq * 4;
        const f32x4 x = *(const f32x4*)(xin + o);
        *(f32x4*)(xout + o) = x + alpha * acc[m][n];
      }
    }
  }
}

DI void phase_proj(const bf16_t* __restrict__ xn, const bf16_t* __restrict__ wint, bf16_t* __restrict__ z, unsigned char* smem) {
  const int tid_ = otid(), lane = tid_ & 63, w = tid_ >> 6, wr = w >> 2, wc = w & 3, fr = lane & 15, fq = lane >> 4;
  constexpr int nN = ZC / 256, nM = HT / 256;
  for (int id = blockIdx.x; id < nM * nN; id += gridDim.x) {
    int pm, pn; tile_coords(id, nN, pm, pn);
    f32x4 acc[8][4]; zero_acc(acc);
    {
      const int idn = id + gridDim.x; int pm2 = 0, pn2 = 0; const bool hn = idn < nM * nN; if (hn) tile_coords(idn, nN, pm2, pn2);
      gemm_block<8, 4, 2, 4>(xn + (size_t)pm * 256 * D, D, wint + (size_t)pn * 256 * D, D, D, acc, smem, id != (int)blockIdx.x,
                             hn ? xn + (size_t)pm2 * 256 * D : nullptr, D, wint + (size_t)pn2 * 256 * D, D);
    }
#pragma unroll
    for (int m = 0; m < 8; ++m) {
      const size_t row = (size_t)pm * 256 + wr * 128 + m * 16 + fr;
#pragma unroll
      for (int n = 0; n < 4; ++n) {
        const f32x4 a = acc[m][n];
        *(uint2*)(z + row * ZC + pn * 256 + wc * 64 + n * 16 + fq * 4) = make_uint2(pack2(a[0], a[1]), pack2(a[2], a[3]));
      }
    }
  }
}

DI void phase_ya(const Params& p, int l, int L, const bf16_t* __restrict__ sg, const bf16_t* __restrict__ g2t, const bf16_t* __restrict__ z,
                 bf16_t* __restrict__ yf, const bf16_t* __restrict__ yb, const float* __restrict__ bon, unsigned char* smem) {
  const int tid_ = otid(), lane = tid_ & 63, w = tid_ >> 6, wr = w >> 1, wc = w & 1, fr = lane & 15, fq = lane >> 4;
  constexpr int nN = 4, nM = HT / 256;
  const float* mu0 = p.in[8] + (size_t)l * 2 * 1792;
  const float* mu1 = mu0 + 1792;
  const float* lng = p.in[17] + (size_t)l * CA;
  const float* lnb = p.in[18] + (size_t)l * CA;
  for (int id = blockIdx.x; id < nM * nN; id += gridDim.x) {
    int pm, pn; tile_coords(id, nN, pm, pn);
    f32x4 acc[4][4]; zero_acc(acc);
    {
      const int idn = id + gridDim.x; int pm2 = 0, pn2 = 0; const bool hn = idn < nM * nN; if (hn) tile_coords(idn, nN, pm2, pn2);
      gemm_block<4, 4, 4, 2>(sg + (size_t)pm * 256 * 128, 128, g2t + (size_t)pn * 128 * 128, 128, 128, acc, smem, id != (int)blockIdx.x,
                             hn ? sg + (size_t)pm2 * 256 * 128 : nullptr, 128, g2t + (size_t)pn2 * 128 * 128, 128);
    }
    const int h = pn * 2 + wc;
    const int c0 = h * 64 + fq * 4;
    f32x4 M0[4], M1[4], GG[4], BB[4];
#pragma unroll
    for (int n = 0; n < 4; ++n) {
      M0[n] = *(const f32x4*)(mu0 + 1024 + c0 + n * 16); M1[n] = *(const f32x4*)(mu1 + 1024 + c0 + n * 16);
      GG[n] = *(const f32x4*)(lng + c0 + n * 16); BB[n] = *(const f32x4*)(lnb + c0 + n * 16);
    }
#pragma unroll
    for (int m = 0; m < 4; ++m) {
      const int row = pm * 256 + wr * 64 + m * 16 + fr;
      const int t = row % L;
      const bool hasp = t > 0, hasn = t < L - 1;
      const bf16_t* zr = z + (size_t)row * ZC + 1024 + c0;
      const bf16_t* zp = hasp ? zr - ZC : zr;
      const bf16_t* zn = hasn ? zr + ZC : zr;
      uint2 A[4], B[4], V0[4], VP[4], VN[4];
#pragma unroll
      for (int n = 0; n < 4; ++n) {
        A[n] = *(const uint2*)(yf + (size_t)row * CA + c0 + n * 16);
        B[n] = *(const uint2*)(yb + (size_t)row * CA + c0 + n * 16);
        V0[n] = *(const uint2*)(zr + n * 16);
        VP[n] = *(const uint2*)(zp + n * 16);
        VN[n] = *(const uint2*)(zn + n * 16);
      }
      const float bsum = bon[(size_t)row * 8 + h] + bon[(size_t)HT * 8 + (size_t)row * 8 + h];
      float y[4][4];
      float s = 0.f;
#pragma unroll
      for (int n = 0; n < 4; ++n) {
        y[n][0] = lo2f(A[n].x) + lo2f(B[n].x); y[n][1] = hi2f(A[n].x) + hi2f(B[n].x); y[n][2] = lo2f(A[n].y) + lo2f(B[n].y); y[n][3] = hi2f(A[n].y) + hi2f(B[n].y);
        s += (y[n][0] + y[n][1]) + (y[n][2] + y[n][3]);
      }
      s = fq_sum(s);
      const float mean = s * (1.0f / 64.0f);
      float q = 0.f;
#pragma unroll
      for (int n = 0; n < 4; ++n)
#pragma unroll
        for (int j = 0; j < 4; ++j) { const float d = y[n][j] - mean; q += d * d; }
      q = fq_sum(q);
      const float rstd = rsqrtf(q * (1.0f / 64.0f) + 64e-5f);
#pragma unroll
      for (int n = 0; n < 4; ++n) {
        const float vc[4] = {lo2f(V0[n].x), hi2f(V0[n].x), lo2f(V0[n].y), hi2f(V0[n].y)};
        const float vpp[4] = {hasp ? lo2f(VP[n].x) : 0.f, hasp ? hi2f(VP[n].x) : 0.f, hasp ? lo2f(VP[n].y) : 0.f, hasp ? hi2f(VP[n].y) : 0.f};
        const float vnn[4] = {hasn ? lo2f(VN[n].x) : 0.f, hasn ? hi2f(VN[n].x) : 0.f, hasn ? lo2f(VN[n].y) : 0.f, hasn ? hi2f(VN[n].y) : 0.f};
        float o[4];
#pragma unroll
        for (int j = 0; j < 4; ++j) {
          const float vs = vc[j] + M0[n][j] * (vpp[j] - vc[j]) + M1[n][j] * (vnn[j] - vc[j]);
          o[j] = ((y[n][j] - mean) * rstd * GG[n][j] + BB[n][j] + bsum * vs) * acc[m][n][j];
        }
        *(uint2*)(yf + (size_t)row * CA + c0 + n * 16) = make_uint2(pack2(o[0], o[1]), pack2(o[2], o[3]));
      }
    }
  }
}

DI void phase_merge(const bf16_t* __restrict__ xn, const bf16_t* __restrict__ Wl, const bf16_t* __restrict__ ya, const bf16_t* __restrict__ yn, const bf16_t* __restrict__ yd,
                    bf16_t* __restrict__ mo, unsigned char* smem) {
  const int tid_ = otid(), lane = tid_ & 63, w = tid_ >> 6, wr = w >> 1, wc = w & 1, fr = lane & 15, fq = lane >> 4;
  constexpr int nN = D / 128, nM = HT / 256;
  for (int id = blockIdx.x; id < nM * nN; id += gridDim.x) {
    int pm, pn; tile_coords(id, nN, pm, pn);
    unsigned tot[4][4][2];
#pragma unroll 1
    for (int i = 0; i < 3; ++i) {
      unsigned gp[4][4][2];
      {
        f32x4 ag[4][4]; zero_acc(ag);
        const bf16_t* Yn = (i == 0) ? ya : (i == 1 ? yn : yd);
        const int Kn = (i == 0) ? 512 : 256;
        const bf16_t* Pn = Wl + (i == 0 ? W_PA : (i == 1 ? W_PB : W_PC));
        gemm_block<4, 4, 4, 2>(xn + (size_t)pm * 256 * D, D, Wl + W_IN + (size_t)(ZC + i * 1024 + pn * 128) * D, D, D, ag, smem, !(i == 0 && id == (int)blockIdx.x),
                               Yn + (size_t)pm * 256 * Kn, Kn, Pn + (size_t)pn * 128 * Kn, Kn);
#pragma unroll
        for (int m = 0; m < 4; ++m)
#pragma unroll
          for (int n = 0; n < 4; ++n) {
            gp[m][n][0] = pack2(sigmoidf_(ag[m][n][0]), sigmoidf_(ag[m][n][1]));
            gp[m][n][1] = pack2(sigmoidf_(ag[m][n][2]), sigmoidf_(ag[m][n][3]));
          }
      }
      f32x4 ay[4][4]; zero_acc(ay);
      const bf16_t* Y = (i == 0) ? ya : (i == 1 ? yn : yd);
      const int Ki = (i == 0) ? 512 : 256;
      const bf16_t* P = Wl + (i == 0 ? W_PA : (i == 1 ? W_PB : W_PC));
      {
        const int idn = id + gridDim.x; int pm2 = pm, pn2 = pn, i2 = i + 1; bool hn = true;
        if (i == 2) { i2 = 0; hn = idn < nM * nN; if (hn) tile_coords(idn, nN, pm2, pn2); }
        gemm_block<4, 4, 4, 2>(Y + (size_t)pm * 256 * Ki, Ki, P + (size_t)pn * 128 * Ki, Ki, Ki, ay, smem, true,
                               hn ? xn + (size_t)pm2 * 256 * D : nullptr, D, Wl + W_IN + (size_t)(ZC + i2 * 1024 + pn2 * 128) * D, D);
      }
#pragma unroll
      for (int m = 0; m < 4; ++m)
#pragma unroll
        for (int n = 0; n < 4; ++n) {
          float t0 = ay[m][n][0] * lo2f(gp[m][n][0]), t1 = ay[m][n][1] * hi2f(gp[m][n][0]);
          float t2 = ay[m][n][2] * lo2f(gp[m][n][1]), t3 = ay[m][n][3] * hi2f(gp[m][n][1]);
          if (i > 0) { t0 += lo2f(tot[m][n][0]); t1 += hi2f(tot[m][n][0]); t2 += lo2f(tot[m][n][1]); t3 += hi2f(tot[m][n][1]); }
          tot[m][n][0] = pack2(t0, t1); tot[m][n][1] = pack2(t2, t3);
        }
    }
#pragma unroll
    for (int m = 0; m < 4; ++m) {
      const size_t row = (size_t)pm * 256 + wr * 64 + m * 16 + fr;
#pragma unroll
      for (int n = 0; n < 4; ++n)
        *(uint2*)(mo + row * D + pn * 128 + wc * 64 + n * 16 + fq * 4) = make_uint2(tot[m][n][0], tot[m][n][1]);
    }
  }
}

DI void item_sg(const Params& p, int l, int L, int item, const bf16_t* __restrict__ z, bf16_t* __restrict__ sg) {
  const int tid_ = otid() & 255, lane = tid_ & 63, w = tid_ >> 6;
  const float* mu0 = p.in[8] + (size_t)l * 2 * 1792 + 1664 + 2 * lane;
  const float* mu1 = mu0 + 1792;
  const float m0a = mu0[0], m0b = mu0[1], m1a = mu1[0], m1b = mu1[1];
  for (int i = w; i < 256; i += 4) {
    const int row = item * 256 + i;
    const int t = row % L;
    const bf16_t* zr = z + (size_t)row * ZC + 1664 + 2 * lane;
    const unsigned c = *(const unsigned*)zr;
    const unsigned pv = (t > 0) ? *(const unsigned*)(zr - ZC) : 0u;
    const unsigned nv = (t < L - 1) ? *(const unsigned*)(zr + ZC) : 0u;
    const float ca = lo2f(c), cb = hi2f(c);
    const float ga = ca + m0a * (lo2f(pv) - ca) + m1a * (lo2f(nv) - ca);
    const float gb = cb + m0b * (hi2f(pv) - cb) + m1b * (hi2f(nv) - cb);
    *(unsigned*)(sg + (size_t)row * 128 + 2 * lane) = pack2(sigmoidf_(ga), sigmoidf_(gb));
  }
}

DI void item_scan(const Params& p, int l, int L, int b, int h, int dir, const bf16_t* __restrict__ z, bf16_t* __restrict__ yout, float* __restrict__ bon, unsigned char* smem) {
  const int tid = otid() & 255, lane = tid & 63, w = tid >> 6, fr = lane & 15, fq = lane >> 4;
  unsigned* ZR = (unsigned*)smem;
  float* VR = (float*)(smem + 11520);
  float* VD = VR + 1024; float* VK = VD + 1024; float* VV = VK + 1024; float* VA = VV + 1024; float* VB = VA + 1024;
  float* YO = VB + 1024;
  float* BO = YO + 1024;
  unsigned char* WT = (unsigned char*)(BO + 16);
  unsigned char* AL = WT + 16 * RS;
  float* MU = (float*)(AL + 16 * RS);
  float* KKC = MU + 640;
  const size_t tok0 = (size_t)b * L;
  const float* mu0 = p.in[8] + (size_t)l * 2 * 1792;
  const float* mu1 = mu0 + 1792;
  const int cA = lane;
  __syncthreads();
  for (int i = tid; i < 640; i += 256) {
    const int s5 = i >> 7, d = (i >> 6) & 1, c = i & 63;
    const int col = (s5 < 3) ? (s5 * 512 + h * 64 + c) : (1536 + (s5 - 3) * 64 + c);
    MU[i] = (d ? mu1 : mu0)[col];
  }
  if (tid < 64) KKC[tid] = p.in[15][(size_t)l * CA + h * 64 + tid];
  const float rkc = p.in[14][((size_t)l * 2 + dir) * CA + h * 64 + cA];
  const int cB = w * 16 + fr;
  const float w0c = p.in[9][((size_t)l * 2 + dir) * CA + h * 64 + cB];
  const float a0c = p.in[11][((size_t)l * 2 + dir) * CA + h * 64 + cB];
  const float kac = p.in[13][((size_t)l * 2 + dir) * CA + h * 64 + cB];
  bf16x8 bw[2], ba[2];
  {
    const float* w2 = p.in[10] + ((size_t)l * 2 + dir) * 64 * CA + h * 64 + cB;
    const float* a2 = p.in[12] + ((size_t)l * 2 + dir) * 64 * CA + h * 64 + cB;
#pragma unroll
    for (int ks = 0; ks < 2; ++ks)
#pragma unroll
      for (int j = 0; j < 8; ++j) {
        bw[ks][j] = (short)f2bf(w2[(size_t)(ks * 32 + fq * 8 + j) * CA]);
        ba[ks][j] = (short)f2bf(a2[(size_t)(ks * 32 + fq * 8 + j) * CA]);
      }
  }
  const int kq = lane & 7, v0 = w * 16 + (lane >> 3) * 2;
  f32x2 S0[4], S1[4];
#pragma unroll
  for (int i = 0; i < 4; ++i) { S0[i] = (f32x2){0.f, 0.f}; S1[i] = (f32x2){0.f, 0.f}; }

  unsigned pf[12], poff[12];
  unsigned vbits = 0u, r0bits = 0u, r17bits = 0u, pf_ok = 0u;
#pragma unroll
  for (int i = 0; i < 12; ++i) {
    const int q = tid + i * 256;
    const int row = q / 160, pr = q - row * 160;
    const int col = (pr < 96) ? ((pr >> 5) * 512 + h * 64 + (pr & 31) * 2) : (1536 + (pr - 96) * 2);
    poff[i] = (q < 2880) ? (unsigned)(row * ZC + col) * 2u : 0u;
    if (q < 2880) vbits |= 1u << i;
    if (row == 0) r0bits |= 1u << i;
    if (row == 17) r17bits |= 1u << i;
  }
  auto prefetch = [&](int tc) {
    const char* zc = (const char*)(z + (tok0 + tc) * ZC) - (size_t)ZC * 2;
    pf_ok = vbits & ~((tc == 0) ? r0bits : 0u) & ~((tc == L - 16) ? r17bits : 0u);
#pragma unroll
    for (int i = 0; i < 12; ++i)
      pf[i] = *(const unsigned*)(zc + (((pf_ok >> i) & 1u) ? poff[i] : (unsigned)(ZC * 2)));
  };
  auto output = [&](int tco) {
    const int tt = tid >> 4, pj = tid & 15;
    const f32x2 ya = *(const f32x2*)(YO + tt * 64 + 2 * pj), yb2 = *(const f32x2*)(YO + tt * 64 + 32 + 2 * pj);
    bf16_t* yp = yout + (tok0 + tco + tt) * CA + h * 64 + 2 * pj;
    *(unsigned*)yp = pack2(ya[0], ya[1]);
    *(unsigned*)(yp + 32) = pack2(yb2[0], yb2[1]);
    if (tid < 16) bon[(tok0 + tco + tid) * 8 + h] = BO[tid];
  };
  const int nch = L / 16;
  prefetch(dir ? L - 16 : 0);
  int tc_prev = 0;
  for (int ci = 0; ci < nch; ++ci) {
    const int tc = dir ? (L - 16 - 16 * ci) : 16 * ci;
#pragma unroll
    for (int i = 0; i < 12; ++i) { const int q = tid + i * 256; if (q < 2880) ZR[q] = ((pf_ok >> i) & 1u) ? pf[i] : 0u; }
    __syncthreads();
    if (ci > 0) output(tc_prev);
    tc_prev = tc;
    if (ci + 1 < nch) prefetch(dir ? (tc - 16) : (tc + 16));
    {
      const int tt = tid >> 4, j = tid & 15, c = 4 * j;
      u32x2 zu[5][3];
      f32x4 mm[5][2];
#pragma unroll
      for (int s5 = 0; s5 < 5; ++s5) {
#pragma unroll
        for (int d3 = 0; d3 < 3; ++d3) zu[s5][d3] = *(const u32x2*)(ZR + (tt + d3) * 160 + s5 * 32 + 2 * j);
        mm[s5][0] = *(const f32x4*)(MU + (s5 * 2) * 64 + c);
        mm[s5][1] = *(const f32x4*)(MU + (s5 * 2 + 1) * 64 + c);
      }
      float zs[5][4];
#pragma unroll
      for (int s5 = 0; s5 < 5; ++s5)
#pragma unroll
        for (int e = 0; e < 4; ++e) {
          const unsigned up = zu[s5][0][e >> 1], uc = zu[s5][1][e >> 1], un = zu[s5][2][e >> 1];
          const float pv = (e & 1) ? hi2f(up) : lo2f(up), cv = (e & 1) ? hi2f(uc) : lo2f(uc), nv = (e & 1) ? hi2f(un) : lo2f(un);
          zs[s5][e] = cv + mm[s5][0][e] * (pv - cv) + mm[s5][1][e] * (nv - cv);
        }
      *(f32x4*)(VR + tt * 64 + c) = (f32x4){zs[0][0], zs[0][1], zs[0][2], zs[0][3]};
      *(f32x4*)(VK + tt * 64 + c) = (f32x4){zs[1][0], zs[1][1], zs[1][2], zs[1][3]};
      *(f32x4*)(VV + tt * 64 + c) = (f32x4){zs[2][0], zs[2][1], zs[2][2], zs[2][3]};
      const f32x4 kc = *(const f32x4*)(KKC + c);
      float kq4[4], th[4];
      float ksum = 0.f;
#pragma unroll
      for (int e = 0; e < 4; ++e) {
        kq4[e] = zs[1][e] * kc[e];
        ksum += kq4[e] * kq4[e];
        th[e] = 1.0f - 2.0f * rcp_(__expf(2.0f * zs[3][e]) + 1.0f);
      }
      *(u32x2*)(WT + tt * RS + c * 2) = (u32x2){pack2(th[0], th[1]), pack2(th[2], th[3])};
      *(u32x2*)(AL + tt * RS + c * 2) = (u32x2){pack2(zs[4][0], zs[4][1]), pack2(zs[4][2], zs[4][3])};
      ksum = row_sum16(ksum);
      const float inv = rcp_(fmaxf(sqrtf(ksum), 1e-12f));
      *(f32x4*)(VA + tt * 64 + c) = (f32x4){kq4[0] * inv, kq4[1] * inv, kq4[2] * inv, kq4[3] * inv};
    }
    __syncthreads();
    {
      f32x4 aw = {0.f, 0.f, 0.f, 0.f}, aa = {0.f, 0.f, 0.f, 0.f};
#pragma unroll
      for (int ks = 0; ks < 2; ++ks) {
        const bf16x8 fw = *(const bf16x8*)(WT + fr * RS + ks * 64 + fq * 16);
        const bf16x8 fa = *(const bf16x8*)(AL + fr * RS + ks * 64 + fq * 16);
        aw = MFMA16(fw, bw[ks], aw);
        aa = MFMA16(fa, ba[ks], aa);
      }
#pragma unroll
      for (int j = 0; j < 4; ++j) {
        const int tt = fq * 4 + j;
        const float x = w0c + aw[j];
        const float e = 0.60653065971263342f * sigmoidf_(x);
        const float dcy = __expf(-e);
        const float a = sigmoidf_(a0c + aa[j]);
        const float k = VK[tt * 64 + cB], kk = VA[tt * 64 + cB];
        VD[tt * 64 + cB] = dcy;
        VK[tt * 64 + cB] = k * (1.0f + (a - 1.0f) * kac);
        VA[tt * 64 + cB] = -kk;
        VB[tt * 64 + cB] = kk * a;
      }
    }
    __syncthreads();
    float pc[4];
#pragma unroll
    for (int i = 0; i < 4; ++i) { const int tt = w * 4 + i; pc[i] = VR[tt * 64 + cA] * VK[tt * 64 + cA] * rkc; }
#pragma unroll
    for (int i = 0; i < 4; ++i) {
      const int tt = w * 4 + i;
      const float s = wave_sum(pc[i]);
      if (lane == 0) BO[tt] = s;
    }
    {
      struct VA_ { f32x4 A0, A1; f32x2 V; };
      auto loada = [&](VA_& q, int off, int voff) {
        q.A0 = *(const f32x4*)(VA + off); q.A1 = *(const f32x4*)(VA + off + 4);
        q.V = *(const f32x2*)(VV + voff);
      };
      auto stepf = [&](const VA_& c, VA_& nx, int off, int voff, int offn, int voffn, bool has_next) {
        const f32x4 D0 = *(const f32x4*)(VD + off), D1 = *(const f32x4*)(VD + off + 4);
        const f32x4 B0 = *(const f32x4*)(VB + off), B1 = *(const f32x4*)(VB + off + 4);
        const f32x4 K0 = *(const f32x4*)(VK + off), K1 = *(const f32x4*)(VK + off + 4);
        const f32x4 R0 = *(const f32x4*)(VR + off), R1 = *(const f32x4*)(VR + off + 4);
        if (has_next) loada(nx, offn, voffn);
        const f32x2 a[4] = {{c.A0[0], c.A0[1]}, {c.A0[2], c.A0[3]}, {c.A1[0], c.A1[1]}, {c.A1[2], c.A1[3]}};
        const f32x2 d[4] = {{D0[0], D0[1]}, {D0[2], D0[3]}, {D1[0], D1[1]}, {D1[2], D1[3]}};
        const f32x2 bb[4] = {{B0[0], B0[1]}, {B0[2], B0[3]}, {B1[0], B1[1]}, {B1[2], B1[3]}};
        const f32x2 kk[4] = {{K0[0], K0[1]}, {K0[2], K0[3]}, {K1[0], K1[1]}, {K1[2], K1[3]}};
        const f32x2 rr[4] = {{R0[0], R0[1]}, {R0[2], R0[3]}, {R1[0], R1[1]}, {R1[2], R1[3]}};
        const f32x2 p0 = (S0[0] * a[0] + S0[1] * a[1]) + (S0[2] * a[2] + S0[3] * a[3]);
        const f32x2 p1 = (S1[0] * a[0] + S1[1] * a[1]) + (S1[2] * a[2] + S1[3] * a[3]);
        const float sa0 = oct_sum(p0[0] + p0[1]);
        const float sa1 = oct_sum(p1[0] + p1[1]);
        f32x2 y0, y1;
#pragma unroll
        for (int i = 0; i < 4; ++i) {
          const f32x2 n0 = S0[i] * d[i] + (sa0 * bb[i] + c.V[0] * kk[i]);
          const f32x2 n1 = S1[i] * d[i] + (sa1 * bb[i] + c.V[1] * kk[i]);
          S0[i] = n0; S1[i] = n1;
          if (i == 0) { y0 = n0 * rr[0]; y1 = n1 * rr[0]; } else { y0 += n0 * rr[i]; y1 += n1 * rr[i]; }
        }
        float ys0 = y0[0] + y0[1], ys1 = y1[0] + y1[1];
        asm volatile("" : "+v"(ys0));
        asm volatile("" : "+v"(ys1));
        oct_sum_pair(ys0, ys1);
        *(f32x2*)(YO + voff) = (f32x2){ys0, ys1};
      };
      const int dstep = dir ? -64 : 64;
      int off = (dir ? 15 * 64 : 0) + kq * 8, voff = (dir ? 15 * 64 : 0) + v0;
      VA_ X, Y;
      loada(X, off, voff);
#pragma unroll 1
      for (int it2 = 0; it2 < 8; ++it2) {
        stepf(X, Y, off, voff, off + dstep, voff + dstep, true);
        stepf(Y, X, off + dstep, voff + dstep, off + 2 * dstep, voff + 2 * dstep, it2 < 7);
        off += 2 * dstep; voff += 2 * dstep;
      }
    }
  }
  __syncthreads();
  output(tc_prev);
  __syncthreads();
}

template <int MODE>
DI void item_attn(const Params& p, int l, int L, int b, int h, int qi, const bf16_t* __restrict__ z, bf16_t* __restrict__ yo, unsigned char* smem, unsigned char* smc) {
  const int tid = otid() & 255, lane = tid & 63, w = tid >> 6, fr = lane & 15, fq = lane >> 4;
  unsigned char* KV0 = (MODE == 1) ? smc : smem;
  constexpr int NLD = (MODE == 1) ? 1 : 2;
  const int t5 = (MODE == 1) ? (tid + (int)(smem - smc) / 256) : tid;
  const int vkey = (MODE == 1) ? (t5 & 63) : lane, vdc0 = (MODE == 1) ? (t5 >> 6) : 2 * w;
  float* RPB = (float*)(smem + 256 * RS);
  const size_t tok0 = (size_t)b * L;
  const int rows = L / 64;
  const int qcol = (MODE == 0 ? 1792 : 2560) + h * 64, kcol = qcol + 256, vcol = qcol + 512;
  const int ntile = (MODE == 0) ? 8 : rows;
  int rs = 0;
  if (MODE == 0) { rs = qi - 4; rs = rs < 0 ? 0 : (rs > rows - 8 ? rows - 8 : rs); }
  const int qc = w * 16 + fr;
  const size_t qtok = tok0 + (size_t)qi * 64 + qc;
  bf16x8 qf[2];
#pragma unroll
  for (int ks = 0; ks < 2; ++ks) qf[ks] = *(const bf16x8*)(z + qtok * ZC + qcol + ks * 32 + fq * 8);
  float lam = 0.f, lam_init = 0.f;
  if (MODE == 0) {
    __syncthreads();
    const float* rp = p.in[19] + ((size_t)l * 4 + h) * 465;
    for (int i = tid; i < 465; i += 256) RPB[i] = rp[i] * LOG2E;
  } else {
    const float* lp = p.in[20] + (size_t)l * 128;
    float v1 = 0.f, v2 = 0.f;
    if (lane < 32) { v1 = lp[lane] * lp[32 + lane]; v2 = lp[64 + lane] * lp[96 + lane]; }
    v1 = wave_sum(v1); v2 = wave_sum(v2);
    lam_init = 0.8f - 0.6f * __expf(-0.3f * (float)l);
    lam = __expf(v1) - __expf(v2) + lam_init;
  }
  u32x4 rk[NLD], rv[NLD];
  auto load_tile = [&](int it) {
    const size_t kt0 = tok0 + (size_t)((MODE == 0) ? (rs + it) : it) * 64;
#pragma unroll
    for (int i = 0; i < NLD; ++i) {
      const int q = t5 + i * 256;
      rk[i] = *(const u32x4*)(z + (kt0 + (q >> 3)) * ZC + kcol + (q & 7) * 8);
      rv[i] = *(const u32x4*)(z + (kt0 + vkey) * ZC + vcol + (vdc0 + i) * 8);
    }
  };
  auto store_tile = [&](int buf) {
    unsigned char* KSw = KV0 + buf * (128 * RS);
    unsigned char* VTw = KSw + 64 * RS;
#pragma unroll
    for (int i = 0; i < NLD; ++i) {
      const int q = t5 + i * 256;
      *(u32x4*)(KSw + (q >> 3) * RS + (q & 7) * 16) = rk[i];
#pragma unroll
      for (int e = 0; e < 8; ++e) {
        const unsigned vwd = rv[i][e >> 1];
        const bf16_t val = (bf16_t)((e & 1) ? (vwd >> 16) : (vwd & 0xffffu));
        *(bf16_t*)(VTw + ((vdc0 + i) * 8 + e) * RS + vkey * 2) = val;
      }
    }
  };
  load_tile(0);
  store_tile(0);
  if (ntile > 1) load_tile(1);
  constexpr int NS = (MODE == 0) ? 1 : 2;
  f32x4 o[NS][4], lacc[NS];
  float mrun[NS];
#pragma unroll
  for (int s = 0; s < NS; ++s) { mrun[s] = -1e30f; lacc[s] = (f32x4){0.f, 0.f, 0.f, 0.f};
#pragma unroll
    for (int dt = 0; dt < 4; ++dt) o[s][dt] = (f32x4){0.f, 0.f, 0.f, 0.f}; }
  const u32x4 ones_u = {0x3F803F80u, 0x3F803F80u, 0x3F803F80u, 0x3F803F80u};
  const bf16x8 ones = __builtin_bit_cast(bf16x8, ones_u);
  const float slope2 = (MODE == 1) ? exp2f(-2.0f * (float)(h + 1)) * LOG2E : 0.f;
  const float sc2 = (MODE == 0) ? 0.125f * LOG2E : 0.17677669529663687f * LOG2E;
  const int qpos = qi * 64 + qc;
  const float dbase = (float)(fq * 4 - qpos);
  int cs = qc - 8; cs = cs < 0 ? 0 : (cs > 48 ? 48 : cs);
  float na_madd[4][4]; int na_dc[4][4];
  if (MODE == 0) {
#pragma unroll
    for (int kt = 0; kt < 4; ++kt)
#pragma unroll
      for (int j = 0; j < 4; ++j) {
        const int kj = kt * 16 + fq * 4 + j;
        const bool valid = (kj >= cs) && (kj < cs + 16);
        int dc = kj - qc + 15; dc = dc < 0 ? 0 : (dc > 30 ? 30 : dc);
        na_madd[kt][j] = valid ? 0.f : -1e30f;
        na_dc[kt][j] = dc;
      }
  }
  for (int it = 0; it < ntile; ++it) {
    __syncthreads();
    if (it + 1 < ntile) store_tile((it + 1) & 1);
    if (it + 2 < ntile) load_tile(it + 2);
    const unsigned char* KS = KV0 + (it & 1) * (128 * RS);
    const unsigned char* VT = KS + 64 * RS;
    f32x4 s[NS][4];
#pragma unroll
    for (int kt = 0; kt < 4; ++kt) {
      const bf16x8 k0 = *(const bf16x8*)(KS + (kt * 16 + fr) * RS + fq * 16);
      const bf16x8 k1 = *(const bf16x8*)(KS + (kt * 16 + fr) * RS + 64 + fq * 16);
      const f32x4 zf = {0.f, 0.f, 0.f, 0.f};
      if (MODE == 0) { s[0][kt] = MFMA16(k0, qf[0], zf); s[0][kt] = MFMA16(k1, qf[1], s[0][kt]); }
      else { s[0][kt] = MFMA16(k0, qf[0], zf); s[NS - 1][kt] = MFMA16(k1, qf[1], zf); }
    }
    float alpha[NS];
    float mx[NS];
#pragma unroll
    for (int sh = 0; sh < NS; ++sh) mx[sh] = -1e30f;
    if (MODE == 0) {
      const float* rpr = RPB + (rs + it - qi + 7) * 31;
#pragma unroll
      for (int kt = 0; kt < 4; ++kt)
#pragma unroll
        for (int j = 0; j < 4; ++j) {
          const float t2 = fmaf(s[0][kt][j], sc2, rpr[na_dc[kt][j]]) + na_madd[kt][j];
          s[0][kt][j] = t2;
          mx[0] = fmaxf(mx[0], t2);
        }
    } else {
      const float d0 = dbase + (float)(it * 64);
      if (it != qi) {
        const float ss = (it < qi) ? slope2 : -slope2;
        const float base = ss * d0;
#pragma unroll
        for (int kt = 0; kt < 4; ++kt)
#pragma unroll
          for (int j = 0; j < 4; ++j) {
            const float negad = fmaf(ss, (float)(kt * 16 + j), base);
#pragma unroll
            for (int sh = 0; sh < NS; ++sh) {
              const float t2 = fmaf(s[sh][kt][j], sc2, negad);
              s[sh][kt][j] = t2;
              mx[sh] = fmaxf(mx[sh], t2);
            }
          }
      } else {
#pragma unroll
        for (int kt = 0; kt < 4; ++kt)
#pragma unroll
          for (int j = 0; j < 4; ++j) {
            const float ad = slope2 * fabsf(d0 + (float)(kt * 16 + j));
#pragma unroll
            for (int sh = 0; sh < NS; ++sh) {
              const float t2 = s[sh][kt][j] * sc2 - ad;
              s[sh][kt][j] = t2;
              mx[sh] = fmaxf(mx[sh], t2);
            }
          }
      }
    }
#pragma unroll
    for (int sh = 0; sh < NS; ++sh) {
      float m1 = mx[sh];
      m1 = fq_max(m1);
      const float mn = fmaxf(mrun[sh], m1);
      alpha[sh] = __builtin_amdgcn_exp2f(mrun[sh] - mn);
      mrun[sh] = mn;
#pragma unroll
      for (int kt = 0; kt < 4; ++kt)
#pragma unroll
        for (int j = 0; j < 4; ++j) s[sh][kt][j] = __builtin_amdgcn_exp2f(s[sh][kt][j] - mn);
      lacc[sh] = lacc[sh] * alpha[sh];
#pragma unroll
      for (int dt = 0; dt < 4; ++dt) o[sh][dt] = o[sh][dt] * alpha[sh];
    }
#pragma unroll
    for (int i2 = 0; i2 < 2; ++i2) {
      bf16x8 pfr[NS];
#pragma unroll
      for (int sh = 0; sh < NS; ++sh) {
        const unsigned u0 = pack2(s[sh][2 * i2][0], s[sh][2 * i2][1]), u1 = pack2(s[sh][2 * i2][2], s[sh][2 * i2][3]);
        const unsigned u2 = pack2(s[sh][2 * i2 + 1][0], s[sh][2 * i2 + 1][1]), u3 = pack2(s[sh][2 * i2 + 1][2], s[sh][2 * i2 + 1][3]);
        const u32x4 u = {u0, u1, u2, u3};
        pfr[sh] = __builtin_bit_cast(bf16x8, u);
      }
#pragma unroll
      for (int sh = 0; sh < NS; ++sh) lacc[sh] = MFMA16(ones, pfr[sh], lacc[sh]);
#pragma unroll
      for (int dt = 0; dt < 4; ++dt) {
        const u32x2 va = *(const u32x2*)(VT + (dt * 16 + fr) * RS + (32 * i2 + fq * 4) * 2);
        const u32x2 vb = *(const u32x2*)(VT + (dt * 16 + fr) * RS + (32 * i2 + 16 + fq * 4) * 2);
        const u32x4 vu = {va[0], va[1], vb[0], vb[1]};
        const bf16x8 vf = __builtin_bit_cast(bf16x8, vu);
#pragma unroll
        for (int sh = 0; sh < NS; ++sh) o[sh][dt] = MFMA16(vf, pfr[sh], o[sh][dt]);
      }
    }
  }
  float linv[NS];
#pragma unroll
  for (int sh = 0; sh < NS; ++sh) linv[sh] = rcp_(lacc[sh][0]);
  if (MODE == 0) {
#pragma unroll
    for (int dt = 0; dt < 4; ++dt) {
      const f32x4 r = o[0][dt] * linv[0];
      *(uint2*)(yo + qtok * 256 + h * 64 + dt * 16 + fq * 4) = make_uint2(pack2(r[0], r[1]), pack2(r[2], r[3]));
    }
  } else {
    f32x4 r[4];
    float ss = 0.f;
#pragma unroll
    for (int dt = 0; dt < 4; ++dt) {
      r[dt] = o[0][dt] * linv[0] - lam * (o[NS - 1][dt] * linv[NS - 1]);
      ss += r[dt][0] * r[dt][0] + r[dt][1] * r[dt][1] + r[dt][2] * r[dt][2] + r[dt][3] * r[dt][3];
    }
    ss = fq_sum(ss);
    const float rn = rsqrtf(ss * (1.0f / 64.0f) + 1e-5f) * (1.0f - lam_init);
    const float* sg = p.in[21] + (size_t)l * 64;
#pragma unroll
    for (int dt = 0; dt < 4; ++dt) {
      const f32x4 g = *(const f32x4*)(sg + dt * 16 + fq * 4);
      const f32x4 q = r[dt] * rn * g;
      *(uint2*)(yo + qtok * 256 + h * 64 + dt * 16 + fq * 4) = make_uint2(pack2(q[0], q[1]), pack2(q[2], q[3]));
    }
  }
}

DI void phase_mixers(const Params& p, int l, int half, unsigned* counter, unsigned char* smem) {
  const int L = half ? 2048 : 4096, nseq = HT / L, rows = L / 64;
  const bf16_t* z = (const bf16_t*)(p.ws + WS_Z);
  bf16_t* yf = (bf16_t*)(p.ws + WS_YF);
  bf16_t* yb = (bf16_t*)(p.ws + WS_YB);
  bf16_t* yn = (bf16_t*)(p.ws + WS_YN);
  bf16_t* yd = (bf16_t*)(p.ws + WS_YD);
  bf16_t* sg = (bf16_t*)(p.ws + WS_SG);
  float* bon = (float*)(p.ws + WS_BON);
  const int n_scan = nseq * 16, n_diff = nseq * 4 * rows, n_na = nseq * rows * 4, n_sg = HT / 256;
  const int total = n_scan + n_diff + n_na + n_sg;
  const int hf = __builtin_amdgcn_readfirstlane(otid() >> 8);
  unsigned char* sm = smem + hf * 65536;
  __shared__ int s_item;
  for (;;) {
    __syncthreads();
    if (threadIdx.x == 0) s_item = (int)atomicAdd(counter, 1u);
    __syncthreads();
    int it = 2 * s_item + hf;
    if (it >= total) break;
    if (it < n_scan) {
      const int dir = it & 1, h = (it >> 1) & 7, b = it >> 4;
      item_scan(p, l, L, b, h, dir, z, dir ? yb : yf, bon + (size_t)dir * HT * 8, sm);
      continue;
    }
    it -= n_scan;
    if (it < n_diff) {
      const int qb = it % rows, h = (it / rows) & 3, b = it / (rows * 4);
      item_attn<1>(p, l, L, b, h, qb, z, yd, sm, smem);
      continue;
    }
    it -= n_diff;
    if (it < n_na) {
      const int r = it % rows, h = (it / rows) & 3, b = it / (rows * 4);
      item_attn<0>(p, l, L, b, h, r, z, yn, sm, smem);
      continue;
    }
    it -= n_na;
    item_sg(p, l, L, it, z, sg);
  }
}

#define XB_TMO      128
#define XB_XCNT(j)  (256  + 64 * (j))
#define XB_XSUB(j)  (1280 + 64 * (j))
#define XB_XGEN(j)  (2304 + 64 * (j))
#define XB_TOP      3328
#define XB_TOPGEN   3392
#define XB_SPIN_CAP (1u << 18)
#define LAS __attribute__((address_space(3)))
DI unsigned xb_ld(unsigned* p)              { return __hip_atomic_load(p, __ATOMIC_RELAXED, __HIP_MEMORY_SCOPE_AGENT); }
DI unsigned xb_add(unsigned* p, unsigned v) { return __hip_atomic_fetch_add(p, v, __ATOMIC_RELAXED, __HIP_MEMORY_SCOPE_AGENT); }
DI unsigned xb_xcc_id() { return (unsigned)__builtin_amdgcn_s_getreg((3 << 11) | 20) & 0xFu; }
#define XB_SPIN(cond, bar) do { unsigned _sp = 0; while (cond) { __builtin_amdgcn_s_sleep(1); \
    if ((++_sp & 255u) == 0u) { if (xb_ld(&(bar)[XB_TMO])) break; if (_sp > XB_SPIN_CAP) { atomicAdd(&(bar)[XB_TMO], 1u); break; } } } } while (0)
struct XcdBarrier { unsigned* bar; unsigned x; volatile LAS unsigned* st; };
DI XcdBarrier xcd_barrier_post(unsigned* bar, volatile LAS unsigned* st) {
  XcdBarrier b; b.bar = bar; b.x = xb_xcc_id(); b.st = st;
  if (threadIdx.x == 0) (void)xb_add(&bar[XB_XCNT(b.x)], 1u);
  return b;
}
DI void xcd_barrier_complete(unsigned* bar, unsigned x, unsigned& nloc, unsigned& nx) {
  const unsigned G = gridDim.x * gridDim.y * gridDim.z;
  unsigned sum, cnt, mine, sp = 0u;
  for (;;) {
    sum = 0u; cnt = 0u; mine = 0u;
#pragma unroll
    for (unsigned j = 0; j < 16; ++j) { const unsigned c = xb_ld(&bar[XB_XCNT(j)]); sum += c; cnt += (c > 0u) ? 1u : 0u; mine = (j == x) ? c : mine; }
    if (sum == G) break;
    __builtin_amdgcn_s_sleep(1);
    if ((++sp & 255u) == 0u) { if (xb_ld(&bar[XB_TMO])) break; if (sp > XB_SPIN_CAP) { atomicAdd(&bar[XB_TMO], 1u); break; } }
  }
  nloc = mine > 0u ? mine : 1u; nx = cnt > 0u ? cnt : 1u;
}
DI void xcd_barrier(const XcdBarrier& b) {
  asm volatile("s_waitcnt vmcnt(0)" ::: "memory");
  __syncthreads();
  if (threadIdx.x == 0) {
    unsigned* bar = b.bar;
    __builtin_amdgcn_s_waitcnt(0);
    unsigned nloc = b.st[0], nx = b.st[1];
    if (nloc == 0u) { xcd_barrier_complete(bar, b.x, nloc, nx); b.st[0] = nloc; b.st[1] = nx; }
    const unsigned old = xb_add(&bar[XB_XSUB(b.x)], 1u);
    const unsigned gen = old / nloc;
    if (old + 1u == (gen + 1u) * nloc) {
      __builtin_amdgcn_fence(__ATOMIC_RELEASE, "agent");
      asm volatile("s_waitcnt vmcnt(0)" ::: "memory");
      const unsigned og = xb_add(&bar[XB_TOP], 1u);
      const unsigned tg = og / nx;
      if (og + 1u == (tg + 1u) * nx) xb_add(&bar[XB_TOPGEN], 1u);
      else XB_SPIN(xb_ld(&bar[XB_TOPGEN]) == tg, bar);
      __builtin_amdgcn_fence(__ATOMIC_ACQUIRE, "agent");
      xb_add(&bar[XB_XGEN(b.x)], 1u);
      asm volatile("s_waitcnt vmcnt(0)" ::: "memory");
    } else {
      XB_SPIN(xb_ld(&bar[XB_XGEN(b.x)]) == gen, bar);
      __builtin_amdgcn_fence(__ATOMIC_ACQUIRE, "agent");
      asm volatile("s_waitcnt vmcnt(0)" ::: "memory");
    }
  }
  __syncthreads();
}

__global__ void __launch_bounds__(512, 2) fwd_megakernel(Params p) {
  cg::grid_group grid = cg::this_grid();
  __shared__ __attribute__((aligned(16))) unsigned char smem[131072];
  bf16_t* W = (bf16_t*)(p.ws + WS_W);
  bf16_t* xn = (bf16_t*)(p.ws + WS_XN);
  bf16_t* hid = (bf16_t*)(p.ws + WS_HID);
  bf16_t* z = (bf16_t*)(p.ws + WS_Z);
  bf16_t* mo = (bf16_t*)(p.ws + WS_M);
  unsigned* ctl = (unsigned*)(p.ws + WS_CTL);
  __shared__ uint4 xb_words;
  if (threadIdx.x == 0) xb_words = make_uint4(0u, 0u, 0u, 0u);
  __syncthreads();
  const XcdBarrier xb = xcd_barrier_post((unsigned*)(p.ws + WS_BAR), (volatile LAS unsigned*)&xb_words);

  phase_convert(p, smem);
  grid.sync();
  for (int half = 0; half < 2; ++half) {
    const float* xin = p.in[half];
    float* x = p.out + (size_t)half * HT * D;
    const int L = half ? 2048 : 4096;
    for (int l = 0; l < NLAYER; ++l) {
      const bf16_t* Wl = W + (size_t)l * W_LAYER;
      const float* xsrc = (l == 0) ? xin : x;
      phase_norm(xsrc, p.in[2] + (size_t)l * D, xn, nullptr);
      xcd_barrier(xb);
      phase_ffn_up(xn, Wl + W_GU, hid, smem);
      xcd_barrier(xb);
      phase_gemm_resid(hid, DFF, Wl + W_WD, xsrc, x, 0.5f, smem);
      xcd_barrier(xb);
      phase_norm(x, p.in[6] + (size_t)l * D, xn, nullptr);
      xcd_barrier(xb);
      phase_proj(xn, Wl + W_IN, z, smem);
      xcd_barrier(xb);
      phase_mixers(p, l, half, ctl + (half * NLAYER + l) * 16, smem);
      xcd_barrier(xb);
      phase_ya(p, l, L, (const bf16_t*)(p.ws + WS_SG), Wl + W_G2, z, (bf16_t*)(p.ws + WS_YF), (const bf16_t*)(p.ws + WS_YB), (const float*)(p.ws + WS_BON), smem);
      xcd_barrier(xb);
      phase_merge(xn, Wl, (const bf16_t*)(p.ws + WS_YF), (const bf16_t*)(p.ws + WS_YN), (const bf16_t*)(p.ws + WS_YD), mo, smem);
      xcd_barrier(xb);
      phase_gemm_resid(mo, D, Wl + W_OUT, x, x, 1.0f, smem);
      xcd_barrier(xb);
      phase_norm(x, p.in[26] + (size_t)l * D, xn, nullptr);
      xcd_barrier(xb);
      phase_ffn_up(xn, Wl + W_GU2, hid, smem);
      xcd_barrier(xb);
      phase_gemm_resid(hid, DFF, Wl + W_WD2, x, x, 0.5f, smem);
      xcd_barrier(xb);
    }
    phase_norm(x, p.in[30], nullptr, x);
    xcd_barrier(xb);
  }
}

extern "C" void kernel_launch(void* const* d_in, const int* in_sizes, int n_in, void* d_out, int out_size, void* d_ws, size_t ws_size, hipStream_t stream) {
  static int grid_blocks = 0;
  if (!grid_blocks) {
    int dev = 0, cus = 0, per_cu = 0;
    (void)hipGetDevice(&dev);
    (void)hipDeviceGetAttribute(&cus, hipDeviceAttributeMultiprocessorCount, dev);
    (void)hipOccupancyMaxActiveBlocksPerMultiprocessor(&per_cu, fwd_megakernel, 512, 0);
    if (per_cu < 1) per_cu = 1;
    if (per_cu > 1) per_cu = 1;
    grid_blocks = cus * per_cu;
    if (ws_size < WS_END) fprintf(stderr, "kernel_launch: workspace too small: need %zu have %zu\n", (size_t)WS_END, ws_size);
  }
  (void)hipMemsetAsync((char*)d_ws + WS_CTL, 0, WS_CTL_BYTES, stream);
  Params p{};
  for (int i = 0; i < 31; ++i) p.in[i] = (const float*)d_in[i];
  p.out = (float*)d_out;
  p.ws = (unsigned char*)d_ws;
  void* args[] = {&p};
  hipError_t e = hipLaunchCooperativeKernel((void*)fwd_megakernel, dim3(grid_blocks), dim3(512), args, 0, stream);
  if (e != hipSuccess) fprintf(stderr, "cooperative launch failed: %s (grid %d)\n", hipGetErrorString(e), grid_blocks);
}
```
